# Optimizing an MI355X kernel written in HIP

```python
import math
import jax, jax.numpy as jnp
from jax import lax
import numpy as np

D_MODEL = 1024
BATCH = 8
SEQ = 4096
DEPTH = 2

HEAD_DIM = 64
N_DIFF_HEADS = 4
DIFF_V_DIM = 2 * HEAD_DIM
DIFF_QK_COLS = N_DIFF_HEADS * HEAD_DIM
DIFF_WIDTH = N_DIFF_HEADS * DIFF_V_DIM
N_SB_HEADS = 8
SB_WIDTH = N_SB_HEADS * HEAD_DIM
QBLOCK = 128
N_BUCKETS = 32
MAX_DISTANCE = 128
N_GROUPS = 4
EXPERTS_PER_GROUP = 8
N_EXPERTS = N_GROUPS * EXPERTS_PER_GROUP
TOP_K = 2
D_FF_EXPERT = 512
MOE_BLOCK = 128
EPS = 1e-6
NEG_INF = -1e30

COL_SIZES = (DIFF_QK_COLS, DIFF_QK_COLS, DIFF_QK_COLS, DIFF_QK_COLS, DIFF_WIDTH,
             SB_WIDTH, SB_WIDTH, SB_WIDTH, D_MODEL, D_MODEL)
IN_COLS = sum(COL_SIZES)

kernel_name = "hybrid_diffattn_stickbreak_hiermoe"


def _split_points():
    pts, acc = [], 0
    for c in COL_SIZES[:-1]:
        acc += c
        pts.append(acc)
    return pts


def rmsnorm(x, g):
    x32 = x.astype(jnp.float32)
    y = x32 * lax.rsqrt(jnp.mean(x32 * x32, axis=-1, keepdims=True) + EPS)
    return (y * g.astype(jnp.float32)).astype(x.dtype)


def t5_bucket(n):
    max_exact = N_BUCKETS // 2
    nf = jnp.maximum(n, max_exact).astype(jnp.float32)
    large = max_exact + (jnp.log(nf / max_exact) / math.log(MAX_DISTANCE / max_exact)
                         * (N_BUCKETS - max_exact)).astype(jnp.int32)
    large = jnp.minimum(large, N_BUCKETS - 1)
    return jnp.where(n < max_exact, n, large)


def diff_attention(q1, q2, k1, k2, v, rel_bias, lam):
    b, h, s, _ = q1.shape
    nblk = s // QBLOCK
    kpos = jnp.arange(s)
    scale = HEAD_DIM ** -0.5

    def block(i):
        start = i * QBLOCK
        qpos = start + jnp.arange(QBLOCK)
        dist = qpos[:, None] - kpos[None, :]
        mask = dist >= 0
        bias = jnp.transpose(rel_bias[t5_bucket(jnp.maximum(dist, 0))], (2, 0, 1)).astype(jnp.float32)

        def probs(q, k):
            qb = lax.dynamic_slice_in_dim(q, start, QBLOCK, axis=2)
            sc = jnp.einsum('bhqd,bhkd->bhqk', qb, k).astype(jnp.float32) * scale + bias
            return jax.nn.softmax(jnp.where(mask, sc, NEG_INF), axis=-1)

        w = probs(q1, k1) - lam * probs(q2, k2)
        return jnp.einsum('bhqk,bhkv->bhqv', w.astype(v.dtype), v)

    o = lax.map(block, jnp.arange(nblk))
    return jnp.transpose(o, (1, 2, 0, 3, 4)).reshape(b, h, s, v.shape[-1])


def stick_breaking_attention(q, k, v):
    b, h, s, d = q.shape
    nblk = s // QBLOCK
    kpos = jnp.arange(s)
    scale = HEAD_DIM ** -0.5

    def block(i):
        start = i * QBLOCK
        qpos = start + jnp.arange(QBLOCK)
        mask = kpos[None, :] < qpos[:, None]
        qb = lax.dynamic_slice_in_dim(q, start, QBLOCK, axis=2)
        z = jnp.einsum('bhqd,bhkd->bhqk', qb, k).astype(jnp.float32) * scale
        log_1m = jnp.where(mask, jax.nn.log_sigmoid(-z), 0.0)
        suffix = lax.cumsum(log_1m, axis=3, reverse=True) - log_1m
        a = jnp.where(mask, jnp.exp(jax.nn.log_sigmoid(z) + suffix), 0.0)
        return jnp.einsum('bhqk,bhkd->bhqd', a.astype(v.dtype), v)

    o = lax.map(block, jnp.arange(nblk))
    return jnp.transpose(o, (1, 2, 0, 3, 4)).reshape(b, h, s, d)


def hier_moe(h, w_group, w_router, w_gate, w_up, w_down):
    b, s, d = h.shape
    t = b * s
    xt = h.reshape(t, d)
    gl = (xt @ w_group).astype(jnp.float32)
    gp = jax.nn.softmax(gl, axis=-1)
    g = jnp.argmax(gl, axis=-1).astype(jnp.int32)
    pg = jnp.take_along_axis(gp, g[:, None], axis=-1)
    el = (xt @ w_router).astype(jnp.float32).reshape(t, N_GROUPS, EXPERTS_PER_GROUP)
    el = jnp.take_along_axis(el, g[:, None, None], axis=1)[:, 0]
    topv, topi = lax.top_k(jax.nn.softmax(el, axis=-1), TOP_K)
    gate = pg * topv / jnp.sum(topv, axis=-1, keepdims=True)
    eid = g[:, None] * EXPERTS_PER_GROUP + topi.astype(jnp.int32)

    flat_e = eid.reshape(-1)
    flat_tok = jnp.broadcast_to(jnp.arange(t, dtype=jnp.int32)[:, None], (t, TOP_K)).reshape(-1)
    flat_w = gate.reshape(-1)
    n = t * TOP_K
    p = ((n + MOE_BLOCK - 1) // MOE_BLOCK) * MOE_BLOCK + N_EXPERTS * MOE_BLOCK
    nblk = p // MOE_BLOCK

    order = jnp.argsort(flat_e, stable=True)
    se = flat_e[order]
    counts = jnp.bincount(flat_e, length=N_EXPERTS).astype(jnp.int32)
    starts = jnp.cumsum(counts) - counts
    padded = ((counts + MOE_BLOCK - 1) // MOE_BLOCK) * MOE_BLOCK
    pend = jnp.cumsum(padded)
    pstarts = pend - padded
    dest = pstarts[se] + (jnp.arange(n, dtype=jnp.int32) - starts[se])
    row_tok = jnp.full((p,), t, jnp.int32).at[dest].set(flat_tok[order])
    row_w = jnp.zeros((p,), jnp.float32).at[dest].set(flat_w[order])
    blk_e = jnp.clip(jnp.searchsorted(pend, jnp.arange(nblk, dtype=jnp.int32) * MOE_BLOCK,
                                      side='right'), 0, N_EXPERTS - 1)

    xpad = jnp.concatenate([xt, jnp.zeros((1, d), xt.dtype)], axis=0)

    def expert_block(args):
        rows, w, e = args
        xb = xpad[rows]
        a = jax.nn.silu(xb @ w_gate[e]) * (xb @ w_up[e])
        return (a @ w_down[e]) * w[:, None].astype(xb.dtype)

    yb = lax.map(expert_block, (row_tok.reshape(nblk, MOE_BLOCK),
                                row_w.reshape(nblk, MOE_BLOCK), blk_e))
    out = jnp.zeros((t + 1, d), h.dtype).at[row_tok].add(yb.reshape(p, d).astype(h.dtype))[:t]
    return out.reshape(b, s, d)


def setup_inputs(seed: int = 0) -> dict:
    key = jax.random.key(seed)
    ks = jax.random.split(key, 20)
    f32 = jnp.float32
    nrm = lambda k, shape, scale: jax.random.normal(k, shape, f32) * scale
    gain = lambda k, shape: 1.0 + 0.02 * jax.random.normal(k, shape, f32)
    return {
        "x": jax.random.normal(ks[0], (BATCH, SEQ, D_MODEL), f32),
        "rel_bias": nrm(ks[1], (N_BUCKETS, N_DIFF_HEADS), 0.5),
        "ln1_g": gain(ks[2], (DEPTH, D_MODEL)),
        "w_in": nrm(ks[3], (DEPTH, D_MODEL, IN_COLS), D_MODEL ** -0.5),
        "qnorm_g": gain(ks[4], (DEPTH, HEAD_DIM)),
        "knorm_g": gain(ks[5], (DEPTH, HEAD_DIM)),
        "lambda_q1": nrm(ks[6], (DEPTH, HEAD_DIM), 0.1),
        "lambda_k1": nrm(ks[7], (DEPTH, HEAD_DIM), 0.1),
        "lambda_q2": nrm(ks[8], (DEPTH, HEAD_DIM), 0.1),
        "lambda_k2": nrm(ks[9], (DEPTH, HEAD_DIM), 0.1),
        "subln_g": gain(ks[10], (DEPTH, DIFF_V_DIM)),
        "w_branch_diff": nrm(ks[11], (DEPTH, DIFF_WIDTH, D_MODEL), DIFF_WIDTH ** -0.5),
        "w_branch_sb": nrm(ks[12], (DEPTH, SB_WIDTH, D_MODEL), SB_WIDTH ** -0.5),
        "w_out": nrm(ks[13], (DEPTH, D_MODEL, D_MODEL), D_MODEL ** -0.5),
        "ln2_g": gain(ks[14], (DEPTH, D_MODEL)),
        "w_group": nrm(ks[15], (DEPTH, D_MODEL, N_GROUPS), D_MODEL ** -0.5),
        "w_router": nrm(ks[16], (DEPTH, D_MODEL, N_EXPERTS), D_MODEL ** -0.5),
        "w_gate": nrm(ks[17], (DEPTH, N_EXPERTS, D_MODEL, D_FF_EXPERT), D_MODEL ** -0.5),
        "w_up": nrm(ks[18], (DEPTH, N_EXPERTS, D_MODEL, D_FF_EXPERT), D_MODEL ** -0.5),
        "w_down": nrm(ks[19], (DEPTH, N_EXPERTS, D_FF_EXPERT, D_MODEL), D_FF_EXPERT ** -0.5),
    }


def reference(x, rel_bias, ln1_g, w_in, qnorm_g, knorm_g, lambda_q1, lambda_k1, lambda_q2,
              lambda_k2, subln_g, w_branch_diff, w_branch_sb, w_out, ln2_g, w_group, w_router,
              w_gate, w_up, w_down):
    b, s, _ = x.shape
    split_pts = _split_points()

    def heads(t, nh):
        return t.reshape(b, s, nh, -1).transpose(0, 2, 1, 3)

    def merge_heads(t):
        return t.transpose(0, 2, 1, 3).reshape(b, s, -1)

    for l in range(DEPTH):
        h = rmsnorm(x, ln1_g[l])
        proj = h @ w_in[l]
        q1, q2, k1, k2, va, qs, kss, vs, ga, gb = jnp.split(proj, split_pts, axis=-1)

        q1 = rmsnorm(heads(q1, N_DIFF_HEADS), qnorm_g[l])
        q2 = rmsnorm(heads(q2, N_DIFF_HEADS), qnorm_g[l])
        k1 = rmsnorm(heads(k1, N_DIFF_HEADS), knorm_g[l])
        k2 = rmsnorm(heads(k2, N_DIFF_HEADS), knorm_g[l])
        lam_init = 0.8 - 0.6 * math.exp(-0.3 * l)
        lam = (jnp.exp(jnp.sum(lambda_q1[l].astype(jnp.float32) * lambda_k1[l].astype(jnp.float32)))
               - jnp.exp(jnp.sum(lambda_q2[l].astype(jnp.float32) * lambda_k2[l].astype(jnp.float32)))
               + lam_init)
        oa = diff_attention(q1, q2, k1, k2, heads(va, N_DIFF_HEADS), rel_bias, lam)
        oa = merge_heads(rmsnorm(oa, subln_g[l]) * (1.0 - lam_init))

        ob = merge_heads(stick_breaking_attention(heads(qs, N_SB_HEADS), heads(kss, N_SB_HEADS),
                                                  heads(vs, N_SB_HEADS)))

        mixed = (jax.nn.sigmoid(ga) * (oa @ w_branch_diff[l])
                 + jax.nn.sigmoid(gb) * (ob @ w_branch_sb[l]))
        x = x + mixed @ w_out[l]

        x = x + hier_moe(rmsnorm(x, ln2_g[l]), w_group[l], w_router[l], w_gate[l], w_up[l], w_down[l])
    return x
```

```cpp
#include <hip/hip_runtime.h>
#include <cstdio>
#include <cstdint>

#define GAS __attribute__((address_space(1)))
#define LAS __attribute__((address_space(3)))
typedef unsigned short bf16;
typedef short bf16x8 __attribute__((ext_vector_type(8)));
typedef short s16x4 __attribute__((ext_vector_type(4)));
typedef short v4i16_t __attribute__((ext_vector_type(4)));
typedef float f32x2 __attribute__((ext_vector_type(2)));
typedef float f32x4 __attribute__((ext_vector_type(4)));
typedef float f32x16 __attribute__((ext_vector_type(16)));
typedef unsigned u32x2 __attribute__((ext_vector_type(2)));
typedef unsigned u32x4 __attribute__((ext_vector_type(4)));
typedef GAS unsigned gu32;

constexpr int T = 32768, SEQ = 4096, NB = 8, D = 1024, NIN = 5120, DEPTH = 2;
constexpr int NE = 32, DFF = 512;
constexpr float EPS = 1e-6f;
constexpr float LOG2E = 1.4426950408889634f;
constexpr float C2 = 0.125f * LOG2E;
constexpr int NWAVES = 8;
#ifndef SB_EARLY_EXIT
#define SB_EARLY_EXIT 1
#endif
#ifndef MK_SPLIT
#define MK_SPLIT 0
#endif
#ifndef PH_MASK
#define PH_MASK 0x3ff
#endif
#define PH_ON(k) (((PH_MASK) >> (k)) & 1)

constexpr size_t MiB = 1u << 20;
constexpr size_t WS_CTL = 0, CTL_ZERO_BYTES = 1 * MiB;
constexpr size_t WS_RSTD1 = 1 * MiB;
constexpr size_t WS_TOKI = 2 * MiB;
constexpr size_t WS_TOKW = 2 * MiB + 512 * 1024;
constexpr size_t WS_ENT_TOK = 3 * MiB;
constexpr size_t WS_ENT_W = 3 * MiB + 512 * 1024;
constexpr size_t WS_ENT_RS = 4 * MiB;
constexpr size_t WS_WR_T = 5 * MiB;
constexpr size_t WS_WIN_T = 8 * MiB;
constexpr size_t WS_WBD_T = 28 * MiB;
constexpr size_t WS_WBS_T = 30 * MiB;
constexpr size_t WS_WOUT_T = 32 * MiB;
constexpr size_t WS_WGU_T = 36 * MiB;
constexpr size_t WS_WDN_T = 100 * MiB;
constexpr size_t WS_XB = 132 * MiB;
constexpr size_t WS_R0 = 196 * MiB;
constexpr size_t WS_DQ = WS_R0;
constexpr size_t WS_DK = WS_R0 + 32 * MiB;
constexpr size_t WS_VA = WS_R0 + 64 * MiB;
constexpr size_t WS_SBQ = WS_R0 + 96 * MiB;
constexpr size_t WS_SBK = WS_R0 + 128 * MiB;
constexpr size_t WS_SBV = WS_R0 + 160 * MiB;
constexpr size_t WS_G1 = WS_R0 + 192 * MiB;
constexpr size_t WS_G2 = WS_R0 + 256 * MiB;
constexpr size_t WS_MIXED = WS_DK;
constexpr int PMAX = 65536 + 32 * 256;
constexpr size_t WS_ACT = WS_R0;
constexpr size_t WS_XS = WS_R0 + 72 * MiB;
constexpr size_t WS_CONTRIB = WS_R0 + 72 * MiB;
constexpr size_t WS_END = WS_R0 + 320 * MiB;

constexpr int CW_BAR = 4096;
constexpr int CW_CNT = 16384;

constexpr int RING_BYTES = 131072;
constexpr int LDSCTL_OFF = RING_BYTES, MISC_OFF = LDSCTL_OFF + 320;
constexpr int LUT_OFF = LDSCTL_OFF + 512;
constexpr int WSF_OFF = LDSCTL_OFF + 2560;
constexpr int MOE_OFF = LDSCTL_OFF + 4608;
constexpr int LDS_BYTES = 147456;

#define RLX_AGENT __ATOMIC_RELAXED, __HIP_MEMORY_SCOPE_AGENT
#define LDS_WAIT() asm volatile("s_waitcnt lgkmcnt(0)" ::: "memory")
#define VM_WAIT() asm volatile("s_waitcnt vmcnt(0)" ::: "memory")
__device__ __forceinline__ unsigned cvt_pk_bf16(float lo, float hi) { unsigned r; asm volatile("v_cvt_pk_bf16_f32 %0, %1, %2" : "=v"(r) : "v"(lo), "v"(hi)); return r; }
__device__ __forceinline__ float bf_lo(unsigned w) { return __uint_as_float(w << 16); }
__device__ __forceinline__ float bf_hi(unsigned w) { return __uint_as_float(w & 0xffff0000u); }
__device__ __forceinline__ float wave_sum(float v) {
#pragma unroll
    for (int o = 1; o < 64; o <<= 1) v += __shfl_xor(v, o);
    return v;
}
__device__ __forceinline__ float fexp2(float x) { return __builtin_amdgcn_exp2f(x); }
__device__ __forceinline__ float flog2(float x) { return __builtin_amdgcn_logf(x); }

#define XB_TMO      128
#define XB_XCNT(j)  (256  + 64 * (j))
#define XB_XSUB(j)  (1280 + 64 * (j))
#define XB_XGEN(j)  (2304 + 64 * (j))
#define XB_TOP      3328
#define XB_TOPGEN   3392
#define XCD_BAR_WORDS 3456
#define XB_SPIN_CAP (1u << 23)
__device__ __forceinline__ unsigned xb_ld(unsigned* p)              { return __hip_atomic_load(p, __ATOMIC_RELAXED, __HIP_MEMORY_SCOPE_AGENT); }
__device__ __forceinline__ unsigned xb_add(unsigned* p, unsigned v) { return __hip_atomic_fetch_add(p, v, __ATOMIC_RELAXED, __HIP_MEMORY_SCOPE_AGENT); }
__device__ __forceinline__ unsigned xb_xcc_id() { return (unsigned)__builtin_amdgcn_s_getreg((3 << 11) | 20) & 0xFu; }
#define XB_SPIN(cond, bar) do { unsigned _sp = 0; while (cond) { __builtin_amdgcn_s_sleep(1); \
    if ((++_sp & 255u) == 0u) { if (xb_ld(&(bar)[XB_TMO])) break; if (_sp > XB_SPIN_CAP) { atomicAdd(&(bar)[XB_TMO], 1u); break; } } } } while (0)
struct XcdBarrier { unsigned* bar; unsigned x; volatile LAS unsigned* st; };
__device__ __forceinline__ XcdBarrier xcd_barrier_post(unsigned* bar, volatile LAS unsigned* st) {
    XcdBarrier b; b.bar = bar; b.x = xb_xcc_id(); b.st = st;
    if (threadIdx.x == 0) (void)xb_add(&bar[XB_XCNT(b.x)], 1u);
    return b;
}
__device__ __forceinline__ void xcd_barrier_complete(unsigned* bar, unsigned x, unsigned& nloc, unsigned& nx) {
    const unsigned G = gridDim.x * gridDim.y * gridDim.z;
    unsigned sum, cnt, mine, sp = 0u;
    for (;;) {
        sum = 0u; cnt = 0u; mine = 0u;
#pragma unroll
        for (unsigned j = 0; j < 16; ++j) { const unsigned c = xb_ld(&bar[XB_XCNT(j)]); sum += c; cnt += (c > 0u) ? 1u : 0u; mine = (j == x) ? c : mine; }
        if (sum == G) break;
        __builtin_amdgcn_s_sleep(1);
        if ((++sp & 255u) == 0u) { if (xb_ld(&bar[XB_TMO])) break; if (sp > XB_SPIN_CAP) { atomicAdd(&bar[XB_TMO], 1u); break; } }
    }
    nloc = mine > 0u ? mine : 1u; nx = cnt > 0u ? cnt : 1u;
}
__device__ __forceinline__ void xcd_barrier(const XcdBarrier& b) {
    asm volatile("s_waitcnt vmcnt(0)" ::: "memory");
    __syncthreads();
    if (threadIdx.x == 0) {
        unsigned* bar = b.bar;
        __builtin_amdgcn_s_waitcnt(0);
        unsigned nloc = b.st[0], nx = b.st[1];
        if (nloc == 0u) { xcd_barrier_complete(bar, b.x, nloc, nx); b.st[0] = nloc; b.st[1] = nx; }
        const unsigned old = xb_add(&bar[XB_XSUB(b.x)], 1u);
        const unsigned gen = old / nloc;
        if (old + 1u == (gen + 1u) * nloc) {
            __builtin_amdgcn_fence(__ATOMIC_RELEASE, "agent");
            asm volatile("s_waitcnt vmcnt(0)" ::: "memory");
            const unsigned og = xb_add(&bar[XB_TOP], 1u);
            const unsigned tg = og / nx;
            if (og + 1u == (tg + 1u) * nx) xb_add(&bar[XB_TOPGEN], 1u);
            else XB_SPIN(xb_ld(&bar[XB_TOPGEN]) == tg, bar);
            __builtin_amdgcn_fence(__ATOMIC_ACQUIRE, "agent");
            xb_add(&bar[XB_XGEN(b.x)], 1u);
            asm volatile("s_waitcnt vmcnt(0)" ::: "memory");
        } else {
            XB_SPIN(xb_ld(&bar[XB_XGEN(b.x)]) == gen, bar);
            __builtin_amdgcn_fence(__ATOMIC_ACQUIRE, "agent");
            asm volatile("s_waitcnt vmcnt(0)" ::: "memory");
        }
    }
    __syncthreads();
}

namespace pg8 {
constexpr int BM = 256, BK = 64, HALF = 128, HTB = HALF * BK * 2, STAGE_BYTES = 8 * HTB, NXCD = 8, WGM = 8;
__host__ __device__ __forceinline__ int lds_byte(int r, int c) { const int st = (r >> 4) * 2 + (c >> 5), rr = r & 15, cc = c & 31, ob = rr * 64 + cc * 2; return st * 1024 + (ob ^ (((ob >> 9) & 1) << 5)); }
__host__ __device__ __forceinline__ void stage_rc(int b, int& R, int& C) { const int st = b / 1024, sb = b % 1024, swz = sb ^ (((sb >> 9) & 1) << 5); R = (st >> 1) * 16 + swz / 64; C = (st & 1) * 32 + (swz % 64) / 2; }
__host__ __device__ __forceinline__ int perm32(int rho) { const int n = rho >> 4, i = rho & 15; return 8 * (i >> 2) + 4 * n + (i & 3); }

struct Unit { const char* A; const char* B; int pm, pn, kind; };
constexpr int KEEP = 0x100;

__device__ __forceinline__ void tile_order(int L, int nM, int nN, int& pm, int& pn) {
    const int nwg = nM * nN; int wgid = L;
    { const int q = nwg / NXCD, r = nwg % NXCD, xcd = wgid % NXCD, off = wgid / NXCD; wgid = (xcd < r ? xcd * (q + 1) : r * (q + 1) + (xcd - r) * q) + off; }
    const int nig = WGM * nN, gid = wgid / nig, fm = gid * WGM, gsz = (nM - fm) < WGM ? (nM - fm) : WGM;
    pm = fm + ((wgid % nig) % gsz); pn = (wgid % nig) / gsz;
}

template <class Epi, class Sched, bool ALIGN_EPI = true, bool SP2 = true>
__device__ __forceinline__ void gemm_phase(LAS unsigned char* lds, const int K, const Sched& S, const Epi& E) {
    int tid_ = threadIdx.x; asm volatile("" : "+v"(tid_));
    const int tid = tid_, wid = __builtin_amdgcn_readfirstlane(tid >> 6), lane = tid & 63, wr = wid >> 2, wc = wid & 3, fr = lane & 15, fq = lane >> 4;
    const int nt = K / BK;
    unsigned voffA[2], voffB[2];
#pragma unroll
    for (int i = 0; i < 2; ++i) { int R, C; stage_rc(tid * 16 + i * 8192, R, C); const int Rb = Epi::PERM ? ((R & ~31) + perm32(R & 31)) : R;
        voffA[i] = (unsigned)(R * K + C) * 2u; voffB[i] = (unsigned)(Rb * K + C) * 2u; }
    const size_t kstep = (size_t)(BK * 2);
    const size_t hstep = (size_t)HALF * K * 2;
    const unsigned ldsw = (unsigned)wid * 1024u;
    const int aoff = lds_byte(wr * 64 + fr, fq * 8), boff = lds_byte(wc * 32 + fr, fq * 8);
#define PG8_SA(b, h) (((b) * 2 + (h)) * HTB)
#define PG8_SB(b, h) ((4 + (b) * 2 + (h)) * HTB)
#define PG8_STAGE(bufoff, gbase, voff) do { _Pragma("unroll") for (int _i = 0; _i < 2; ++_i) \
        __builtin_amdgcn_global_load_lds((const unsigned*)((const char*)(gbase) + (voff)[_i]), (LAS unsigned*)(lds + (bufoff) + ldsw + _i * 8192), 16, 0, 0); } while (0)
#define PG8_LDA(dst, b, h) do { _Pragma("unroll") for (int m = 0; m < 4; ++m) _Pragma("unroll") for (int k = 0; k < 2; ++k) dst[m][k] = *(const LAS bf16x8*)(lds + PG8_SA(b, h) + aoff + m * 2048 + k * 1024); } while (0)
#define PG8_LDB(dst, b, h) do { _Pragma("unroll") for (int n = 0; n < 2; ++n) _Pragma("unroll") for (int k = 0; k < 2; ++k) dst[n][k] = *(const LAS bf16x8*)(lds + PG8_SB(b, h) + boff + n * 2048 + k * 1024); } while (0)
#define PG8_MMA(ai, bj, At, Bt) do { __builtin_amdgcn_s_setprio(1); _Pragma("unroll") for (int m = 0; m < 4; ++m) _Pragma("unroll") for (int n = 0; n < 2; ++n) _Pragma("unroll") for (int k = 0; k < 2; ++k) \
        acc[ai][bj][m][n] = __builtin_amdgcn_mfma_f32_16x16x32_bf16(Bt[n][k], At[m][k], acc[ai][bj][m][n], 0, 0, 0); __builtin_amdgcn_s_setprio(0); } while (0)
#define PG8_WAIT_V(n) asm volatile("s_waitcnt vmcnt(" #n ")" ::: "memory")
#define PG8_WAIT_L(n) asm volatile("s_waitcnt lgkmcnt(" #n ")" ::: "memory")
#define PG8_BAR __builtin_amdgcn_s_barrier()
#define PG8_SCHED __builtin_amdgcn_sched_barrier(0)
    Unit cur, nxt; int ui = 0;
    if (!S.next(0, cur)) return;
    f32x4 acc[2][2][4][2];
#pragma unroll
    for (int a = 0; a < 2; ++a)
#pragma unroll
        for (int b = 0; b < 2; ++b)
#pragma unroll
            for (int m = 0; m < 4; ++m)
#pragma unroll
                for (int n = 0; n < 2; ++n) acc[a][b][m][n] = (f32x4){0.f, 0.f, 0.f, 0.f};
    bf16x8 At[4][2], B0[2][2], B1[2][2];
    const char* cA = cur.A; const char* cB = cur.B;
    static_assert(SP2, "only the SP2 loop is kept here");
    PG8_STAGE(PG8_SB(0, 0), cB, voffB); PG8_STAGE(PG8_SB(0, 1), cB + hstep, voffB); PG8_STAGE(PG8_SA(0, 0), cA, voffA); PG8_STAGE(PG8_SA(0, 1), cA + hstep, voffA);
    if (wr == 1) PG8_BAR;
    PG8_WAIT_V(2); PG8_BAR;
    PG8_STAGE(PG8_SB(1, 0), cB + kstep, voffB); PG8_STAGE(PG8_SA(1, 0), cA + kstep, voffA); PG8_STAGE(PG8_SB(1, 1), cB + hstep + kstep, voffB);
    PG8_WAIT_V(6); PG8_BAR;
    for (;;) {
        const bool has_next = S.next(ui + 1, nxt);
        const char* nA = has_next ? nxt.A : cA; const char* nB = has_next ? nxt.B : cB;
        for (int t = 0; t < nt; t += 2) {
            const bool last = (t == nt - 2);
            const char* a1 = cA + (size_t)(t + 1) * kstep;
            const char* a2 = last ? nA : cA + (size_t)(t + 2) * kstep; const char* b2 = last ? nB : cB + (size_t)(t + 2) * kstep;
            const char* a3 = a2 + kstep; const char* b3 = b2 + kstep;
            PG8_LDB(B0, 0, 0); PG8_LDB(B1, 0, 1); PG8_SCHED; PG8_LDA(At, 0, 0); PG8_STAGE(PG8_SA(1, 1), a1 + hstep, voffA);
            PG8_WAIT_V(8); PG8_WAIT_L(0); PG8_BAR; PG8_MMA(0, 0, At, B0); PG8_MMA(0, 1, At, B1); PG8_BAR; PG8_SCHED;
            PG8_LDA(At, 0, 1); PG8_STAGE(PG8_SB(0, 0), b2, voffB); PG8_STAGE(PG8_SB(0, 1), b2 + hstep, voffB); PG8_STAGE(PG8_SA(0, 0), a2, voffA);
            PG8_WAIT_V(8); PG8_WAIT_L(0); PG8_BAR; PG8_MMA(1, 0, At, B0); PG8_MMA(1, 1, At, B1); PG8_BAR; PG8_SCHED;
            PG8_LDB(B0, 1, 0); PG8_LDB(B1, 1, 1); PG8_SCHED; PG8_LDA(At, 1, 0); PG8_STAGE(PG8_SA(0, 1), a2 + hstep, voffA);
            PG8_WAIT_V(8); PG8_WAIT_L(0); PG8_BAR; PG8_MMA(0, 0, At, B0); PG8_MMA(0, 1, At, B1); PG8_BAR; PG8_SCHED;
            PG8_LDA(At, 1, 1); PG8_STAGE(PG8_SB(1, 0), b3, voffB); PG8_STAGE(PG8_SB(1, 1), b3 + hstep, voffB); PG8_STAGE(PG8_SA(1, 0), a3, voffA);
            PG8_WAIT_V(8); PG8_WAIT_L(0); PG8_BAR; PG8_MMA(1, 0, At, B0); PG8_MMA(1, 1, At, B1); PG8_BAR; PG8_SCHED;
        }
        if constexpr (ALIGN_EPI) { if (wr == 0) PG8_BAR; }
        E(acc, cur, wr, wc, fr, fq);
        if (!has_next) break;
        if (!(cur.kind & KEEP)) {
#pragma unroll
            for (int a = 0; a < 2; ++a)
#pragma unroll
                for (int b = 0; b < 2; ++b)
#pragma unroll
                    for (int m = 0; m < 4; ++m)
#pragma unroll
                        for (int n = 0; n < 2; ++n) acc[a][b][m][n] = (f32x4){0.f, 0.f, 0.f, 0.f};
        }
        cur = nxt; cA = nA; cB = nB; ++ui;
        if constexpr (ALIGN_EPI) { if (wr == 1) PG8_BAR; }
    }
    PG8_WAIT_V(0);
    if constexpr (!ALIGN_EPI) { if (wr == 0) PG8_BAR; }
    PG8_BAR;
#undef PG8_SA
#undef PG8_SB
#undef PG8_STAGE
#undef PG8_LDA
#undef PG8_LDB
#undef PG8_MMA
#undef PG8_WAIT_V
#undef PG8_WAIT_L
#undef PG8_BAR
#undef PG8_SCHED
}
}

struct Args { const float* in[20]; float* out; unsigned char* ws; int ph_lo, ph_hi; };
#define KIN(i) (((const __attribute__((address_space(4))) Args*)__builtin_amdgcn_kernarg_segment_ptr())->in[i])
struct Frame {
    LAS unsigned char* lds;
    volatile LAS unsigned* MISC;
    gu32* ctl;
    int tid, lane, wave, G;
    unsigned char* ws;
    float* out;
};

using pg8::Unit;
typedef f32x4 Acc[2][2][4][2];

struct EpiInProj {
    static constexpr bool PERM = true;
    unsigned char* ws; const float* gq; const float* gk;
    __device__ __forceinline__ void operator()(Acc& acc, const Unit& u, int wr, int wc, int fr, int fq) const {
        const int row0 = u.pm * 256 + wr * 64 + fr; const int pn = u.pn; const float* rstd = (const float*)(ws + WS_RSTD1);
        bf16* G1 = (bf16*)(ws + WS_G1); bf16* G2 = (bf16*)(ws + WS_G2);
        if (pn < 4) {
            const float* g = ((pn < 2) ? gq : gk) + 8 * fq; const float sc = (pn < 2) ? C2 : 1.f;
            bf16* dst = (bf16*)(ws + WS_DQ + (size_t)(pn >> 1) * (32 * MiB)) + wc * 128 + (pn & 1) * 64 + 8 * fq;
#pragma unroll
            for (int ai = 0; ai < 2; ++ai)
#pragma unroll
                for (int m = 0; m < 4; ++m) {
                    const int row = row0 + ai * 128 + m * 16; const float r_ = rstd[row]; float ss = 0.f; f32x4 v[2][2];
#pragma unroll
                    for (int bj = 0; bj < 2; ++bj)
#pragma unroll
                        for (int n = 0; n < 2; ++n) { v[bj][n] = acc[ai][bj][m][n] * r_; ss += (v[bj][n][0] * v[bj][n][0] + v[bj][n][1] * v[bj][n][1]) + (v[bj][n][2] * v[bj][n][2] + v[bj][n][3] * v[bj][n][3]); }
                    ss += __shfl_xor(ss, 16); ss += __shfl_xor(ss, 32);
                    const float inv = sc / sqrtf(ss * (1.0f / 64.0f) + EPS);
                    bf16* rowp = dst + (size_t)row * 512;
#pragma unroll
                    for (int bj = 0; bj < 2; ++bj) { const f32x4 g0 = *(const f32x4*)(g + 32 * bj) * inv, g1 = *(const f32x4*)(g + 32 * bj + 4) * inv; u32x4 w;
                        w.x = cvt_pk_bf16(v[bj][0][0] * g0[0], v[bj][0][1] * g0[1]); w.y = cvt_pk_bf16(v[bj][0][2] * g0[2], v[bj][0][3] * g0[3]);
                        w.z = cvt_pk_bf16(v[bj][1][0] * g1[0], v[bj][1][1] * g1[1]); w.w = cvt_pk_bf16(v[bj][1][2] * g1[2], v[bj][1][3] * g1[3]);
                        *(u32x4*)(rowp + bj * 32) = w; }
                    asm volatile("" ::: "memory");
                }
        } else if (pn < 12) {
            const int sec = (pn - 4) >> 1; bf16* dst = (bf16*)(ws + WS_VA + (size_t)sec * (32 * MiB)) + ((pn - 4) & 1) * 256 + wc * 32 + 8 * fq; const float sc = (sec == 1) ? C2 : 1.f;
#pragma unroll
            for (int ai = 0; ai < 2; ++ai)
#pragma unroll
                for (int m = 0; m < 4; ++m) { const int row = row0 + ai * 128 + m * 16; const float r_ = rstd[row] * sc; bf16* rowp = dst + (size_t)row * 512;
#pragma unroll
                    for (int bj = 0; bj < 2; ++bj) { const f32x4 v0 = acc[ai][bj][m][0] * r_, v1 = acc[ai][bj][m][1] * r_; u32x4 w;
                        w.x = cvt_pk_bf16(v0[0], v0[1]); w.y = cvt_pk_bf16(v0[2], v0[3]); w.z = cvt_pk_bf16(v1[0], v1[1]); w.w = cvt_pk_bf16(v1[2], v1[3]);
                        *(u32x4*)(rowp + bj * 128) = w; }
                    asm volatile("" ::: "memory"); }
        } else {
            const int col0 = (pn - 12) * 128 + wc * 32 + 8 * fq;
#pragma unroll
            for (int ai = 0; ai < 2; ++ai)
#pragma unroll
                for (int m = 0; m < 4; ++m) { const int row = row0 + ai * 128 + m * 16; const float r_ = rstd[row]; const size_t off = (size_t)row * 1024 + col0;
                    float rr[8], sb[8];
#pragma unroll
                    for (int n = 0; n < 2; ++n)
#pragma unroll
                        for (int j = 0; j < 4; ++j) { const float ga = acc[ai][0][m][n][j] * r_, gb = fmaxf(acc[ai][1][m][n][j] * r_, -60.f);
                            const float ea = fexp2(-ga * LOG2E), eb = fexp2(-gb * LOG2E);
                            rr[n * 4 + j] = (1.f + eb) * __builtin_amdgcn_rcpf(1.f + ea); sb[n * 4 + j] = __builtin_amdgcn_rcpf(1.f + eb); }
                    u32x4 w1, w2;
                    w1.x = cvt_pk_bf16(rr[0], rr[1]); w1.y = cvt_pk_bf16(rr[2], rr[3]); w1.z = cvt_pk_bf16(rr[4], rr[5]); w1.w = cvt_pk_bf16(rr[6], rr[7]);
                    w2.x = cvt_pk_bf16(sb[0], sb[1]); w2.y = cvt_pk_bf16(sb[2], sb[3]); w2.z = cvt_pk_bf16(sb[4], sb[5]); w2.w = cvt_pk_bf16(sb[6], sb[7]);
                    *(u32x4*)(G1 + off) = w1; *(u32x4*)(G2 + off) = w2;
                    asm volatile("" ::: "memory"); }
        }
    }
};

struct EpiBranch {
    static constexpr bool PERM = true;
    const bf16 *G1, *G2; bf16* MIXED;
    __device__ __forceinline__ void operator()(Acc& acc, const Unit& u, int wr, int wc, int fr, int fq) const {
        const int row0 = u.pm * 256 + wr * 64 + fr; const int col0 = u.pn * 256 + wc * 32 + 8 * fq; const bool first = (u.kind & 0xff) == 0;
        const bf16* Gp = first ? G1 : G2;
#pragma unroll
        for (int ai = 0; ai < 2; ++ai)
#pragma unroll
            for (int m = 0; m < 4; ++m) { const size_t off = (size_t)(row0 + ai * 128 + m * 16) * 1024 + col0;
#pragma unroll
                for (int bj = 0; bj < 2; ++bj) { const u32x4 g = *(const u32x4*)(Gp + off + bj * 128);
                    f32x4 v0 = acc[ai][bj][m][0], v1 = acc[ai][bj][m][1];
                    v0[0] *= bf_lo(g.x); v0[1] *= bf_hi(g.x); v0[2] *= bf_lo(g.y); v0[3] *= bf_hi(g.y); v1[0] *= bf_lo(g.z); v1[1] *= bf_hi(g.z); v1[2] *= bf_lo(g.w); v1[3] *= bf_hi(g.w);
                    if (first) { acc[ai][bj][m][0] = v0; acc[ai][bj][m][1] = v1; }
                    else { u32x4 w; w.x = cvt_pk_bf16(v0[0], v0[1]); w.y = cvt_pk_bf16(v0[2], v0[3]); w.z = cvt_pk_bf16(v1[0], v1[1]); w.w = cvt_pk_bf16(v1[2], v1[3]);
                        *(u32x4*)(MIXED + off + bj * 128) = w; } } }
    }
};

struct EpiOutProj {
    static constexpr bool PERM = true;
    const float* xold; float* xnew; bf16* XB;
    __device__ __forceinline__ void operator()(Acc& acc, const Unit& u, int wr, int wc, int fr, int fq) const {
        const int row0 = u.pm * 256 + wr * 64 + fr; const int col0 = u.pn * 256 + wc * 32 + 8 * fq;
#pragma unroll
        for (int ai = 0; ai < 2; ++ai)
#pragma unroll
            for (int m = 0; m < 4; ++m) { const size_t off = (size_t)(row0 + ai * 128 + m * 16) * 1024 + col0;
#pragma unroll
                for (int bj = 0; bj < 2; ++bj) { const f32x4 x0 = *(const f32x4*)(xold + off + bj * 128), x1 = *(const f32x4*)(xold + off + bj * 128 + 4);
                    const f32x4 v0 = acc[ai][bj][m][0] + x0, v1 = acc[ai][bj][m][1] + x1;
                    *(f32x4*)(xnew + off + bj * 128) = v0; *(f32x4*)(xnew + off + bj * 128 + 4) = v1;
                    u32x4 w; w.x = cvt_pk_bf16(v0[0], v0[1]); w.y = cvt_pk_bf16(v0[2], v0[3]); w.z = cvt_pk_bf16(v1[0], v1[1]); w.w = cvt_pk_bf16(v1[2], v1[3]);
                    *(u32x4*)(XB + off + bj * 128) = w; } }
    }
};

struct EpiMoe1 {
    static constexpr bool PERM = true;
    const float* ent_rs; bf16* ACT;
    __device__ __forceinline__ void operator()(Acc& acc, const Unit& u, int wr, int wc, int fr, int fq) const {
        const int row0 = u.pm * 256 + wr * 64 + fr; const int col0 = u.pn * 128 + wc * 32 + 8 * fq;
#pragma unroll
        for (int ai = 0; ai < 2; ++ai)
#pragma unroll
            for (int m = 0; m < 4; ++m) { const int prow = row0 + ai * 128 + m * 16; const float r_ = ent_rs[prow]; float a[8];
#pragma unroll
                for (int n = 0; n < 2; ++n)
#pragma unroll
                    for (int j = 0; j < 4; ++j) { const float g = acc[ai][0][m][n][j] * r_, up = acc[ai][1][m][n][j] * r_;
                        a[n * 4 + j] = g * up * __builtin_amdgcn_rcpf(1.f + fexp2(-g * LOG2E)); }
                u32x4 w; w.x = cvt_pk_bf16(a[0], a[1]); w.y = cvt_pk_bf16(a[2], a[3]); w.z = cvt_pk_bf16(a[4], a[5]); w.w = cvt_pk_bf16(a[6], a[7]);
                *(u32x4*)(ACT + (size_t)prow * 512 + col0) = w; }
    }
};

struct EpiMoe2 {
    static constexpr bool PERM = true;
    const int* ent_tok; const float* ent_w; bf16* CONTRIB;
    __device__ __forceinline__ void operator()(Acc& acc, const Unit& u, int wr, int wc, int fr, int fq) const {
        const int row0 = u.pm * 256 + wr * 64 + fr; const int col0 = u.pn * 256 + wc * 32 + 8 * fq;
#pragma unroll
        for (int ai = 0; ai < 2; ++ai)
#pragma unroll
            for (int m = 0; m < 4; ++m) { const int prow = row0 + ai * 128 + m * 16; const int tok2 = ent_tok[prow]; const float w_ = ent_w[prow];
                if (tok2 >= 0) {
#pragma unroll
                    for (int bj = 0; bj < 2; ++bj) { const f32x4 v0 = acc[ai][bj][m][0] * w_, v1 = acc[ai][bj][m][1] * w_; u32x4 w;
                        w.x = cvt_pk_bf16(v0[0], v0[1]); w.y = cvt_pk_bf16(v0[2], v0[3]); w.z = cvt_pk_bf16(v1[0], v1[1]); w.w = cvt_pk_bf16(v1[2], v1[3]);
                        *(u32x4*)(CONTRIB + (size_t)tok2 * 1024 + col0 + bj * 128) = w; } } }
    }
};

struct SchedPlain {
    const char* A; const char* Bt; int nM, nN, K, G, c;
    __device__ __forceinline__ bool next(int i, Unit& u) const {
        const long L = (long)i * G + c; if (L >= (long)nM * nN) return false;
        pg8::tile_order((int)L, nM, nN, u.pm, u.pn); u.kind = 0;
        u.A = A + (size_t)u.pm * 256 * K * 2; u.B = Bt + (size_t)u.pn * 256 * K * 2; return true;
    }
};
struct SchedBranch {
    const char *OA, *OB, *WBD, *WBS; int G, c;
    __device__ __forceinline__ bool next(int i, Unit& u) const {
        const long L = (long)(i >> 1) * G + c; if (L >= 128 * 4) return false;
        pg8::tile_order((int)L, 128, 4, u.pm, u.pn); const int br = i & 1; u.kind = br ? 1 : (0 | pg8::KEEP);
        u.A = (br ? OB : OA) + (size_t)u.pm * 256 * 512 * 2; u.B = (br ? WBS : WBD) + (size_t)u.pn * 256 * 512 * 2; return true;
    }
};
struct SchedMoe {
    const char* A; const char* W; const LAS int* ust; int K; size_t wstride; int G, c;
    __device__ __forceinline__ bool next(int i, Unit& u) const {
        const long L = (long)i * G + c; const int nrb = ust[32]; if (L >= (long)nrb * 4) return false;
        const int rb = (int)(L >> 2), pn = (int)(L & 3); int e = 0;
        for (int j = 1; j < 32; ++j) e += (ust[j] <= rb) ? 1 : 0;
        u.pm = rb; u.pn = pn; u.kind = 0; u.A = A + (size_t)rb * 256 * K * 2; u.B = W + (size_t)e * wstride + (size_t)pn * 256 * K * 2; return true;
    }
};

template <class RowMap>
__device__ __forceinline__ void transpose_item(const float* W, int N, bf16* WT, int Kd, const float* gk, LAS float* scr, int kb, int nb, int lane, const RowMap& map) {
    const int k0 = 64 * kb, n0 = 32 * nb;
#pragma unroll 8
    for (int i = 0; i < 32; ++i) { const int kk = 2 * i + (lane >> 5); float v = W[(size_t)(k0 + kk) * N + n0 + (lane & 31)]; if (gk) v *= gk[k0 + kk]; scr[kk * 33 + (lane & 31)] = v; }
    LDS_WAIT(); asm volatile("" ::: "memory");
    const int c = lane & 7;
#pragma unroll
    for (int j = 0; j < 4; ++j) { const int n = (lane >> 3) + 8 * j; const LAS float* s = scr + (8 * c) * 33 + n;
        u32x4 o; o.x = cvt_pk_bf16(s[0 * 33], s[1 * 33]); o.y = cvt_pk_bf16(s[2 * 33], s[3 * 33]); o.z = cvt_pk_bf16(s[4 * 33], s[5 * 33]); o.w = cvt_pk_bf16(s[6 * 33], s[7 * 33]);
        *(u32x4*)(WT + (size_t)map(n0 + n) * Kd + k0 + 8 * c) = o; }
    LDS_WAIT(); asm volatile("" ::: "memory");
}
struct MapPlain { __device__ __forceinline__ int operator()(int c) const { return c; } };
struct MapIn {
    __device__ __forceinline__ int operator()(int c) const {
        if (c < 1024) { const int pn = c >> 8, hh = (c >> 6) & 3, d = c & 63; return 256 * pn + 128 * (d >> 5) + 32 * hh + (d & 31); }
        if (c < 3072) return c;
        if (c < 4096) { const int cc = c - 3072; return 3072 + 256 * (cc >> 7) + (cc & 127); }
        const int cc = c - 4096; return 3072 + 256 * (cc >> 7) + 128 + (cc & 127);
    }
};
struct MapGU { int up; __device__ __forceinline__ int operator()(int c) const { return 256 * (c >> 7) + 128 * up + (c & 127); } };

__device__ __forceinline__ void convert_moe_weights(Frame& F, int l, int gw, int NGW) {
    LAS float* scr = (LAS float*)(F.lds + F.wave * 16384);
    const float* g2 = KIN(14) + l * D;
    for (int it = gw; it < NE * 768; it += NGW) {
        const int e = it / 768, r = it % 768;
        if (r < 512) { const int up = r >> 8, q = r & 255, kb = q >> 4, nb = q & 15;
            const float* W = (up ? KIN(18) : KIN(17)) + ((size_t)l * NE + e) * (size_t)D * DFF;
            transpose_item(W, DFF, (bf16*)(F.ws + WS_WGU_T) + (size_t)e * 1024 * 1024, 1024, g2, scr, kb, nb, F.lane, MapGU{up});
        } else { const int q = r - 512, kb = q >> 5, nb = q & 31;
            const float* W = KIN(19) + ((size_t)l * NE + e) * (size_t)DFF * D;
            transpose_item(W, D, (bf16*)(F.ws + WS_WDN_T) + (size_t)e * 1024 * 512, 512, nullptr, scr, kb, nb, F.lane, MapPlain{});
        }
    }
}
__device__ __forceinline__ void convert_small_weights(Frame& F, int gw, int NGW) {
    LAS float* scr = (LAS float*)(F.lds + F.wave * 16384);
    for (int it = gw; it < 2 * 3584; it += NGW) {
        const int l = it / 3584; int r = it % 3584;
        if (r < 2560) { const int kb = r / 160, nb = r % 160;
            transpose_item(KIN(3) + (size_t)l * D * NIN, NIN, (bf16*)(F.ws + WS_WIN_T) + (size_t)l * NIN * D, D, KIN(2) + l * D, scr, kb, nb, F.lane, MapIn{}); continue; }
        r -= 2560;
        if (r < 256) { transpose_item(KIN(11) + (size_t)l * 512 * D, D, (bf16*)(F.ws + WS_WBD_T) + (size_t)l * D * 512, 512, nullptr, scr, r >> 5, r & 31, F.lane, MapPlain{}); continue; }
        r -= 256;
        if (r < 256) { transpose_item(KIN(12) + (size_t)l * 512 * D, D, (bf16*)(F.ws + WS_WBS_T) + (size_t)l * D * 512, 512, nullptr, scr, r >> 5, r & 31, F.lane, MapPlain{}); continue; }
        r -= 256;
        transpose_item(KIN(13) + (size_t)l * D * D, D, (bf16*)(F.ws + WS_WOUT_T) + (size_t)l * D * D, D, nullptr, scr, r >> 5, r & 31, F.lane, MapPlain{});
    }
    const int gt = (gw * 64 + F.lane), NT_ = NGW * 64;
    for (int idx = gt; idx < 2 * 48 * 1024; idx += NT_) {
        const int l = idx / (48 * 1024), r = idx % (48 * 1024), n = r >> 10, k = r & 1023; float v = 0.f;
        if (n < 32) v = KIN(16)[((size_t)l * D + k) * 32 + n]; else if (n < 36) v = KIN(15)[((size_t)l * D + k) * 4 + (n - 32)];
        v *= KIN(14)[l * D + k];
        ((bf16*)(F.ws + WS_WR_T))[idx] = (bf16)(cvt_pk_bf16(v, 0.f) & 0xffffu);
    }
}
template <bool ADD, bool WX, bool WB>
__device__ __forceinline__ void rows_phase(Frame& F, const float* xin, float* xout, int gw, int NGW) {
    const bf16* C = (const bf16*)(F.ws + WS_CONTRIB); bf16* XB = (bf16*)(F.ws + WS_XB); float* rstd = (float*)(F.ws + WS_RSTD1);
    for (int m = gw; m < T; m += NGW) {
        const f32x4* xr = (const f32x4*)(xin + (size_t)m * D) + F.lane;
        f32x4 v[4];
#pragma unroll
        for (int j = 0; j < 4; ++j) v[j] = xr[64 * j];
        if (ADD) {
            const u32x2* c0 = (const u32x2*)(C + (size_t)(2 * m) * D) + F.lane; const u32x2* c1 = (const u32x2*)(C + (size_t)(2 * m + 1) * D) + F.lane;
#pragma unroll
            for (int j = 0; j < 4; ++j) { const u32x2 a = c0[64 * j], b = c1[64 * j];
                v[j][0] += bf_lo(a.x) + bf_lo(b.x); v[j][1] += bf_hi(a.x) + bf_hi(b.x); v[j][2] += bf_lo(a.y) + bf_lo(b.y); v[j][3] += bf_hi(a.y) + bf_hi(b.y); }
        }
        if (WX) { f32x4* xo = (f32x4*)(xout + (size_t)m * D) + F.lane;
#pragma unroll
            for (int j = 0; j < 4; ++j) xo[64 * j] = v[j]; }
        if (WB) {
            float s = 0.f;
#pragma unroll
            for (int j = 0; j < 4; ++j) s += (v[j][0] * v[j][0] + v[j][1] * v[j][1]) + (v[j][2] * v[j][2] + v[j][3] * v[j][3]);
            s = wave_sum(s);
            if (F.lane == 0) rstd[m] = 1.0f / sqrtf(s * (1.0f / D) + EPS);
            u32x2* o = (u32x2*)(XB + (size_t)m * D) + F.lane;
#pragma unroll
            for (int j = 0; j < 4; ++j) { u32x2 w; w.x = cvt_pk_bf16(v[j][0], v[j][1]); w.y = cvt_pk_bf16(v[j][2], v[j][3]); o[64 * j] = w; }
        }
    }
}

__device__ __forceinline__ void router_phase(Frame& F, int l) {
    const bf16* XB = (const bf16*)(F.ws + WS_XB); const bf16* WR = (const bf16*)(F.ws + WS_WR_T) + (size_t)l * 48 * 1024;
    int* TOKI = (int*)(F.ws + WS_TOKI); float* TOKW = (float*)(F.ws + WS_TOKW);
    unsigned* gcnt = (unsigned*)(F.ctl + CW_CNT + 64 * l);
    LAS int* lcnt = (LAS int*)(F.lds + MOE_OFF) + 64; LAS int* lbase = lcnt + 32;
    const int fr = F.lane & 15, fq = F.lane >> 4;
    for (int chunk = blockIdx.x; chunk < T / 128; chunk += F.G) {
        if (F.tid < 32) lcnt[F.tid] = 0;
        __syncthreads();
        const int row = chunk * 128 + F.wave * 16 + fr;
        f32x4 a0 = {0.f, 0.f, 0.f, 0.f}, a1 = a0, a2 = a0; float ss = 0.f;
        const bf16* xp = XB + (size_t)row * D + 8 * fq; const bf16* wp = WR + (size_t)fr * D + 8 * fq;
#pragma unroll 4
        for (int kk = 0; kk < 32; ++kk) {
            const u32x4 xa = *(const u32x4*)(xp + 32 * kk);
            const bf16x8 w0 = *(const bf16x8*)(wp + 32 * kk), w1 = *(const bf16x8*)(wp + 16 * D + 32 * kk), w2 = *(const bf16x8*)(wp + 32 * D + 32 * kk);
            { float t0 = bf_lo(xa.x), t1 = bf_hi(xa.x), t2 = bf_lo(xa.y), t3 = bf_hi(xa.y), t4 = bf_lo(xa.z), t5 = bf_hi(xa.z), t6 = bf_lo(xa.w), t7 = bf_hi(xa.w);
              ss += (t0 * t0 + t1 * t1) + (t2 * t2 + t3 * t3) + (t4 * t4 + t5 * t5) + (t6 * t6 + t7 * t7); }
            const bf16x8 xf = __builtin_bit_cast(bf16x8, xa);
            a0 = __builtin_amdgcn_mfma_f32_16x16x32_bf16(w0, xf, a0, 0, 0, 0);
            a1 = __builtin_amdgcn_mfma_f32_16x16x32_bf16(w1, xf, a1, 0, 0, 0);
            a2 = __builtin_amdgcn_mfma_f32_16x16x32_bf16(w2, xf, a2, 0, 0, 0);
        }
        ss += __shfl_xor(ss, 16); ss += __shfl_xor(ss, 32);
        const float rstd = 1.0f / sqrtf(ss * (1.0f / D) + EPS);
        float gl[4];
#pragma unroll
        for (int j = 0; j < 4; ++j) gl[j] = __shfl(a2[j], fr) * rstd;
        int g = 0; float gm = gl[0];
#pragma unroll
        for (int j = 1; j < 4; ++j) if (gl[j] > gm) { gm = gl[j]; g = j; }
        float gs = 0.f;
#pragma unroll
        for (int j = 0; j < 4; ++j) gs += __expf(gl[j] - gm);
        const float pg = 1.0f / gs;
        f32x4 sel = (g >> 1) ? a1 : a0;
        float el[8];
#pragma unroll
        for (int i = 0; i < 8; ++i) { const int src = fr + 16 * (2 * (g & 1) + (i >> 2)); el[i] = __shfl(sel[i & 3], src) * rstd; }
        int i1 = 0; float m1 = el[0];
#pragma unroll
        for (int i = 1; i < 8; ++i) if (el[i] > m1) { m1 = el[i]; i1 = i; }
        int i2 = -1; float m2 = -3.0e38f;
#pragma unroll
        for (int i = 0; i < 8; ++i) if (i != i1 && el[i] > m2) { m2 = el[i]; i2 = i; }
        const float p2 = __expf(m2 - m1); const float w0 = pg / (1.f + p2), w1 = pg * p2 / (1.f + p2);
        const int e0 = 8 * g + i1, e1 = 8 * g + i2;
        int lp0 = 0, lp1 = 0;
        if (fq == 0) { lp0 = __hip_atomic_fetch_add(lcnt + e0, 1, __ATOMIC_RELAXED, __HIP_MEMORY_SCOPE_WORKGROUP); lp1 = __hip_atomic_fetch_add(lcnt + e1, 1, __ATOMIC_RELAXED, __HIP_MEMORY_SCOPE_WORKGROUP); }
        __syncthreads();
        if (F.tid < 32) lbase[F.tid] = (int)__hip_atomic_fetch_add(gcnt + F.tid, (unsigned)lcnt[F.tid], RLX_AGENT);
        __syncthreads();
        if (fq == 0) {
            *(int4*)(TOKI + (size_t)row * 4) = make_int4(e0, e1, lbase[e0] + lp0, lbase[e1] + lp1);
            *(f32x4*)(TOKW + (size_t)row * 4) = (f32x4){w0, w1, rstd, 0.f};
        }
        __syncthreads();
    }
}
__device__ __forceinline__ void build_ust(Frame& F, int l) {
    LAS int* ust = (LAS int*)(F.lds + MOE_OFF); LAS int* cnt = ust + 64;
    if (F.tid == 0) { int acc = 0;
        for (int e = 0; e < 32; ++e) { const int c = (int)__hip_atomic_load((unsigned*)(F.ctl + CW_CNT + 64 * l) + e, RLX_AGENT); cnt[e] = c; ust[e] = acc; acc += (c + 255) >> 8; }
        ust[32] = acc; }
    __syncthreads();
}
__device__ __forceinline__ void scatter_phase(Frame& F, int l, int gw, int NGW) {
    build_ust(F, l);
    const LAS int* ust = (const LAS int*)(F.lds + MOE_OFF); const LAS int* cnt = ust + 64;
    const bf16* XB = (const bf16*)(F.ws + WS_XB); bf16* XS = (bf16*)(F.ws + WS_XS);
    const int* TOKI = (const int*)(F.ws + WS_TOKI); const float* TOKW = (const float*)(F.ws + WS_TOKW);
    int* ent_tok = (int*)(F.ws + WS_ENT_TOK); float* ent_w = (float*)(F.ws + WS_ENT_W); float* ent_rs = (float*)(F.ws + WS_ENT_RS);
    for (int m = gw; m < T; m += NGW) {
        const int4 ti = *(const int4*)(TOKI + (size_t)m * 4); const f32x4 tw = *(const f32x4*)(TOKW + (size_t)m * 4);
        const int p0 = 256 * ust[ti.x] + ti.z, p1 = 256 * ust[ti.y] + ti.w;
        const u32x4* src = (const u32x4*)(XB + (size_t)m * D) + F.lane;
        const u32x4 a = src[0], b = src[64];
        u32x4* d0 = (u32x4*)(XS + (size_t)p0 * D) + F.lane; u32x4* d1 = (u32x4*)(XS + (size_t)p1 * D) + F.lane;
        d0[0] = a; d0[64] = b; d1[0] = a; d1[64] = b;
        if (F.lane == 0) { ent_tok[p0] = 2 * m; ent_tok[p1] = 2 * m + 1; ent_w[p0] = tw[0]; ent_w[p1] = tw[1]; ent_rs[p0] = tw[2]; ent_rs[p1] = tw[2]; }
    }
    const int gt = gw * 64 + F.lane, NT_ = NGW * 64;
    for (int idx = gt; idx < 32 * 256; idx += NT_) { const int e = idx >> 8, p = cnt[e] + (idx & 255);
        if (p < (((cnt[e] + 255) >> 8) << 8)) { const int pr = 256 * ust[e] + p; ent_tok[pr] = -1; ent_w[pr] = 0.f; ent_rs[pr] = 0.f; } }
}

__device__ __forceinline__ int crow(int r, int hi) { return (r & 3) + 8 * (r >> 2) + 4 * hi; }
__device__ __forceinline__ s16x4 vtr(const LAS unsigned char* p) { return __builtin_bit_cast(s16x4, __builtin_amdgcn_ds_read_tr16_b64_v4i16((LAS v4i16_t*)p)); }
__device__ __forceinline__ void glds(const void* g, LAS unsigned char* l) { __builtin_amdgcn_global_load_lds((const unsigned*)g, (LAS unsigned*)l, 16, 0, 0); }
#define PKV(lo, hi4) (bf16x8){lo[0], lo[1], lo[2], lo[3], hi4[0], hi4[1], hi4[2], hi4[3]}

__device__ __forceinline__ void pack_p(const f32x16& p0, const f32x16& p1, bf16x8 (&pa)[4]) {
    u32x4 w0, w1, w2, w3;
    w0.x = cvt_pk_bf16(p0[0], p0[1]); w0.y = cvt_pk_bf16(p0[2], p0[3]); w0.z = cvt_pk_bf16(p0[4], p0[5]); w0.w = cvt_pk_bf16(p0[6], p0[7]);
    w1.x = cvt_pk_bf16(p0[8], p0[9]); w1.y = cvt_pk_bf16(p0[10], p0[11]); w1.z = cvt_pk_bf16(p0[12], p0[13]); w1.w = cvt_pk_bf16(p0[14], p0[15]);
    w2.x = cvt_pk_bf16(p1[0], p1[1]); w2.y = cvt_pk_bf16(p1[2], p1[3]); w2.z = cvt_pk_bf16(p1[4], p1[5]); w2.w = cvt_pk_bf16(p1[6], p1[7]);
    w3.x = cvt_pk_bf16(p1[8], p1[9]); w3.y = cvt_pk_bf16(p1[10], p1[11]); w3.z = cvt_pk_bf16(p1[12], p1[13]); w3.w = cvt_pk_bf16(p1[14], p1[15]);
    pa[0] = __builtin_bit_cast(bf16x8, w0); pa[1] = __builtin_bit_cast(bf16x8, w1); pa[2] = __builtin_bit_cast(bf16x8, w2); pa[3] = __builtin_bit_cast(bf16x8, w3);
}
template <int NDB>
__device__ __forceinline__ void pv_mma(f32x16 (&o)[NDB], const LAS unsigned char* vp, const bf16x8 (&pa)[4]) {
#pragma unroll
    for (int db = 0; db < NDB; ++db) {
        s16x4 lo[4], hi4[4];
#pragma unroll
        for (int ks = 0; ks < 4; ++ks) { lo[ks] = vtr(vp + db * 4096 + ks * 1024); hi4[ks] = vtr(vp + db * 4096 + ks * 1024 + 512); }
#pragma unroll
        for (int ks = 0; ks < 4; ++ks) o[db] = __builtin_amdgcn_mfma_f32_32x32x16_bf16(pa[ks], PKV(lo[ks], hi4[ks]), o[db], 0, 0, 0);
        __builtin_amdgcn_sched_barrier(0);
    }
}
__device__ __forceinline__ void qk_mma(f32x16& p0, f32x16& p1, const LAS unsigned char* Kb, const LAS unsigned char* Qs, int lane, int r32, int hi) {
    const LAS unsigned char* kb = Kb + hi * 1024 + r32 * 16;
#pragma unroll
    for (int d0 = 0; d0 < 4; ++d0) {
        const bf16x8 b0 = *(const LAS bf16x8*)(kb + d0 * 2048), b1 = *(const LAS bf16x8*)(kb + d0 * 2048 + 512), q = *(const LAS bf16x8*)(Qs + d0 * 1024 + lane * 16);
        p0 = __builtin_amdgcn_mfma_f32_32x32x16_bf16(b0, q, p0, 0, 0, 0); p1 = __builtin_amdgcn_mfma_f32_32x32x16_bf16(b1, q, p1, 0, 0, 0);
    }
}

__device__ __forceinline__ void diff_epilogue(Frame& F, f32x16 (&o)[4], LAS float* xch, const float* subg, float lam_init, bf16* Ow);
__device__ __forceinline__ void diff_stream(f32x16 (&o)[4], float& l, const LAS unsigned char* Kb, const LAS unsigned char* Vb, const bf16x8 (&qr)[4], const LAS float* lut,
                                            bool near, float cfar, int qrow, int kmin, int lane, int r32, int hi) {
    f32x16 p0, p1; const float init = near ? 0.f : cfar;
#pragma unroll
    for (int r = 0; r < 16; ++r) { p0[r] = init; p1[r] = init; }
    const LAS unsigned char* kb = Kb + hi * 1024 + r32 * 16;
#pragma unroll
    for (int d0 = 0; d0 < 4; ++d0) {
        const bf16x8 b0 = *(const LAS bf16x8*)(kb + d0 * 2048), b1 = *(const LAS bf16x8*)(kb + d0 * 2048 + 512);
        p0 = __builtin_amdgcn_mfma_f32_32x32x16_bf16(b0, qr[d0], p0, 0, 0, 0); p1 = __builtin_amdgcn_mfma_f32_32x32x16_bf16(b1, qr[d0], p1, 0, 0, 0);
    }
    if (near) {
#pragma unroll
        for (int r = 0; r < 16; ++r) { const int d0 = qrow - (kmin + crow(r, hi)), d1 = d0 - 32;
            const float b0 = lut[min(max(d0, 0), 127)], b1 = lut[min(max(d1, 0), 127)];
            p0[r] = d0 < 0 ? 0.f : fexp2(p0[r] + b0); p1[r] = d1 < 0 ? 0.f : fexp2(p1[r] + b1); }
    } else {
#pragma unroll
        for (int r = 0; r < 16; ++r) { p0[r] = fexp2(p0[r]); p1[r] = fexp2(p1[r]); }
    }
    float s = 0.f;
#pragma unroll
    for (int r = 0; r < 16; ++r) s += p0[r] + p1[r];
    l += s;
    bf16x8 pa[4]; pack_p(p0, p1, pa);
    const LAS unsigned char* vp = Vb + ((lane >> 4) & 1) * 32 + (lane & 3) * 8 + (4 * hi + ((lane & 15) >> 2)) * 64;
    pv_mma<4>(o, vp, pa);
}

__device__ __forceinline__ void diff_unit(Frame& F, int b, int h, int qb, const float* subg, float lam, float lam_init) {
    const int lane = F.lane, r32 = lane & 31, hi = lane >> 5, wid = F.wave, js = wid >> 2, wq = wid & 3;
    bf16* DQ = (bf16*)(F.ws + WS_DQ); const bf16* DK = (const bf16*)(F.ws + WS_DK); const bf16* VA = (const bf16*)(F.ws + WS_VA);
    const long rowbase = (long)b * SEQ; const int q0 = qb * 128, qw = q0 + 32 * wq;
    LAS unsigned char* kv = F.lds;
    LAS float* wsf = (LAS float*)(F.lds + WSF_OFF) + wid * 64; const LAS float* lut = (const LAS float*)(F.lds + LUT_OFF) + h * 128;
    const int NT = (q0 + 128) / 64;
    const bf16* k1src = DK + (rowbase + lane) * 512 + h * 128 + wid * 8;
    const bf16* vsrc0 = VA + (rowbase + 16 * (wid & 3) + (lane >> 2)) * 512 + h * 128 + (wid >> 2) * 32 + (lane & 3) * 8;
#define DIFF_ISSUE(t, bufi) do { LAS unsigned char* bb_ = kv + (bufi) * 32768; const long ro_ = (long)(t) * 64 * 512; \
        glds(k1src + ro_, bb_ + wid * 1024); glds(k1src + ro_ + 64, bb_ + 8192 + wid * 1024); \
        glds(vsrc0 + ro_, bb_ + 16384 + wid * 1024); glds(vsrc0 + ro_ + 64, bb_ + 16384 + (wid + 8) * 1024); } while (0)
    DIFF_ISSUE(0, 0);
    bf16x8 qr[4];
#pragma unroll
    for (int d0 = 0; d0 < 4; ++d0) qr[d0] = *(const bf16x8*)(DQ + (rowbase + qw + r32) * 512 + h * 128 + js * 64 + d0 * 16 + hi * 8);
    f32x16 o[4];
#pragma unroll
    for (int i = 0; i < 4; ++i)
#pragma unroll
        for (int r = 0; r < 16; ++r) o[i][r] = 0.f;
    float l = 0.f;
    const float cfar = lut[127];
    asm volatile("s_waitcnt vmcnt(0) lgkmcnt(0)" ::: "memory"); __syncthreads();
    for (int t = 0; t < NT; ++t) {
        if (t + 1 < NT) DIFF_ISSUE(t + 1, (t + 1) & 1);
        const int kmin = 64 * t;
        if (kmin <= qw + 31) {
            const bool near = (qw - (kmin + 63)) < 113;
            const LAS unsigned char* bb = kv + (t & 1) * 32768;
            diff_stream(o, l, bb + js * 8192, bb + 16384, qr, lut, near, cfar, qw + r32, kmin, lane, r32, hi);
        }
        asm volatile("s_waitcnt vmcnt(0) lgkmcnt(0)" ::: "memory"); __syncthreads();
    }
#undef DIFF_ISSUE
    l += __shfl_xor(l, 32);
    if (hi == 0) wsf[r32] = l;
    LDS_WAIT();
    const float sc = js ? lam : 1.0f;
#pragma unroll
    for (int r = 0; r < 16; ++r) { const float rl = sc / wsf[crow(r, hi)];
#pragma unroll
        for (int db = 0; db < 4; ++db) o[db][r] *= rl; }
    LAS float* xch = (LAS float*)(F.lds + 65536 + wq * 16384);
    if (js) {
#pragma unroll
        for (int db = 0; db < 4; ++db)
#pragma unroll
            for (int r = 0; r < 16; ++r) xch[(db * 16 + r) * 64 + lane] = o[db][r];
    }
    asm volatile("s_waitcnt lgkmcnt(0)" ::: "memory"); __syncthreads();
    if (!js) diff_epilogue(F, o, xch, subg, lam_init, DQ + (rowbase + qw) * 512 + h * 128);
    asm volatile("s_waitcnt lgkmcnt(0)" ::: "memory"); __syncthreads();
}
__device__ __forceinline__ void diff_epilogue(Frame& F, f32x16 (&o)[4], LAS float* xch, const float* subg, float lam_init, bf16* Ow) {
    int lane = F.lane; asm volatile("" : "+v"(lane));
    const int r32 = lane & 31, hi = lane >> 5;
    float ssq[16];
#pragma unroll
    for (int r = 0; r < 16; ++r) { float s = 0.f;
#pragma unroll
        for (int db = 0; db < 4; ++db) { const float v = o[db][r] - xch[(db * 16 + r) * 64 + lane]; o[db][r] = v; s += v * v; }
        ssq[r] = s; }
#pragma unroll
    for (int r = 0; r < 16; ++r) { float s = ssq[r]; s += __shfl_xor(s, 1); s += __shfl_xor(s, 2); s += __shfl_xor(s, 4); s += __shfl_xor(s, 8); s += __shfl_xor(s, 16);
        ssq[r] = (1.0f - lam_init) / sqrtf(s * (1.0f / 128.0f) + EPS); }
    float sg[4];
#pragma unroll
    for (int db = 0; db < 4; ++db) sg[db] = subg[32 * db + r32];
    LDS_WAIT();
    LAS bf16* stl = (LAS bf16*)xch;
#pragma unroll
    for (int r = 0; r < 16; ++r) { const int orow = crow(r, hi);
#pragma unroll
        for (int db = 0; db < 4; ++db) stl[orow * 128 + db * 32 + r32] = (bf16)(cvt_pk_bf16(o[db][r] * ssq[r] * sg[db], 0.f) & 0xffffu); }
    LDS_WAIT();
#pragma unroll
    for (int i = 0; i < 8; ++i) { const int row = i * 4 + (lane >> 4), ch = lane & 15; const u32x4 v = *(const LAS u32x4*)(stl + row * 128 + ch * 8); *(u32x4*)(Ow + (long)row * 512 + ch * 8) = v; }
}

__device__ __forceinline__ void sb_unit(Frame& F, int b, int h, int blk) {
    const int lane = F.lane, r32 = lane & 31, hi = lane >> 5, wid = F.wave;
    bf16* SBQ = (bf16*)(F.ws + WS_SBQ); const bf16* SBK = (const bf16*)(F.ws + WS_SBK); const bf16* SBV = (const bf16*)(F.ws + WS_SBV);
    const long rowbase = (long)b * SEQ; const int qw = 32 * blk; const int qrow = qw + r32;
    LAS unsigned char* kb_ = F.lds + wid * 16384; LAS unsigned char* vb_ = kb_ + 8192;
    bf16x8 qr[4];
#pragma unroll
    for (int d0 = 0; d0 < 4; ++d0) qr[d0] = *(const bf16x8*)(SBQ + (rowbase + qrow) * 512 + h * 64 + d0 * 16 + hi * 8);
    f32x16 o[2];
#pragma unroll
    for (int i = 0; i < 2; ++i)
#pragma unroll
        for (int r = 0; r < 16; ++r) o[i][r] = 0.f;
    float carry = 0.f;
    const bf16* ksrc = SBK + (rowbase + lane) * 512 + h * 64;
    const bf16* vsrc = SBV + (rowbase + (lane >> 2)) * 512 + h * 64 + (lane & 3) * 8;
    const LAS unsigned char* kp = kb_ + hi * 1024 + r32 * 16;
    const LAS unsigned char* vp = vb_ + ((lane >> 4) & 1) * 32 + (lane & 3) * 8 + (4 * hi + ((lane & 15) >> 2)) * 64;
    for (int t = qw >> 6; t >= 0; --t) {
        const int kmin = 64 * t;
        asm volatile("s_waitcnt lgkmcnt(0)" ::: "memory");
#pragma unroll
        for (int c = 0; c < 8; ++c) glds(ksrc + (long)kmin * 512 + c * 8, kb_ + c * 1024);
#pragma unroll
        for (int p = 0; p < 8; ++p) glds(vsrc + (long)(kmin + 16 * (p & 3)) * 512 + (p >> 2) * 32, vb_ + p * 1024);
        asm volatile("s_waitcnt vmcnt(0)" ::: "memory");
        f32x16 p0, p1;
#pragma unroll
        for (int r = 0; r < 16; ++r) { p0[r] = 0.f; p1[r] = 0.f; }
#pragma unroll
        for (int d0 = 0; d0 < 4; ++d0) {
            const bf16x8 b0 = *(const LAS bf16x8*)(kp + d0 * 2048), b1 = *(const LAS bf16x8*)(kp + d0 * 2048 + 512);
            p0 = __builtin_amdgcn_mfma_f32_32x32x16_bf16(b0, qr[d0], p0, 0, 0, 0); p1 = __builtin_amdgcn_mfma_f32_32x32x16_bf16(b1, qr[d0], p1, 0, 0, 0);
        }
        float Lb[8][4], T_own[8], T_oth[8];
#pragma unroll
        for (int i = 0; i < 8; ++i) {
#pragma unroll
            for (int e = 0; e < 4; ++e) { const float y = (i < 4) ? p0[4 * i + e] : p1[4 * (i - 4) + e]; const int key = kmin + 8 * i + 4 * hi + e;
                const float sp = fmaxf(y, 0.f) + flog2(1.f + fexp2(-fabsf(y)));
                Lb[i][e] = (key < qrow) ? sp : 0.f; }
            T_own[i] = (Lb[i][0] + Lb[i][1]) + (Lb[i][2] + Lb[i][3]);
        }
#pragma unroll
        for (int i = 0; i < 8; ++i) T_oth[i] = __shfl_xor(T_own[i], 32);
        float after = carry;
#pragma unroll
        for (int i = 7; i >= 0; --i) {
            const float off = after + (hi == 0 ? T_oth[i] : 0.f);
            after += T_own[i] + T_oth[i];
            float suf = off;
#pragma unroll
            for (int e = 3; e >= 0; --e) { const float y = (i < 4) ? p0[4 * i + e] : p1[4 * (i - 4) + e]; const int key = kmin + 8 * i + 4 * hi + e;
                const float a = (key < qrow) ? fexp2(y - Lb[i][e] - suf) : 0.f; suf += Lb[i][e];
                if (i < 4) p0[4 * i + e] = a; else p1[4 * (i - 4) + e] = a; }
        }
        carry = after;
        bf16x8 pa[4]; pack_p(p0, p1, pa);
        pv_mma<2>(o, vp, pa);
#if SB_EARLY_EXIT
        if (__all(carry > 150.f)) break;
#endif
    }
    asm volatile("s_waitcnt lgkmcnt(0)" ::: "memory");
    LAS bf16* stl = (LAS bf16*)kb_;
#pragma unroll
    for (int r = 0; r < 16; ++r) { const int orow = crow(r, hi);
#pragma unroll
        for (int db = 0; db < 2; ++db) stl[orow * 64 + db * 32 + r32] = (bf16)(cvt_pk_bf16(o[db][r], 0.f) & 0xffffu); }
    LDS_WAIT();
    bf16* Ow = SBQ + (rowbase + qw) * 512 + h * 64;
#pragma unroll
    for (int i = 0; i < 4; ++i) { const int row = i * 8 + (lane >> 3), ch = lane & 7; const u32x4 v = *(const LAS u32x4*)(stl + row * 64 + ch * 8); *(u32x4*)(Ow + (long)row * 512 + ch * 8) = v; }
    asm volatile("s_waitcnt lgkmcnt(0)" ::: "memory");
}

__device__ __forceinline__ int t5_bucket(int n) {
    if (n < 16) return n;
    int b = 16;
    const int thr[15] = {19, 21, 24, 27, 31, 35, 40, 46, 52, 59, 67, 77, 87, 99, 113};
#pragma unroll
    for (int j = 0; j < 15; ++j) b += (n >= thr[j]) ? 1 : 0;
    return b;
}

__device__ __forceinline__ void attention_phase(Frame& F, int l) {
    const float* relb = KIN(1); const float* gq = KIN(4) + l * 64; const float* gk = KIN(5) + l * 64;
    float s1 = 0.f, s2 = 0.f, gqm = 0.f, gkm = 0.f;
    for (int d = 0; d < 64; ++d) { s1 += KIN(6)[l * 64 + d] * KIN(7)[l * 64 + d]; s2 += KIN(8)[l * 64 + d] * KIN(9)[l * 64 + d]; gqm = fmaxf(gqm, fabsf(gq[d])); gkm = fmaxf(gkm, fabsf(gk[d])); }
    const float lam_init = 0.8f - 0.6f * expf(-0.3f * (float)l);
    const float lam = expf(s1) - expf(s2) + lam_init;
    {
        const int h = F.tid >> 7, d = F.tid & 127; float mb = -3.0e38f;
        for (int bkt = 0; bkt < 32; ++bkt) mb = fmaxf(mb, relb[bkt * 4 + h]);
        const float M = 8.f * gqm * gkm + mb;
        ((LAS float*)(F.lds + LUT_OFF))[h * 128 + d] = (relb[t5_bucket(d) * 4 + h] - M) * LOG2E;
    }
    __syncthreads();
    const float* subg = KIN(10) + l * 128;
#ifndef ATT_MASK
#define ATT_MASK 3
#endif
    if (ATT_MASK & 1) for (int i = 0;; ++i) { const long L = (long)i * F.G + blockIdx.x; if (L >= 1024) break;
        const int Lm = (int)(L & 255), bh = Lm >> 3, s = Lm & 7, k = (int)(L >> 8), qb = (k == 0) ? 31 - s : (k == 1) ? 16 + s : (k == 2) ? 15 - s : s;
        diff_unit(F, bh >> 2, bh & 3, qb, subg, lam, lam_init); }
    __syncthreads();
    const int gw = blockIdx.x * NWAVES + F.wave, NGW = F.G * NWAVES;
    if (ATT_MASK & 2) for (int i = 0;; ++i) { const long p = (long)(i >> 1) * NGW + gw; if (p >= 4096) break;
        const int bh = (int)(p >> 6), x = (int)(p & 63), blk = (i & 1) ? 127 - x : x;
        sb_unit(F, bh >> 3, bh & 7, blk); }
    __syncthreads();
}

constexpr int NPHASE = 1 + 9 * DEPTH;
__global__ void __launch_bounds__(NWAVES * 64, 2) mk_fwd(Args args) {
    extern __shared__ __attribute__((aligned(16))) unsigned char lds_raw[];
    Frame F;
    F.lds = (LAS unsigned char*)lds_raw;
    F.MISC = (volatile LAS unsigned*)(F.lds + MISC_OFF);
    F.tid = threadIdx.x; F.lane = F.tid & 63; F.wave = __builtin_amdgcn_readfirstlane(F.tid >> 6); F.G = gridDim.x;
    F.ws = args.ws; F.ctl = (gu32*)(args.ws + WS_CTL); F.out = args.out;
    for (int u = F.tid; u < (LDS_BYTES - LDSCTL_OFF) / 4; u += NWAVES * 64) ((LAS unsigned*)(F.lds + LDSCTL_OFF))[u] = 0u;
    __syncthreads();
    XcdBarrier bar; bar.bar = (unsigned*)(F.ctl + CW_BAR); bar.x = 0; bar.st = nullptr;
    if (!MK_SPLIT) bar = xcd_barrier_post((unsigned*)(F.ctl + CW_BAR), F.MISC + 8);
    const int lo = args.ph_lo, hi = args.ph_hi;
#define IN(k) (lo <= (k) && (k) < hi)
#define SEAM(k) do { if (IN(k) && IN((k) + 1)) xcd_barrier(bar); } while (0)
#define REFRESH() int gw, NGW, c; do { int t_ = threadIdx.x; asm volatile("" : "+v"(t_)); F.tid = t_; F.lane = t_ & 63; F.wave = __builtin_amdgcn_readfirstlane(t_ >> 6); \
        gw = blockIdx.x * NWAVES + F.wave; NGW = F.G * NWAVES; c = (int)blockIdx.x; (void)gw; (void)NGW; (void)c; } while (0)

    if (PH_ON(0) && IN(0)) { REFRESH();
        convert_small_weights(F, gw, NGW);
        convert_moe_weights(F, 0, gw, NGW);
        rows_phase<false, false, true>(F, KIN(0), nullptr, gw, NGW);
    }
    SEAM(0);
#pragma nounroll
    for (int l = 0; l < DEPTH; ++l) {
        const int pb = 1 + 9 * l;
        if (PH_ON(1) && IN(pb + 0)) {   REFRESH();
            SchedPlain S{(const char*)(F.ws + WS_XB), (const char*)(F.ws + WS_WIN_T) + (size_t)l * NIN * D * 2, 128, 20, D, F.G, c};
            EpiInProj E{F.ws, KIN(4) + l * 64, KIN(5) + l * 64};
            pg8::gemm_phase<EpiInProj, SchedPlain>(F.lds, D, S, E);
        }
        SEAM(pb + 0);
        if (PH_ON(2) && IN(pb + 1)) { REFRESH(); attention_phase(F, l); }
        SEAM(pb + 1);
        if (PH_ON(3) && IN(pb + 2)) {   REFRESH();
            SchedBranch S{(const char*)(F.ws + WS_DQ), (const char*)(F.ws + WS_SBQ), (const char*)(F.ws + WS_WBD_T) + (size_t)l * D * 512 * 2, (const char*)(F.ws + WS_WBS_T) + (size_t)l * D * 512 * 2, F.G, c};
            EpiBranch E{(const bf16*)(F.ws + WS_G1), (const bf16*)(F.ws + WS_G2), (bf16*)(F.ws + WS_MIXED)};
            pg8::gemm_phase<EpiBranch, SchedBranch>(F.lds, 512, S, E);
        }
        SEAM(pb + 2);
        if (PH_ON(4) && IN(pb + 3)) {   REFRESH();
            SchedPlain S{(const char*)(F.ws + WS_MIXED), (const char*)(F.ws + WS_WOUT_T) + (size_t)l * D * D * 2, 128, 4, D, F.G, c};
            EpiOutProj E{l == 0 ? KIN(0) : (const float*)F.out, F.out, (bf16*)(F.ws + WS_XB)};
            pg8::gemm_phase<EpiOutProj, SchedPlain>(F.lds, D, S, E);
        }
        SEAM(pb + 3);
        if (PH_ON(5) && IN(pb + 4)) { REFRESH(); router_phase(F, l); }
        SEAM(pb + 4);
        if (PH_ON(6) && IN(pb + 5)) { REFRESH(); scatter_phase(F, l, gw, NGW); }
        SEAM(pb + 5);
        if (PH_ON(7) && IN(pb + 6)) {   REFRESH();
            build_ust(F, l);
            SchedMoe S{(const char*)(F.ws + WS_XS), (const char*)(F.ws + WS_WGU_T), (const LAS int*)(F.lds + MOE_OFF), D, (size_t)1024 * 1024 * 2, F.G, c};
            EpiMoe1 E{(const float*)(F.ws + WS_ENT_RS), (bf16*)(F.ws + WS_ACT)};
            pg8::gemm_phase<EpiMoe1, SchedMoe>(F.lds, D, S, E);
        }
        SEAM(pb + 6);
        if (PH_ON(8) && IN(pb + 7)) {   REFRESH();
            build_ust(F, l);
            SchedMoe S{(const char*)(F.ws + WS_ACT), (const char*)(F.ws + WS_WDN_T), (const LAS int*)(F.lds + MOE_OFF), DFF, (size_t)1024 * 512 * 2, F.G, c};
            EpiMoe2 E{(const int*)(F.ws + WS_ENT_TOK), (const float*)(F.ws + WS_ENT_W), (bf16*)(F.ws + WS_CONTRIB)};
            pg8::gemm_phase<EpiMoe2, SchedMoe>(F.lds, DFF, S, E);
        }
        SEAM(pb + 7);
        if (PH_ON(9) && IN(pb + 8)) {   REFRESH();
            if (l + 1 < DEPTH) { rows_phase<true, true, true>(F, F.out, F.out, gw, NGW); convert_moe_weights(F, l + 1, gw, NGW); }
            else rows_phase<true, true, false>(F, F.out, F.out, gw, NGW);
        }
        if (l + 1 < DEPTH) SEAM(pb + 8);
    }
#undef IN
#undef SEAM
}

extern "C" void kernel_launch(void* const* d_in, const int* in_sizes, int n_in, void* d_out, int out_size, void* d_ws, size_t ws_size, hipStream_t stream) {
    static int grid = 0;
    if (grid == 0) {
        if (n_in != 20 || in_sizes[0] != T * D || out_size != T * D || ws_size < WS_END) { fprintf(stderr, "kernel_launch: unexpected shapes / workspace (n_in %d, ws %zu, need %zu)\n", n_in, ws_size, (size_t)WS_END); grid = -1; return; }
        int dev = 0, cus = 0, per_cu = 0;
        if (hipGetDevice(&dev) != hipSuccess || hipDeviceGetAttribute(&cus, hipDeviceAttributeMultiprocessorCount, dev) != hipSuccess) { grid = -1; return; }
        if (hipFuncSetAttribute((const void*)mk_fwd, hipFuncAttributeMaxDynamicSharedMemorySize, LDS_BYTES) != hipSuccess) { fprintf(stderr, "kernel_launch: hipFuncSetAttribute failed\n"); grid = -1; return; }
        if (hipOccupancyMaxActiveBlocksPerMultiprocessor(&per_cu, (const void*)mk_fwd, NWAVES * 64, LDS_BYTES) != hipSuccess || per_cu < 1) fprintf(stderr, "kernel_launch: occupancy query reports %d\n", per_cu);
        (void)hipGetLastError();
        grid = cus;
    }
    if (grid < 0) return;
    if (hipMemsetAsync((char*)d_ws + WS_CTL, 0, CTL_ZERO_BYTES, stream) != hipSuccess) return;
    Args a{};
    for (int i = 0; i < 20; ++i) a.in[i] = (const float*)d_in[i];
    a.out = (float*)d_out; a.ws = (unsigned char*)d_ws;
#if MK_SPLIT
    for (int p = 0; p < NPHASE; ++p) { a.ph_lo = p; a.ph_hi = p + 1; hipLaunchKernelGGL(mk_fwd, dim3(grid), dim3(NWAVES * 64), LDS_BYTES, stream, a); }
#else
    a.ph_lo = 0; a.ph_hi = NPHASE;
    hipLaunchKernelGGL(mk_fwd, dim3(grid), dim3(NWAVES * 64), LDS_BYTES, stream, a);
#endif
}
```

```cpp
#include <hip/hip_runtime.h>
#include <cstdio>
#include <cstdint>

#define GAS __attribute__((address_space(1)))
#define LAS __attribute__((address_space(3)))
typedef unsigned short bf16;
typedef short bf16x8 __attribute__((ext_vector_type(8)));
typedef short s16x4 __attribute__((ext_vector_type(4)));
typedef short v4i16_t __attribute__((ext_vector_type(4)));
typedef float f32x2 __attribute__((ext_vector_type(2)));
typedef float f32x4 __attribute__((ext_vector_type(4)));
typedef float f32x16 __attribute__((ext_vector_type(16)));
typedef unsigned u32x2 __attribute__((ext_vector_type(2)));
typedef unsigned u32x4 __attribute__((ext_vector_type(4)));
typedef int v4i_t __attribute__((ext_vector_type(4)));
typedef GAS unsigned gu32;

constexpr int T = 32768, SEQ = 4096, NB = 8, D = 1024, NIN = 5120, DEPTH = 2;
constexpr int NE = 32, DFF = 512;
constexpr float EPS = 1e-6f;
constexpr float LOG2E = 1.4426950408889634f;
constexpr float C2 = 0.125f * LOG2E;
constexpr int NWAVES = 8;
#ifndef SB_EARLY_EXIT
#define SB_EARLY_EXIT 1
#endif
#ifndef MK_SPLIT
#define MK_SPLIT 0
#endif
#ifndef PH_MASK
#define PH_MASK 0x3ff
#endif
#define PH_ON(k) (((PH_MASK) >> (k)) & 1)
#ifndef PROBE_TYPE
#define PROBE_TYPE -1
#endif
#define PROBE_AMP 8
#define PB_START(k) do { if (PROBE_TYPE == (k)) F.pb_t0 = __builtin_amdgcn_s_memrealtime(); } while (0)
#define PB_END(k) do { if (PROBE_TYPE == (k)) F.pb_acc += __builtin_amdgcn_s_memrealtime() - F.pb_t0; } while (0)

constexpr size_t MiB = 1u << 20;
constexpr size_t WS_CTL = 0, CTL_ZERO_BYTES = 1 * MiB;
constexpr size_t WS_RSTD1 = 1 * MiB;
constexpr size_t WS_IDENT = 2 * MiB;
constexpr size_t WS_WR_T = 5 * MiB;
constexpr size_t WS_WIN_T = 8 * MiB;
constexpr size_t WS_WBD_T = 28 * MiB;
constexpr size_t WS_WBS_T = 30 * MiB;
constexpr size_t WS_WOUT_T = 32 * MiB;
constexpr size_t WS_WGU_T = 36 * MiB;
constexpr size_t WS_WDN_T = 100 * MiB;
constexpr size_t WS_XB = 132 * MiB;
constexpr size_t WS_R0 = 196 * MiB;
constexpr size_t WS_DQ = WS_R0;
constexpr size_t WS_DK = WS_R0 + 32 * MiB;
constexpr size_t WS_VA = WS_R0 + 64 * MiB;
constexpr size_t WS_SBQ = WS_R0 + 96 * MiB;
constexpr size_t WS_SBK = WS_R0 + 128 * MiB;
constexpr size_t WS_SBV = WS_R0 + 160 * MiB;
constexpr size_t WS_G1 = WS_R0 + 192 * MiB;
constexpr size_t WS_MIXED = WS_G1;
constexpr int PMAX = 65536 + 32 * 256;
constexpr size_t WS_ACT = WS_SBK;
constexpr size_t WS_XB8 = WS_DK;
constexpr float W8_SCALE = 64.f, A8_SCALE = 2.f, C8_SCALE = 32.f;
constexpr size_t WS_CONTRIB = WS_G1;
constexpr int ECAP = 32768;
constexpr size_t WS_ENT_TOK = 68 * MiB;
constexpr size_t WS_ENT_W = 72 * MiB;
constexpr size_t WS_ENT_RS = 76 * MiB;
constexpr size_t WS_END = WS_R0 + 256 * MiB;

constexpr int CW_BAR = 4096;
constexpr int CW_LBAR = 20480;
constexpr int CW_XRANK = 12288;
constexpr int CW_CNT = 16384;
constexpr int CW_SBQ = 24576;

constexpr int RING_BYTES = 131072;
constexpr int LDSCTL_OFF = RING_BYTES, MISC_OFF = LDSCTL_OFF + 320;
constexpr int LUT_OFF = LDSCTL_OFF + 512;
constexpr int WSF_OFF = LDSCTL_OFF + 2560;
constexpr int MOE_OFF = LDSCTL_OFF + 4608;
constexpr int AUX_OFF = LDSCTL_OFF + 7680;
constexpr int IDT_OFF = LDSCTL_OFF + 5632;
constexpr int LDS_BYTES = 147456;

#define RLX_AGENT __ATOMIC_RELAXED, __HIP_MEMORY_SCOPE_AGENT
#define LDS_WAIT() asm volatile("s_waitcnt lgkmcnt(0)" ::: "memory")
#define VM_WAIT() asm volatile("s_waitcnt vmcnt(0)" ::: "memory")
__device__ __forceinline__ unsigned cvt_pk_bf16(float lo, float hi) { unsigned r; asm volatile("v_cvt_pk_bf16_f32 %0, %1, %2" : "=v"(r) : "v"(lo), "v"(hi)); return r; }
__device__ __forceinline__ float bf_lo(unsigned w) { return __uint_as_float(w << 16); }
__device__ __forceinline__ float bf_hi(unsigned w) { return __uint_as_float(w & 0xffff0000u); }
__device__ __forceinline__ float wave_sum(float v) {
#pragma unroll
    for (int o = 1; o < 64; o <<= 1) v += __shfl_xor(v, o);
    return v;
}
__device__ __forceinline__ u32x2 pack8_fp8(const float (&a)[8]) {
    int w0 = 0, w1 = 0;
    w0 = __builtin_amdgcn_cvt_pk_fp8_f32(a[0], a[1], w0, false); w0 = __builtin_amdgcn_cvt_pk_fp8_f32(a[2], a[3], w0, true);
    w1 = __builtin_amdgcn_cvt_pk_fp8_f32(a[4], a[5], w1, false); w1 = __builtin_amdgcn_cvt_pk_fp8_f32(a[6], a[7], w1, true);
    u32x2 r; r.x = (unsigned)w0; r.y = (unsigned)w1; return r;
}
__device__ __forceinline__ float fexp2(float x) { return __builtin_amdgcn_exp2f(x); }
__device__ __forceinline__ float flog2(float x) { return __builtin_amdgcn_logf(x); }

#define XB_TMO      128
#define XB_XCNT(j)  (256  + 64 * (j))
#define XB_XSUB(j)  (1280 + 64 * (j))
#define XB_XGEN(j)  (2304 + 64 * (j))
#define XB_TOP      3328
#define XB_TOPGEN   3392
#define XCD_BAR_WORDS 3456
#define XB_SPIN_CAP (1u << 23)
__device__ __forceinline__ unsigned xb_ld(unsigned* p)              { return __hip_atomic_load(p, __ATOMIC_RELAXED, __HIP_MEMORY_SCOPE_AGENT); }
__device__ __forceinline__ unsigned xb_add(unsigned* p, unsigned v) { return __hip_atomic_fetch_add(p, v, __ATOMIC_RELAXED, __HIP_MEMORY_SCOPE_AGENT); }
__device__ __forceinline__ unsigned xb_xcc_id() { return (unsigned)__builtin_amdgcn_s_getreg((3 << 11) | 20) & 0xFu; }
#define XB_SPIN(cond, bar) do { unsigned _sp = 0; while (cond) { __builtin_amdgcn_s_sleep(1); \
    if ((++_sp & 255u) == 0u) { if (xb_ld(&(bar)[XB_TMO])) break; if (_sp > XB_SPIN_CAP) { atomicAdd(&(bar)[XB_TMO], 1u); break; } } } } while (0)
struct XcdBarrier { unsigned* bar; unsigned x; volatile LAS unsigned* st; };
__device__ __forceinline__ XcdBarrier xcd_barrier_post(unsigned* bar, volatile LAS unsigned* st) {
    XcdBarrier b; b.bar = bar; b.x = xb_xcc_id(); b.st = st;
    if (threadIdx.x == 0) (void)xb_add(&bar[XB_XCNT(b.x)], 1u);
    return b;
}
__device__ __forceinline__ void xcd_barrier_complete(unsigned* bar, unsigned x, unsigned& nloc, unsigned& nx) {
    const unsigned G = gridDim.x * gridDim.y * gridDim.z;
    unsigned sum, cnt, mine, sp = 0u;
    for (;;) {
        sum = 0u; cnt = 0u; mine = 0u;
#pragma unroll
        for (unsigned j = 0; j < 16; ++j) { const unsigned c = xb_ld(&bar[XB_XCNT(j)]); sum += c; cnt += (c > 0u) ? 1u : 0u; mine = (j == x) ? c : mine; }
        if (sum == G) break;
        __builtin_amdgcn_s_sleep(1);
        if ((++sp & 255u) == 0u) { if (xb_ld(&bar[XB_TMO])) break; if (sp > XB_SPIN_CAP) { atomicAdd(&bar[XB_TMO], 1u); break; } }
    }
    nloc = mine > 0u ? mine : 1u; nx = cnt > 0u ? cnt : 1u;
}
__device__ __forceinline__ void xcd_barrier(const XcdBarrier& b) {
    asm volatile("s_waitcnt vmcnt(0)" ::: "memory");
    __syncthreads();
    if (threadIdx.x == 0) {
        unsigned* bar = b.bar;
        __builtin_amdgcn_s_waitcnt(0);
        unsigned nloc = b.st[0], nx = b.st[1];
        if (nloc == 0u) { xcd_barrier_complete(bar, b.x, nloc, nx); b.st[0] = nloc; b.st[1] = nx; }
        const unsigned old = xb_add(&bar[XB_XSUB(b.x)], 1u);
        const unsigned gen = old / nloc;
        if (old + 1u == (gen + 1u) * nloc) {
            __builtin_amdgcn_fence(__ATOMIC_RELEASE, "agent");
            asm volatile("s_waitcnt vmcnt(0)" ::: "memory");
            const unsigned og = xb_add(&bar[XB_TOP], 1u);
            const unsigned tg = og / nx;
            if (og + 1u == (tg + 1u) * nx) xb_add(&bar[XB_TOPGEN], 1u);
            else XB_SPIN(xb_ld(&bar[XB_TOPGEN]) == tg, bar);
            __builtin_amdgcn_fence(__ATOMIC_ACQUIRE, "agent");
            xb_add(&bar[XB_XGEN(b.x)], 1u);
            asm volatile("s_waitcnt vmcnt(0)" ::: "memory");
        } else {
            XB_SPIN(xb_ld(&bar[XB_XGEN(b.x)]) == gen, bar);
            __builtin_amdgcn_fence(__ATOMIC_ACQUIRE, "agent");
            asm volatile("s_waitcnt vmcnt(0)" ::: "memory");
        }
    }
    __syncthreads();
}

__device__ __forceinline__ void xcc_barrier(unsigned* lb, unsigned x, unsigned nloc, unsigned* tmo) {
    asm volatile("s_waitcnt vmcnt(0)" ::: "memory");
    __syncthreads();
    if (threadIdx.x == 0) {
        const unsigned old = xb_add(&lb[64 * x], 1u), gen = old / nloc;
        if (old + 1u == (gen + 1u) * nloc) xb_add(&lb[1024 + 64 * x], 1u);
        else { unsigned sp = 0; while (xb_ld(&lb[1024 + 64 * x]) == gen) { __builtin_amdgcn_s_sleep(1);
                   if ((++sp & 255u) == 0u) { if (xb_ld(tmo)) break; if (sp > XB_SPIN_CAP) { atomicAdd(tmo, 1u); break; } } } }
        __builtin_amdgcn_fence(__ATOMIC_ACQUIRE, "agent");
        asm volatile("s_waitcnt vmcnt(0)" ::: "memory");
    }
    __syncthreads();
}

namespace pg8 {
constexpr int BM = 256, BK = 64, HALF = 128, HTB = HALF * BK * 2, STAGE_BYTES = 8 * HTB, NXCD = 8, WGM = 8;
__host__ __device__ __forceinline__ int lds_byte(int r, int c) { const int st = (r >> 4) * 2 + (c >> 5), rr = r & 15, cc = c & 31, ob = rr * 64 + cc * 2; return st * 1024 + (ob ^ (((ob >> 9) & 1) << 5)); }
__host__ __device__ __forceinline__ void stage_rc(int b, int& R, int& C) { const int st = b / 1024, sb = b % 1024, swz = sb ^ (((sb >> 9) & 1) << 5); R = (st >> 1) * 16 + swz / 64; C = (st & 1) * 32 + (swz % 64) / 2; }
__host__ __device__ __forceinline__ int perm32(int rho) { const int n = rho >> 4, i = rho & 15; return 8 * (i >> 2) + 4 * n + (i & 3); }

struct Unit { const char* A; const char* B; int pm, pn, kind, eoff, nvalid, goff, gnv, slot; };
constexpr int KEEP = 0x100;

__device__ __forceinline__ void tile_order(int L, int nM, int nN, int& pm, int& pn) {
    const int nwg = nM * nN; int wgid = L;
    { const int q = nwg / NXCD, r = nwg % NXCD, xcd = wgid % NXCD, off = wgid / NXCD; wgid = (xcd < r ? xcd * (q + 1) : r * (q + 1) + (xcd - r) * q) + off; }
    const int nig = WGM * nN, gid = wgid / nig, fm = gid * WGM, gsz = (nM - fm) < WGM ? (nM - fm) : WGM;
    pm = fm + ((wgid % nig) % gsz); pn = (wgid % nig) / gsz;
}

template <class Epi, class Sched, bool ALIGN_EPI = true, bool SP2 = true>
__device__ __forceinline__ void gemm_phase(LAS unsigned char* lds, const int K_, const Sched& S, const Epi& E, unsigned long long* pb = nullptr) {
    int tid_ = threadIdx.x; asm volatile("" : "+v"(tid_));
    const int tid = tid_, wid = __builtin_amdgcn_readfirstlane(tid >> 6), lane = tid & 63, wr = wid >> 2, wc = wid & 3, fr = lane & 15, fq = lane >> 4;
    int K = K_; asm volatile("" : "+s"(K));
    const int nt = K / BK;
    unsigned voffA[2], voffB[2]; int gR[2]; unsigned gC[2];
#pragma unroll
    for (int i = 0; i < 2; ++i) { int R, C; stage_rc(tid * 16 + i * 8192, R, C); const int Rb = Epi::PERM ? ((R & ~31) + perm32(R & 31)) : R;
        voffA[i] = (unsigned)(R * K + C) * 2u; voffB[i] = (unsigned)(Rb * K + C) * 2u; gR[i] = R; gC[i] = (unsigned)C * 2u; }
    unsigned voffG[2][2]; (void)gR; (void)gC;
    LAS int* idtab = (LAS int*)(lds + STAGE_BYTES + (IDT_OFF - RING_BYTES));
#define PG8_IDS_DMA(u_, slot) do { if (wid < 4) { int t_ = tid; asm volatile("" : "+v"(t_));   \
        __builtin_amdgcn_global_load_lds((const unsigned*)(S.ids + (u_).goff + t_), (LAS unsigned*)(idtab + (slot) * 256 + wid * 64), 4, 0, 0); } } while (0)
    LAS int* auxt = (LAS int*)(lds + STAGE_BYTES + (AUX_OFF - RING_BYTES));
#define PG8_AUX_DMA(u_) do { if (wid < 4) { int t_ = tid; asm volatile("" : "+v"(t_)); \
        if (S.aux0) __builtin_amdgcn_global_load_lds((const unsigned*)(S.aux0 + (u_).eoff + t_), (LAS unsigned*)(auxt + (u_).slot * 256 + wid * 64), 4, 0, 0); \
        if (S.aux1) __builtin_amdgcn_global_load_lds((const unsigned*)(S.aux1 + (u_).eoff + t_), (LAS unsigned*)(auxt + 768 + (u_).slot * 256 + wid * 64), 4, 0, 0); } } while (0)
#define PG8_IDS_READ(u_, slot) do { _Pragma("unroll") for (int i_ = 0; i_ < 2; ++i_) { int g_ = gR[i_]; asm volatile("" : "+v"(g_)); _Pragma("unroll") for (int h_ = 0; h_ < 2; ++h_) { const int r_ = h_ * 128 + g_; int id_ = idtab[(slot) * 256 + r_]; \
        id_ = (r_ < (u_).gnv) ? (id_ >> 1) : 0; voffG[h_][i_] = (unsigned)id_ * (unsigned)(K * 2) + gC[i_]; } } } while (0)
#define PG8_STAGE_A(buf, h, gbase) do { if constexpr (Sched::GATHER) { PG8_STAGE(PG8_SA(buf, h), gbase, voffG[h]); } else { PG8_STAGE(PG8_SA(buf, h), (gbase) + (h) * hstep, voffA); } } while (0)
    const size_t kstep = (size_t)(BK * 2);
    const size_t hstep = (size_t)HALF * K * 2;
    const unsigned ldsw = (unsigned)wid * 1024u;
    constexpr bool F8 = Sched::FP8;
    const int aoff = lds_byte(wr * 64 + fr, fq * 8), boff = lds_byte(wc * 32 + fr, fq * 8);
    constexpr int KSTEP = 1024;
#define PG8_SA(b, h) (((b) * 2 + (h)) * HTB)
#define PG8_SB(b, h) ((4 + (b) * 2 + (h)) * HTB)
#define PG8_STAGE(bufoff, gbase, voff) do { _Pragma("unroll") for (int _i = 0; _i < 2; ++_i) \
        __builtin_amdgcn_global_load_lds((const unsigned*)((const char*)(gbase) + (voff)[_i]), (LAS unsigned*)(lds + (bufoff) + ldsw + _i * 8192), 16, 0, 0); } while (0)
#define PG8_LDA(dst, b, h) do { _Pragma("unroll") for (int m = 0; m < 4; ++m) _Pragma("unroll") for (int k = 0; k < 2; ++k) dst[m][k] = *(const LAS bf16x8*)(lds + PG8_SA(b, h) + aoff + m * 2048 + k * KSTEP); } while (0)
#define PG8_LDB(dst, b, h) do { _Pragma("unroll") for (int n = 0; n < 2; ++n) _Pragma("unroll") for (int k = 0; k < 2; ++k) dst[n][k] = *(const LAS bf16x8*)(lds + PG8_SB(b, h) + boff + n * 2048 + k * KSTEP); } while (0)
#define PG8_CAT(x) __builtin_shufflevector(__builtin_bit_cast(v4i_t, (x)[0]), __builtin_bit_cast(v4i_t, (x)[1]), 0, 1, 2, 3, 4, 5, 6, 7)
#define PG8_MMA(ai, bj, At, Bt) do { __builtin_amdgcn_s_setprio(1); if constexpr (F8) { _Pragma("unroll") for (int m = 0; m < 4; ++m) _Pragma("unroll") for (int n = 0; n < 2; ++n) \
        acc[ai][bj][m][n] = __builtin_amdgcn_mfma_scale_f32_16x16x128_f8f6f4(PG8_CAT(Bt[n]), PG8_CAT(At[m]), acc[ai][bj][m][n], 0, 0, 0, 0x7f7f7f7f, 0, 0x7f7f7f7f); } else { \
        _Pragma("unroll") for (int m = 0; m < 4; ++m) _Pragma("unroll") for (int n = 0; n < 2; ++n) _Pragma("unroll") for (int k = 0; k < 2; ++k) \
        acc[ai][bj][m][n] = __builtin_amdgcn_mfma_f32_16x16x32_bf16(Bt[n][k], At[m][k], acc[ai][bj][m][n], 0, 0, 0); } __builtin_amdgcn_s_setprio(0); } while (0)
#define PG8_WAIT_V(n) asm volatile("s_waitcnt vmcnt(" #n ")" ::: "memory")
#define PG8_WAIT_L(n) asm volatile("s_waitcnt lgkmcnt(" #n ")" ::: "memory")
#define PG8_BAR __builtin_amdgcn_s_barrier()
#define PG8_SCHED __builtin_amdgcn_sched_barrier(0)
    Unit cur, nxt; int ui = 0;
    if (!S.next(0, cur)) return;
    f32x4 acc[2][2][4][2];
#pragma unroll
    for (int a = 0; a < 2; ++a)
#pragma unroll
        for (int b = 0; b < 2; ++b)
#pragma unroll
            for (int m = 0; m < 4; ++m)
#pragma unroll
                for (int n = 0; n < 2; ++n) acc[a][b][m][n] = (f32x4){0.f, 0.f, 0.f, 0.f};
    bf16x8 At[4][2], B0[2][2], B1[2][2];
    const char* cA = cur.A; const char* cB = cur.B;
    static_assert(SP2, "only the SP2 loop is kept here");
    cur.slot = 0;
    if constexpr (Sched::GATHER) { PG8_IDS_DMA(cur, 0); PG8_AUX_DMA(cur); PG8_WAIT_V(0); __syncthreads(); PG8_IDS_READ(cur, 0); }
    else if (S.aux0) { PG8_AUX_DMA(cur); PG8_WAIT_V(0); __syncthreads(); }
    PG8_STAGE(PG8_SB(0, 0), cB, voffB); PG8_STAGE(PG8_SB(0, 1), cB + hstep, voffB); PG8_STAGE_A(0, 0, cA); PG8_STAGE_A(0, 1, cA);
    if (wr == 1) PG8_BAR;
    PG8_WAIT_V(2); PG8_BAR;
    PG8_STAGE(PG8_SB(1, 0), cB + kstep, voffB); PG8_STAGE_A(1, 0, cA + kstep); PG8_STAGE(PG8_SB(1, 1), cB + hstep + kstep, voffB);
    PG8_WAIT_V(6); PG8_BAR;
    for (;;) {
        const bool has_next = S.next(ui + 1, nxt);
        const char* nA = has_next ? nxt.A : cA; const char* nB = has_next ? nxt.B : cB;
        nxt.slot = (cur.slot == 2) ? 0 : cur.slot + 1;
        if constexpr (Sched::GATHER) { if (has_next) { PG8_IDS_DMA(nxt, (ui + 1) & 1); PG8_AUX_DMA(nxt); } }
        else { if (has_next && S.aux0) PG8_AUX_DMA(nxt); }
#pragma nounroll
        for (int t = 0; t < nt; t += 2) {
            unsigned long long pbt = 0; if (pb && (PROBE_TYPE == 21 || PROBE_TYPE == 22)) pbt = __builtin_amdgcn_s_memrealtime();
            const bool last = (t == nt - 2);
            const char* a1 = cA + (size_t)(t + 1) * kstep;
            const char* a2 = last ? nA : cA + (size_t)(t + 2) * kstep; const char* b2 = last ? nB : cB + (size_t)(t + 2) * kstep;
            const char* a3 = a2 + kstep; const char* b3 = b2 + kstep;
            PG8_LDB(B0, 0, 0); PG8_LDB(B1, 0, 1); PG8_SCHED; PG8_LDA(At, 0, 0); PG8_STAGE_A(1, 1, a1);
            if constexpr (Sched::GATHER) { if (last && has_next) PG8_IDS_READ(nxt, (ui + 1) & 1); }
            PG8_WAIT_V(8); PG8_WAIT_L(0); PG8_BAR; PG8_MMA(0, 0, At, B0); PG8_MMA(0, 1, At, B1); PG8_BAR; PG8_SCHED;
            PG8_LDA(At, 0, 1); PG8_STAGE(PG8_SB(0, 0), b2, voffB); PG8_STAGE(PG8_SB(0, 1), b2 + hstep, voffB); PG8_STAGE_A(0, 0, a2);
            PG8_WAIT_V(8); PG8_WAIT_L(0); PG8_BAR; PG8_MMA(1, 0, At, B0); PG8_MMA(1, 1, At, B1); PG8_BAR; PG8_SCHED;
            PG8_LDB(B0, 1, 0); PG8_LDB(B1, 1, 1); PG8_SCHED; PG8_LDA(At, 1, 0); PG8_STAGE_A(0, 1, a2);
            PG8_WAIT_V(8); PG8_WAIT_L(0); PG8_BAR; PG8_MMA(0, 0, At, B0); PG8_MMA(0, 1, At, B1); PG8_BAR; PG8_SCHED;
            PG8_LDA(At, 1, 1); PG8_STAGE(PG8_SB(1, 0), b3, voffB); PG8_STAGE(PG8_SB(1, 1), b3 + hstep, voffB); PG8_STAGE_A(1, 0, a3);
            PG8_WAIT_V(8); PG8_WAIT_L(0); PG8_BAR; PG8_MMA(1, 0, At, B0); PG8_MMA(1, 1, At, B1); PG8_BAR; PG8_SCHED;
            if (pb && ((PROBE_TYPE == 21 && t == 0) || (PROBE_TYPE == 22 && t != 0))) *pb += __builtin_amdgcn_s_memrealtime() - pbt;
        }
        unsigned long long pbe = 0; if (pb && PROBE_TYPE == 20) pbe = __builtin_amdgcn_s_memrealtime();
        if constexpr (ALIGN_EPI) { if (wr == 0) PG8_BAR; }
        { unsigned z_ = 0u; asm volatile("" : "+v"(z_));
          const int l_ = (int)__builtin_amdgcn_mbcnt_hi(~0u, __builtin_amdgcn_mbcnt_lo(~0u, z_));
          E(acc, cur, wr, wc, l_ & 15, l_ >> 4); }
        if (pb && PROBE_TYPE == 20) *pb += __builtin_amdgcn_s_memrealtime() - pbe;
        if (!has_next) break;
        if (!(cur.kind & KEEP)) {
#pragma unroll
            for (int a = 0; a < 2; ++a)
#pragma unroll
                for (int b = 0; b < 2; ++b)
#pragma unroll
                    for (int m = 0; m < 4; ++m)
#pragma unroll
                        for (int n = 0; n < 2; ++n) acc[a][b][m][n] = (f32x4){0.f, 0.f, 0.f, 0.f};
        }
        cur = nxt; cA = nA; cB = nB; ++ui;
        if constexpr (ALIGN_EPI) { if (wr == 1) PG8_BAR; }
    }
    PG8_WAIT_V(0);
    if constexpr (!ALIGN_EPI) { if (wr == 0) PG8_BAR; }
    PG8_BAR;
#undef PG8_SA
#undef PG8_SB
#undef PG8_STAGE
#undef PG8_STAGE_A
#undef PG8_IDS_DMA
#undef PG8_AUX_DMA
#undef PG8_IDS_READ
#undef PG8_LDA
#undef PG8_LDB
#undef PG8_MMA
#undef PG8_CAT
#undef PG8_WAIT_V
#undef PG8_WAIT_L
#undef PG8_BAR
#undef PG8_SCHED
}
}

struct Args { const float* in[20]; float* out; unsigned char* ws; int ph_lo, ph_hi; };
#define KIN(i) (((const __attribute__((address_space(4))) Args*)__builtin_amdgcn_kernarg_segment_ptr())->in[i])
struct Frame {
    LAS unsigned char* lds;
    volatile LAS unsigned* MISC;
    gu32* ctl;
    int tid, lane, wave, G;
    int vcu, cx, local_ok;
    unsigned char* ws;
    float* out;
    unsigned long long pb_t0, pb_acc;
};

using pg8::Unit;
typedef f32x4 Acc[2][2][4][2];

struct EpiInProj {
    static constexpr bool PERM = true;
    unsigned char* ws; const LAS float* gl; const LAS float* rs_tab;
    __device__ __forceinline__ void operator()(Acc& acc, const Unit& u, int wr, int wc, int fr, int fq) const {
        const int row0 = u.pm * 256 + wr * 64 + fr; const int pn = u.pn;
        float rs[2][4];
#pragma unroll
        for (int ai = 0; ai < 2; ++ai)
#pragma unroll
            for (int m = 0; m < 4; ++m) rs[ai][m] = rs_tab[u.slot * 256 + wr * 64 + fr + ai * 128 + m * 16];
        if (pn < 4) {
            const LAS float* g = gl + (pn >> 1) * 64 + 8 * fq;
            bf16* dst = (bf16*)(ws + WS_DQ + (size_t)(pn >> 1) * (32 * MiB)) + wc * 128 + (pn & 1) * 64 + 8 * fq;
#pragma unroll
            for (int ai = 0; ai < 2; ++ai)
#pragma unroll
                for (int m = 0; m < 4; ++m) {
                    const int row = row0 + ai * 128 + m * 16; const float r_ = rs[ai][m]; float ss = 0.f; f32x4 v[2][2];
#pragma unroll
                    for (int bj = 0; bj < 2; ++bj)
#pragma unroll
                        for (int n = 0; n < 2; ++n) { v[bj][n] = acc[ai][bj][m][n] * r_; ss += (v[bj][n][0] * v[bj][n][0] + v[bj][n][1] * v[bj][n][1]) + (v[bj][n][2] * v[bj][n][2] + v[bj][n][3] * v[bj][n][3]); }
                    ss += __shfl_xor(ss, 16); ss += __shfl_xor(ss, 32);
                    const float inv = __builtin_amdgcn_rsqf(ss * (1.0f / 64.0f) + EPS);
                    bf16* rowp = dst + (size_t)row * 512;
#pragma unroll
                    for (int bj = 0; bj < 2; ++bj) { const f32x4 g0 = *(const LAS f32x4*)(g + 32 * bj) * inv, g1 = *(const LAS f32x4*)(g + 32 * bj + 4) * inv; u32x4 w;
                        w.x = cvt_pk_bf16(v[bj][0][0] * g0[0], v[bj][0][1] * g0[1]); w.y = cvt_pk_bf16(v[bj][0][2] * g0[2], v[bj][0][3] * g0[3]);
                        w.z = cvt_pk_bf16(v[bj][1][0] * g1[0], v[bj][1][1] * g1[1]); w.w = cvt_pk_bf16(v[bj][1][2] * g1[2], v[bj][1][3] * g1[3]);
                        *(u32x4*)(rowp + bj * 32) = w; }
                }
        } else if (pn < 12) {
            const int sec = (pn - 4) >> 1; bf16* dst = (bf16*)(ws + WS_VA + (size_t)sec * (32 * MiB)) + ((pn - 4) & 1) * 256 + wc * 32 + 8 * fq; const float sc = (sec == 1) ? C2 : 1.f;
#pragma unroll
            for (int ai = 0; ai < 2; ++ai)
#pragma unroll
                for (int m = 0; m < 4; ++m) { const int row = row0 + ai * 128 + m * 16; const float r_ = rs[ai][m] * sc; bf16* rowp = dst + (size_t)row * 512;
#pragma unroll
                    for (int bj = 0; bj < 2; ++bj) { const f32x4 v0 = acc[ai][bj][m][0] * r_, v1 = acc[ai][bj][m][1] * r_; u32x4 w;
                        w.x = cvt_pk_bf16(v0[0], v0[1]); w.y = cvt_pk_bf16(v0[2], v0[3]); w.z = cvt_pk_bf16(v1[0], v1[1]); w.w = cvt_pk_bf16(v1[2], v1[3]);
                        *(u32x4*)(rowp + bj * 128) = w; } }
        } else {
            const int col0 = (pn - 12) * 128 + wc * 32 + 8 * fq; unsigned char* G = ws + WS_G1;
#pragma unroll
            for (int ai = 0; ai < 2; ++ai)
#pragma unroll
                for (int m = 0; m < 4; ++m) { const int row = row0 + ai * 128 + m * 16; const float r_ = rs[ai][m];
                    unsigned qa[8], qb[8];
#pragma unroll
                    for (int n = 0; n < 2; ++n)
#pragma unroll
                        for (int j = 0; j < 4; ++j) { const float ga = acc[ai][0][m][n][j] * r_, gb = acc[ai][1][m][n][j] * r_;
                            const float sa = __builtin_amdgcn_rcpf(1.f + fexp2(-ga * LOG2E)), sb = __builtin_amdgcn_rcpf(1.f + fexp2(-gb * LOG2E));
                            qa[n * 4 + j] = (unsigned)(sa * 255.f + 0.5f); qb[n * 4 + j] = max(1u, (unsigned)(sb * 255.f + 0.5f)); }
                    u32x4 w;
                    w.x = qa[0] | (qa[1] << 8) | (qa[2] << 16) | (qa[3] << 24); w.y = qa[4] | (qa[5] << 8) | (qa[6] << 16) | (qa[7] << 24);
                    w.z = qb[0] | (qb[1] << 8) | (qb[2] << 16) | (qb[3] << 24); w.w = qb[4] | (qb[5] << 8) | (qb[6] << 16) | (qb[7] << 24);
                    *(u32x4*)(G + (size_t)row * 2048 + (size_t)col0 * 2) = w; }
        }
    }
};

struct EpiBranch {
    static constexpr bool PERM = true;
    const unsigned char* G; bf16* MIXED;
    __device__ __forceinline__ void operator()(Acc& acc, const Unit& u, int wr, int wc, int fr, int fq) const {
        const int row0 = u.pm * 256 + wr * 64 + fr; const int col0 = u.pn * 256 + wc * 32 + 8 * fq; const bool first = (u.kind & 0xff) == 0;
        const unsigned char* Gp = G + (size_t)row0 * 2048 + (size_t)col0 * 2;
        u32x4 g[2][4][2];
#pragma unroll
        for (int ai = 0; ai < 2; ++ai)
#pragma unroll
            for (int m = 0; m < 4; ++m)
#pragma unroll
                for (int bj = 0; bj < 2; ++bj) g[ai][m][bj] = *(const u32x4*)(Gp + (size_t)(ai * 128 + m * 16) * 2048 + bj * 256);
#define UB(w, k) ((float)(((w) >> (8 * (k))) & 0xffu))
        if (first) {
#pragma unroll
            for (int ai = 0; ai < 2; ++ai)
#pragma unroll
                for (int m = 0; m < 4; ++m)
#pragma unroll
                    for (int bj = 0; bj < 2; ++bj) { u32x4 gg = g[ai][m][bj]; asm volatile("" : "+v"(gg));
                        f32x4 v0 = acc[ai][bj][m][0], v1 = acc[ai][bj][m][1];
                        v0[0] *= UB(gg.x, 0) * __builtin_amdgcn_rcpf(UB(gg.z, 0)); v0[1] *= UB(gg.x, 1) * __builtin_amdgcn_rcpf(UB(gg.z, 1)); v0[2] *= UB(gg.x, 2) * __builtin_amdgcn_rcpf(UB(gg.z, 2)); v0[3] *= UB(gg.x, 3) * __builtin_amdgcn_rcpf(UB(gg.z, 3));
                        v1[0] *= UB(gg.y, 0) * __builtin_amdgcn_rcpf(UB(gg.w, 0)); v1[1] *= UB(gg.y, 1) * __builtin_amdgcn_rcpf(UB(gg.w, 1)); v1[2] *= UB(gg.y, 2) * __builtin_amdgcn_rcpf(UB(gg.w, 2)); v1[3] *= UB(gg.y, 3) * __builtin_amdgcn_rcpf(UB(gg.w, 3));
                        acc[ai][bj][m][0] = v0; acc[ai][bj][m][1] = v1; }
        } else {
            bf16* Mp = MIXED + (size_t)row0 * 1024 + col0; asm volatile("" : "+v"(Mp)); const float q = 1.0f / 255.0f;
#pragma unroll
            for (int ai = 0; ai < 2; ++ai)
#pragma unroll
                for (int m = 0; m < 4; ++m)
#pragma unroll
                    for (int bj = 0; bj < 2; ++bj) { u32x4 gg = g[ai][m][bj]; asm volatile("" : "+v"(gg)); const f32x4 v0 = acc[ai][bj][m][0] * q, v1 = acc[ai][bj][m][1] * q; u32x4 w;
                        w.x = cvt_pk_bf16(v0[0] * UB(gg.z, 0), v0[1] * UB(gg.z, 1)); w.y = cvt_pk_bf16(v0[2] * UB(gg.z, 2), v0[3] * UB(gg.z, 3));
                        w.z = cvt_pk_bf16(v1[0] * UB(gg.w, 0), v1[1] * UB(gg.w, 1)); w.w = cvt_pk_bf16(v1[2] * UB(gg.w, 2), v1[3] * UB(gg.w, 3));
                        *(u32x4*)(Mp + (size_t)(ai * 128 + m * 16) * 1024 + bj * 128) = w; }
        }
#undef UB
    }
};

struct EpiOutProj {
    static constexpr bool PERM = true;
    bf16* XB; unsigned char* XB8;
    __device__ __forceinline__ void operator()(Acc& acc, const Unit& u, int wr, int wc, int fr, int fq) const {
        const int row0 = u.pm * 256 + wr * 64 + fr; const int col0 = u.pn * 256 + wc * 32 + 8 * fq;
        bf16* base = XB + (size_t)row0 * 1024 + col0; unsigned char* base8 = XB8 + (size_t)row0 * 1024 + col0;
        u32x4 g[2][4][2];
#pragma unroll
        for (int ai = 0; ai < 2; ++ai)
#pragma unroll
            for (int m = 0; m < 4; ++m)
#pragma unroll
                for (int bj = 0; bj < 2; ++bj) g[ai][m][bj] = *(const u32x4*)(base + (size_t)(ai * 128 + m * 16) * 1024 + bj * 128);
#pragma unroll
        for (int ai = 0; ai < 2; ++ai)
#pragma unroll
            for (int m = 0; m < 4; ++m)
#pragma unroll
                for (int bj = 0; bj < 2; ++bj) { const u32x4 gg = g[ai][m][bj]; const f32x4 a0 = acc[ai][bj][m][0], a1 = acc[ai][bj][m][1]; u32x4 w;
                    w.x = cvt_pk_bf16(a0[0] + bf_lo(gg.x), a0[1] + bf_hi(gg.x)); w.y = cvt_pk_bf16(a0[2] + bf_lo(gg.y), a0[3] + bf_hi(gg.y));
                    w.z = cvt_pk_bf16(a1[0] + bf_lo(gg.z), a1[1] + bf_hi(gg.z)); w.w = cvt_pk_bf16(a1[2] + bf_lo(gg.w), a1[3] + bf_hi(gg.w));
                    *(u32x4*)(base + (size_t)(ai * 128 + m * 16) * 1024 + bj * 128) = w;
                    const float v8[8] = {bf_lo(w.x), bf_hi(w.x), bf_lo(w.y), bf_hi(w.y), bf_lo(w.z), bf_hi(w.z), bf_lo(w.w), bf_hi(w.w)};
                    *(u32x2*)(base8 + (size_t)(ai * 128 + m * 16) * 1024 + bj * 128) = pack8_fp8(v8); }
    }
};

struct EpiMoe1 {
    static constexpr bool PERM = true;
    const LAS float* rs_tab; unsigned char* ACT;
    __device__ __forceinline__ void operator()(Acc& acc, const Unit& u, int wr, int wc, int fr, int fq) const {
        const int row0 = u.pm * 256 + wr * 64 + fr; const int col0 = u.pn * 128 + wc * 32 + 8 * fq; const int r0 = wr * 64 + fr;
        float rs[2][4];
#pragma unroll
        for (int ai = 0; ai < 2; ++ai)
#pragma unroll
            for (int m = 0; m < 4; ++m) { const int r = r0 + ai * 128 + m * 16; rs[ai][m] = (r < u.nvalid) ? rs_tab[u.slot * 256 + r] * (1.0f / W8_SCALE) : 0.f; }
#pragma unroll
        for (int ai = 0; ai < 2; ++ai)
#pragma unroll
            for (int m = 0; m < 4; ++m) { const int prow = row0 + ai * 128 + m * 16; const float r_ = rs[ai][m]; float a[8];
#pragma unroll
                for (int n = 0; n < 2; ++n)
#pragma unroll
                    for (int j = 0; j < 4; ++j) { const float g = acc[ai][0][m][n][j] * r_, up = acc[ai][1][m][n][j] * r_;
                        a[n * 4 + j] = A8_SCALE * g * up * __builtin_amdgcn_rcpf(1.f + fexp2(-g * LOG2E)); }
                *(u32x2*)(ACT + (size_t)prow * 512 + col0) = pack8_fp8(a); }
    }
};

struct EpiMoe2 {
    static constexpr bool PERM = true;
    const LAS int* tok_tab; unsigned char* CONTRIB;
    __device__ __forceinline__ void operator()(Acc& acc, const Unit& u, int wr, int wc, int fr, int fq) const {
        const int col0 = u.pn * 256 + wc * 32 + 8 * fq; const int r0 = wr * 64 + fr;
        int tk[2][4]; float ww[2][4];
#pragma unroll
        for (int ai = 0; ai < 2; ++ai)
#pragma unroll
            for (int m = 0; m < 4; ++m) { const int r = r0 + ai * 128 + m * 16; const bool ok = r < u.nvalid; tk[ai][m] = ok ? tok_tab[u.slot * 256 + r] : -1; ww[ai][m] = ok ? __int_as_float(tok_tab[768 + u.slot * 256 + r]) * (C8_SCALE / (W8_SCALE * A8_SCALE)) : 0.f; }
#pragma unroll
        for (int ai = 0; ai < 2; ++ai)
#pragma unroll
            for (int m = 0; m < 4; ++m) { const int tok2 = tk[ai][m]; const float w_ = ww[ai][m];
                if (tok2 >= 0) {
#pragma unroll
                    for (int bj = 0; bj < 2; ++bj) { const f32x4 v0 = acc[ai][bj][m][0] * w_, v1 = acc[ai][bj][m][1] * w_;
                        const float v8[8] = {v0[0], v0[1], v0[2], v0[3], v1[0], v1[1], v1[2], v1[3]};
                        *(u32x2*)(CONTRIB + (size_t)tok2 * 1024 + col0 + bj * 128) = pack8_fp8(v8); } } }
    }
};

struct SchedPlain {
    static constexpr bool GATHER = false; static constexpr bool FP8 = false;
    const char* A; const char* Bt; int nM, nN, K, G, c; const int* aux0 = nullptr; const int* aux1 = nullptr;
    __device__ __forceinline__ bool next(int i, Unit& u) const {
        const long L = (long)i * G + c; if (L >= (long)nM * nN) return false;
        pg8::tile_order((int)L, nM, nN, u.pm, u.pn); u.kind = 0; u.eoff = 256 * u.pm; u.nvalid = 256; u.goff = 0; u.gnv = 0;
        u.A = A + (size_t)u.pm * 256 * K * 2; u.B = Bt + (size_t)u.pn * 256 * K * 2; return true;
    }
};
struct SchedBranch {
    static constexpr bool GATHER = false; static constexpr bool FP8 = false;
    const char *OA, *OB, *WBD, *WBS; int G, c; const int* aux0 = nullptr; const int* aux1 = nullptr;
    __device__ __forceinline__ bool next(int i, Unit& u) const {
        const long L = (long)(i >> 1) * G + c; if (L >= 128 * 4) return false;
        pg8::tile_order((int)L, 128, 4, u.pm, u.pn); const int br = i & 1; u.kind = br ? 1 : (0 | pg8::KEEP); u.eoff = 0; u.nvalid = 256; u.goff = 0; u.gnv = 0;
        u.A = (br ? OB : OA) + (size_t)u.pm * 256 * 512 * 2; u.B = (br ? WBS : WBD) + (size_t)u.pn * 256 * 512 * 2; return true;
    }
};
template <bool G>
struct SchedMoe {
    static constexpr bool GATHER = true; static constexpr bool FP8 = true;
    const char* A; const char* W; const LAS int* ust; const int* ids; const int* aux0; const int* aux1; int K; size_t wstride; int Gn, c;
    __device__ __forceinline__ bool next(int i, Unit& u) const {
        const int v = (Gn % 8 == 0) ? (c % 8) * (Gn / 8) + c / 8 : c;
        const long L = (long)i * Gn + v; const int nrb = ust[32]; if (L >= (long)nrb * 4) return false;
        const int rb = (int)(L >> 2), pn = (int)(L & 3); int e = 0;
        for (int j = 1; j < 32; ++j) e += (ust[j] <= rb) ? 1 : 0;
        const int rbl = rb - ust[e]; const int left = ust[64 + e] - 256 * rbl;
        u.pm = rb; u.pn = pn; u.kind = 0; u.eoff = e * ECAP + 256 * rbl; u.nvalid = left < 256 ? left : 256;
        if (G) { u.goff = u.eoff; u.gnv = u.nvalid; } else { u.goff = 256 * rb; u.gnv = 256; }
        u.A = A; u.B = W + (size_t)e * wstride + (size_t)pn * 256 * K * 2; return true;
    }
};

template <class RowMap>
__device__ __forceinline__ void transpose_item(const float* W, int N, bf16* WT, int Kd, const float* gk, LAS unsigned* scr, int kb, int nb, int lane, const RowMap& map) {
    const int k0 = 64 * kb, n0 = 64 * nb, n4 = lane & 15, kq = lane >> 4;
    f32x4 va[8], vb[8];
    const float* wp = W + (size_t)(k0 + 2 * kq) * N + n0 + 4 * n4;
#pragma unroll
    for (int i = 0; i < 8; ++i) { va[i] = __builtin_nontemporal_load((const f32x4*)(wp + (size_t)(8 * i) * N)); vb[i] = __builtin_nontemporal_load((const f32x4*)(wp + (size_t)(8 * i + 1) * N)); }
#pragma unroll
    for (int i = 0; i < 8; ++i) {
        float ga = 1.f, gb = 1.f; if (gk) { ga = gk[k0 + 8 * i + 2 * kq]; gb = gk[k0 + 8 * i + 2 * kq + 1]; }
#pragma unroll
        for (int j = 0; j < 4; ++j) scr[(4 * n4 + j) * 33 + 4 * i + kq] = cvt_pk_bf16(va[i][j] * ga, vb[i][j] * gb);
    }
    LDS_WAIT(); asm volatile("" ::: "memory");
    const int nl = lane >> 3, c = lane & 7;
#pragma unroll
    for (int p = 0; p < 8; ++p) { const int n = 8 * p + nl; const LAS unsigned* sp = scr + n * 33 + 4 * c;
        u32x4 o; o.x = sp[0]; o.y = sp[1]; o.z = sp[2]; o.w = sp[3];
        *(u32x4*)(WT + (size_t)map(n0 + n) * Kd + k0 + 8 * c) = o; }
    LDS_WAIT(); asm volatile("" ::: "memory");
}
template <class RowMap>
__device__ __forceinline__ void transpose_item8(const float* W, int N, unsigned char* WT, int Kd, const float* gk, float scale, LAS unsigned char* scr, int kb, int nb, int lane, const RowMap& map) {
    const int k0 = 64 * kb, n0 = 64 * nb, n4 = lane & 15, kq = lane >> 4;
    f32x4 va[8], vb[8];
    const float* wp = W + (size_t)(k0 + 2 * kq) * N + n0 + 4 * n4;
#pragma unroll
    for (int i = 0; i < 8; ++i) { va[i] = __builtin_nontemporal_load((const f32x4*)(wp + (size_t)(8 * i) * N)); vb[i] = __builtin_nontemporal_load((const f32x4*)(wp + (size_t)(8 * i + 1) * N)); }
#pragma unroll
    for (int i = 0; i < 8; ++i) {
        float ga = scale, gb = scale; if (gk) { ga *= gk[k0 + 8 * i + 2 * kq]; gb *= gk[k0 + 8 * i + 2 * kq + 1]; }
#pragma unroll
        for (int j = 0; j < 4; ++j) *(LAS unsigned short*)(scr + (4 * n4 + j) * 72 + 8 * i + 2 * kq) = (unsigned short)(__builtin_amdgcn_cvt_pk_fp8_f32(va[i][j] * ga, vb[i][j] * gb, 0, false) & 0xffff);
    }
    LDS_WAIT(); asm volatile("" ::: "memory");
    const int nl = lane >> 3, c = lane & 7;
#pragma unroll
    for (int p = 0; p < 8; ++p) { const int n = 8 * p + nl; const u32x2 o = *(const LAS u32x2*)(scr + n * 72 + 8 * c);
        *(u32x2*)(WT + (size_t)map(n0 + n) * Kd + k0 + 8 * c) = o; }
    LDS_WAIT(); asm volatile("" ::: "memory");
}
struct MapPlain { __device__ __forceinline__ int operator()(int c) const { return c; } };
struct MapIn {
    __device__ __forceinline__ int operator()(int c) const {
        if (c < 1024) { const int pn = c >> 8, hh = (c >> 6) & 3, d = c & 63; return 256 * pn + 128 * (d >> 5) + 32 * hh + (d & 31); }
        if (c < 3072) return c;
        if (c < 4096) { const int cc = c - 3072; return 3072 + 256 * (cc >> 7) + (cc & 127); }
        const int cc = c - 4096; return 3072 + 256 * (cc >> 7) + 128 + (cc & 127);
    }
};
struct MapGU { int up; __device__ __forceinline__ int operator()(int c) const { return 256 * (c >> 7) + 128 * up + (c & 127); } };

__device__ __forceinline__ void convert_moe_weights(Frame& F, int l, int gw, int NGW) {
    LAS unsigned char* scr = (LAS unsigned char*)(F.lds + F.wave * 16384);
    const float* g2 = KIN(14) + l * D;
    for (int it = gw; it < NE * 384; it += NGW) {
        const int e = it / 384, r = it % 384;
        if (r < 256) { const int up = r >> 7, q = r & 127, kb = q >> 3, nb = q & 7;
            const float* W = (up ? KIN(18) : KIN(17)) + ((size_t)l * NE + e) * (size_t)D * DFF;
            transpose_item8(W, DFF, (unsigned char*)(F.ws + WS_WGU_T) + (size_t)e * 1024 * 1024, 1024, g2, W8_SCALE, scr, kb, nb, F.lane, MapGU{up});
        } else { const int q = r - 256, kb = q >> 4, nb = q & 15;
            const float* W = KIN(19) + ((size_t)l * NE + e) * (size_t)DFF * D;
            transpose_item8(W, D, (unsigned char*)(F.ws + WS_WDN_T) + (size_t)e * 1024 * 512, 512, nullptr, W8_SCALE, scr, kb, nb, F.lane, MapPlain{});
        }
    }
}
__device__ __forceinline__ void convert_small_weights(Frame& F, int gw, int NGW) {
    LAS unsigned* scr = (LAS unsigned*)(F.lds + F.wave * 16384);
    for (int it = gw; it < 2 * 1792; it += NGW) {
        const int l = it / 1792; int r = it % 1792;
        if (r < 1280) { const int kb = r / 80, nb = r % 80;
            transpose_item(KIN(3) + (size_t)l * D * NIN, NIN, (bf16*)(F.ws + WS_WIN_T) + (size_t)l * NIN * D, D, KIN(2) + l * D, scr, kb, nb, F.lane, MapIn{}); continue; }
        r -= 1280;
        if (r < 128) { transpose_item(KIN(11) + (size_t)l * 512 * D, D, (bf16*)(F.ws + WS_WBD_T) + (size_t)l * D * 512, 512, nullptr, scr, r >> 4, r & 15, F.lane, MapPlain{}); continue; }
        r -= 128;
        if (r < 128) { transpose_item(KIN(12) + (size_t)l * 512 * D, D, (bf16*)(F.ws + WS_WBS_T) + (size_t)l * D * 512, 512, nullptr, scr, r >> 4, r & 15, F.lane, MapPlain{}); continue; }
        r -= 128;
        transpose_item(KIN(13) + (size_t)l * D * D, D, (bf16*)(F.ws + WS_WOUT_T) + (size_t)l * D * D, D, nullptr, scr, r >> 4, r & 15, F.lane, MapPlain{});
    }
    const int gt = (gw * 64 + F.lane), NT_ = NGW * 64;
    for (int i = gt; i < PMAX; i += NT_) ((int*)(F.ws + WS_IDENT))[i] = 2 * i;
    for (int idx = gt; idx < 2 * 48 * 1024; idx += NT_) {
        const int l = idx / (48 * 1024), r = idx % (48 * 1024), n = r >> 10, k = r & 1023; float v = 0.f;
        if (n < 32) v = KIN(16)[((size_t)l * D + k) * 32 + n]; else if (n < 36) v = KIN(15)[((size_t)l * D + k) * 4 + (n - 32)];
        v *= KIN(14)[l * D + k];
        ((bf16*)(F.ws + WS_WR_T))[idx] = (bf16)(cvt_pk_bf16(v, 0.f) & 0xffffu);
    }
}
template <bool INB, bool ADD, bool WX, bool WB>
__device__ __forceinline__ void rows_phase(Frame& F, const float* xin, float* xout, int m_first, int m_step, int m_end) {
    const unsigned char* C = (const unsigned char*)(F.ws + WS_CONTRIB); bf16* XB = (bf16*)(F.ws + WS_XB); float* rstd = (float*)(F.ws + WS_RSTD1);
    for (int m0 = m_first; m0 < m_end; m0 += m_step) {
        f32x4 v[2][4]; u32x2 xa[2][4]; unsigned ca[2][4], cb[2][4];
#pragma unroll
        for (int q = 0; q < 2; ++q) {
            if (INB) { const u32x2* xr = (const u32x2*)(XB + (size_t)(m0 + q) * D) + F.lane;
#pragma unroll
                for (int j = 0; j < 4; ++j) xa[q][j] = xr[64 * j]; }
            else { const f32x4* xr = (const f32x4*)(xin + (size_t)(m0 + q) * D) + F.lane;
#pragma unroll
                for (int j = 0; j < 4; ++j) v[q][j] = __builtin_nontemporal_load(xr + 64 * j); }
            if (ADD) { const unsigned* c0 = (const unsigned*)(C + (size_t)(2 * (m0 + q)) * D) + F.lane; const unsigned* c1 = (const unsigned*)(C + (size_t)(2 * (m0 + q) + 1) * D) + F.lane;
#pragma unroll
                for (int j = 0; j < 4; ++j) { ca[q][j] = c0[64 * j]; cb[q][j] = c1[64 * j]; } } }
#pragma unroll
        for (int q = 0; q < 2; ++q) { const int m = m0 + q;
            if (INB) {
#pragma unroll
                for (int j = 0; j < 4; ++j) { const u32x2 a = xa[q][j]; v[q][j] = (f32x4){bf_lo(a.x), bf_hi(a.x), bf_lo(a.y), bf_hi(a.y)}; } }
            if (ADD) {
#pragma unroll
                for (int j = 0; j < 4; ++j) { const int a = (int)ca[q][j], b = (int)cb[q][j];
                    const f32x2 a0 = __builtin_amdgcn_cvt_pk_f32_fp8(a, false), a1 = __builtin_amdgcn_cvt_pk_f32_fp8(a, true), b0 = __builtin_amdgcn_cvt_pk_f32_fp8(b, false), b1 = __builtin_amdgcn_cvt_pk_f32_fp8(b, true);
                    v[q][j][0] += (a0[0] + b0[0]) * (1.0f / C8_SCALE); v[q][j][1] += (a0[1] + b0[1]) * (1.0f / C8_SCALE); v[q][j][2] += (a1[0] + b1[0]) * (1.0f / C8_SCALE); v[q][j][3] += (a1[1] + b1[1]) * (1.0f / C8_SCALE); } }
            if (WX) { f32x4* xo = (f32x4*)(xout + (size_t)m * D) + F.lane;
#pragma unroll
                for (int j = 0; j < 4; ++j) __builtin_nontemporal_store(v[q][j], xo + 64 * j); }
            if (WB) {
                u32x2 w[4]; float s_ = 0.f;
#pragma unroll
                for (int j = 0; j < 4; ++j) { w[j].x = cvt_pk_bf16(v[q][j][0], v[q][j][1]); w[j].y = cvt_pk_bf16(v[q][j][2], v[q][j][3]);
                    const float r0 = bf_lo(w[j].x), r1 = bf_hi(w[j].x), r2 = bf_lo(w[j].y), r3 = bf_hi(w[j].y); s_ += (r0 * r0 + r1 * r1) + (r2 * r2 + r3 * r3); }
                s_ = wave_sum(s_);
                if (F.lane == 0) rstd[m] = 1.0f / sqrtf(s_ * (1.0f / D) + EPS);
                u32x2* o = (u32x2*)(XB + (size_t)m * D) + F.lane;
#pragma unroll
                for (int j = 0; j < 4; ++j) o[64 * j] = w[j];
            } }
    }
}

__device__ __forceinline__ void router_phase(Frame& F, int l) {
    const bf16* XB = (const bf16*)(F.ws + WS_XB); const bf16* WR = (const bf16*)(F.ws + WS_WR_T) + (size_t)l * 48 * 1024;
    int* ent_tok = (int*)(F.ws + WS_ENT_TOK); float* ent_w = (float*)(F.ws + WS_ENT_W); float* ent_rs = (float*)(F.ws + WS_ENT_RS);
    unsigned* gcnt = (unsigned*)(F.ctl + CW_CNT + 64 * l);
    LAS int* lcnt = (LAS int*)(F.lds + MOE_OFF) + 64; LAS int* lbase = lcnt + 32;
    const int fr = F.lane & 15, fq = F.lane >> 4;
    { LAS u32x4* wl = (LAS u32x4*)F.lds; u32x4 tmp[12];
#pragma unroll
        for (int j = 0; j < 12; ++j) { const int f = F.tid + 512 * j, ln = f & 63, kk = (f >> 6) & 31, nb = f >> 11; tmp[j] = *(const u32x4*)(WR + (size_t)(16 * nb + (ln & 15)) * D + 32 * kk + 8 * (ln >> 4)); }
#pragma unroll
        for (int j = 0; j < 12; ++j) wl[F.tid + 512 * j] = tmp[j];
    }
    __syncthreads();
    for (int chunk = F.vcu; chunk < T / 128; chunk += F.G) {
        if (F.tid < 32) lcnt[F.tid] = 0;
        __syncthreads();
        const int row = chunk * 128 + F.wave * 16 + fr;
        f32x4 a0 = {0.f, 0.f, 0.f, 0.f}, a1 = a0, a2 = a0; float ss = 0.f;
        const bf16* xp = XB + (size_t)row * D + 8 * fq; const LAS bf16x8* wl = (const LAS bf16x8*)F.lds + F.lane;
#pragma unroll
        for (int kb_ = 0; kb_ < 2; ++kb_) {
        u32x4 xa[16];
#pragma unroll
        for (int kk = 0; kk < 16; ++kk) xa[kk] = *(const u32x4*)(xp + 32 * (16 * kb_ + kk));
#pragma unroll
        for (int k_ = 0; k_ < 16; ++k_) { const int kk = 16 * kb_ + k_;
            { const u32x4 x_ = xa[k_]; float t0 = bf_lo(x_.x), t1 = bf_hi(x_.x), t2 = bf_lo(x_.y), t3 = bf_hi(x_.y), t4 = bf_lo(x_.z), t5 = bf_hi(x_.z), t6 = bf_lo(x_.w), t7 = bf_hi(x_.w);
              ss += (t0 * t0 + t1 * t1) + (t2 * t2 + t3 * t3) + (t4 * t4 + t5 * t5) + (t6 * t6 + t7 * t7); }
            const bf16x8 xf = __builtin_bit_cast(bf16x8, xa[k_]);
            a0 = __builtin_amdgcn_mfma_f32_16x16x32_bf16(wl[(0 * 32 + kk) * 64], xf, a0, 0, 0, 0);
            a1 = __builtin_amdgcn_mfma_f32_16x16x32_bf16(wl[(1 * 32 + kk) * 64], xf, a1, 0, 0, 0);
            a2 = __builtin_amdgcn_mfma_f32_16x16x32_bf16(wl[(2 * 32 + kk) * 64], xf, a2, 0, 0, 0);
            if ((k_ & 3) == 3) __builtin_amdgcn_sched_barrier(0);
        }
        asm volatile("" ::: "memory");
        }
        ss += __shfl_xor(ss, 16); ss += __shfl_xor(ss, 32);
        const float rstd = 1.0f / sqrtf(ss * (1.0f / D) + EPS);
        float gl[4];
#pragma unroll
        for (int j = 0; j < 4; ++j) gl[j] = __shfl(a2[j], fr) * rstd;
        int g = 0; float gm = gl[0];
#pragma unroll
        for (int j = 1; j < 4; ++j) if (gl[j] > gm) { gm = gl[j]; g = j; }
        float gs = 0.f;
#pragma unroll
        for (int j = 0; j < 4; ++j) gs += __expf(gl[j] - gm);
        const float pg = 1.0f / gs;
        f32x4 sel = (g >> 1) ? a1 : a0;
        float el[8];
#pragma unroll
        for (int i = 0; i < 8; ++i) { const int src = fr + 16 * (2 * (g & 1) + (i >> 2)); el[i] = __shfl(sel[i & 3], src) * rstd; }
        int i1 = 0; float m1 = el[0];
#pragma unroll
        for (int i = 1; i < 8; ++i) if (el[i] > m1) { m1 = el[i]; i1 = i; }
        int i2 = -1; float m2 = -3.0e38f;
#pragma unroll
        for (int i = 0; i < 8; ++i) if (i != i1 && el[i] > m2) { m2 = el[i]; i2 = i; }
        const float p2 = __expf(m2 - m1); const float w0 = pg / (1.f + p2), w1 = pg * p2 / (1.f + p2);
        const int e0 = 8 * g + i1, e1 = 8 * g + i2;
        int lp0 = 0, lp1 = 0;
        if (fq == 0) { lp0 = __hip_atomic_fetch_add(lcnt + e0, 1, __ATOMIC_RELAXED, __HIP_MEMORY_SCOPE_WORKGROUP); lp1 = __hip_atomic_fetch_add(lcnt + e1, 1, __ATOMIC_RELAXED, __HIP_MEMORY_SCOPE_WORKGROUP); }
        __syncthreads();
        if (F.tid < 32) lbase[F.tid] = (int)__hip_atomic_fetch_add(gcnt + F.tid, (unsigned)lcnt[F.tid], RLX_AGENT);
        __syncthreads();
        if (fq == 0) {
            const int s0 = e0 * ECAP + lbase[e0] + lp0, s1 = e1 * ECAP + lbase[e1] + lp1;
            ent_tok[s0] = 2 * row; ent_tok[s1] = 2 * row + 1; ent_w[s0] = w0; ent_w[s1] = w1; ent_rs[s0] = rstd; ent_rs[s1] = rstd;
        }
        __syncthreads();
    }
}
__device__ __forceinline__ void build_ust(Frame& F, int l) {
    LAS int* ust = (LAS int*)(F.lds + MOE_OFF); LAS int* cnt = ust + 64;
    if (F.tid < 32) cnt[F.tid] = (int)__hip_atomic_load((unsigned*)(F.ctl + CW_CNT + 64 * l) + F.tid, RLX_AGENT);
    __syncthreads();
    if (F.tid == 0) { int acc = 0;
        for (int e = 0; e < 32; ++e) { ust[e] = acc; acc += (cnt[e] + 255) >> 8; }
        ust[32] = acc; }
    __syncthreads();
}
__device__ __forceinline__ int crow(int r, int hi) { return (r & 3) + 8 * (r >> 2) + 4 * hi; }
__device__ __forceinline__ s16x4 vtr(const LAS unsigned char* p) { return __builtin_bit_cast(s16x4, __builtin_amdgcn_ds_read_tr16_b64_v4i16((LAS v4i16_t*)p)); }
__device__ __forceinline__ void glds(const void* g, LAS unsigned char* l) { __builtin_amdgcn_global_load_lds((const unsigned*)g, (LAS unsigned*)l, 16, 0, 0); }
#define PKV(lo, hi4) (bf16x8){lo[0], lo[1], lo[2], lo[3], hi4[0], hi4[1], hi4[2], hi4[3]}

__device__ __forceinline__ void pack_p(const f32x16& p0, const f32x16& p1, bf16x8 (&pa)[4]) {
    u32x4 w0, w1, w2, w3;
    w0.x = cvt_pk_bf16(p0[0], p0[1]); w0.y = cvt_pk_bf16(p0[2], p0[3]); w0.z = cvt_pk_bf16(p0[4], p0[5]); w0.w = cvt_pk_bf16(p0[6], p0[7]);
    w1.x = cvt_pk_bf16(p0[8], p0[9]); w1.y = cvt_pk_bf16(p0[10], p0[11]); w1.z = cvt_pk_bf16(p0[12], p0[13]); w1.w = cvt_pk_bf16(p0[14], p0[15]);
    w2.x = cvt_pk_bf16(p1[0], p1[1]); w2.y = cvt_pk_bf16(p1[2], p1[3]); w2.z = cvt_pk_bf16(p1[4], p1[5]); w2.w = cvt_pk_bf16(p1[6], p1[7]);
    w3.x = cvt_pk_bf16(p1[8], p1[9]); w3.y = cvt_pk_bf16(p1[10], p1[11]); w3.z = cvt_pk_bf16(p1[12], p1[13]); w3.w = cvt_pk_bf16(p1[14], p1[15]);
    pa[0] = __builtin_bit_cast(bf16x8, w0); pa[1] = __builtin_bit_cast(bf16x8, w1); pa[2] = __builtin_bit_cast(bf16x8, w2); pa[3] = __builtin_bit_cast(bf16x8, w3);
}
template <int NDB>
__device__ __forceinline__ void pv_mma(f32x16 (&o)[NDB], const LAS unsigned char* vp, const bf16x8 (&pa)[4]) {
    s16x4 lo[2][4], hi4[2][4];
#pragma unroll
    for (int ks = 0; ks < 4; ++ks) { lo[0][ks] = vtr(vp + ks * 1024); hi4[0][ks] = vtr(vp + ks * 1024 + 512); }
#pragma unroll
    for (int db = 0; db < NDB; ++db) {
        if (db + 1 < NDB) {
#pragma unroll
            for (int ks = 0; ks < 4; ++ks) { lo[(db + 1) & 1][ks] = vtr(vp + (db + 1) * 4096 + ks * 1024); hi4[(db + 1) & 1][ks] = vtr(vp + (db + 1) * 4096 + ks * 1024 + 512); }
        }
        __builtin_amdgcn_sched_barrier(0);
#pragma unroll
        for (int ks = 0; ks < 4; ++ks) o[db] = __builtin_amdgcn_mfma_f32_32x32x16_bf16(pa[ks], PKV(lo[db & 1][ks], hi4[db & 1][ks]), o[db], 0, 0, 0);
        __builtin_amdgcn_sched_barrier(0);
    }
}
__device__ __forceinline__ void qk_mma(f32x16& p0, f32x16& p1, const LAS unsigned char* Kb, const LAS unsigned char* Qs, int lane, int r32, int hi) {
    const LAS unsigned char* kb = Kb + hi * 1024 + r32 * 16;
#pragma unroll
    for (int d0 = 0; d0 < 4; ++d0) {
        const bf16x8 b0 = *(const LAS bf16x8*)(kb + d0 * 2048), b1 = *(const LAS bf16x8*)(kb + d0 * 2048 + 512), q = *(const LAS bf16x8*)(Qs + d0 * 1024 + lane * 16);
        p0 = __builtin_amdgcn_mfma_f32_32x32x16_bf16(b0, q, p0, 0, 0, 0); p1 = __builtin_amdgcn_mfma_f32_32x32x16_bf16(b1, q, p1, 0, 0, 0);
    }
}

__device__ __forceinline__ void diff_epilogue(Frame& F, f32x16 (&o)[4], LAS float* xch, const float* subg, float lam_init, bf16* Ow);
template <int VAR>
__device__ __forceinline__ void diff_stream(f32x16 (&o)[4], float& l, const LAS unsigned char* Kb, const LAS unsigned char* Vb, const bf16x8 (&qr)[4], const LAS float* lut,
                                            bool near, float cfar, int qrow, int kmin, int lane, int r32, int hi) {
    f32x16 p0, p1; const float init = near ? 0.f : cfar;
#pragma unroll
    for (int r = 0; r < 16; ++r) { p0[r] = init; p1[r] = init; }
    const LAS unsigned char* kb = Kb + r32 * 128; const int sw = (r32 >> 1) & 7;
    bf16x8 kf[8];
#pragma unroll
    for (int d0 = 0; d0 < 4; ++d0) { const int so = (((2 * d0 + hi) ^ sw) << 4); kf[2 * d0] = *(const LAS bf16x8*)(kb + so); kf[2 * d0 + 1] = *(const LAS bf16x8*)(kb + 4096 + so); }
    __builtin_amdgcn_sched_barrier(0);
#pragma unroll
    for (int d0 = 0; d0 < 4; ++d0) { if (!(VAR & 4)) { p0 = __builtin_amdgcn_mfma_f32_32x32x16_bf16(kf[2 * d0], qr[d0], p0, 0, 0, 0); p1 = __builtin_amdgcn_mfma_f32_32x32x16_bf16(kf[2 * d0 + 1], qr[d0], p1, 0, 0, 0); }
        else { p0[d0] += __builtin_bit_cast(f32x4, kf[2 * d0])[0]; p1[d0] += __builtin_bit_cast(f32x4, kf[2 * d0 + 1])[0]; } }
    if (VAR & 1) { } else if (near) {
#pragma unroll
        for (int r = 0; r < 16; ++r) { const int d0 = qrow - (kmin + crow(r, hi)), d1 = d0 - 32;
            const float b0 = lut[min(max(d0, 0), 127)], b1 = lut[min(max(d1, 0), 127)];
            p0[r] = d0 < 0 ? 0.f : fexp2(p0[r] + b0); p1[r] = d1 < 0 ? 0.f : fexp2(p1[r] + b1); }
    } else {
#pragma unroll
        for (int r = 0; r < 16; ++r) { p0[r] = fexp2(p0[r]); p1[r] = fexp2(p1[r]); }
    }
    float s = 0.f;
#pragma unroll
    for (int r = 0; r < 16; ++r) s += p0[r] + p1[r];
    l += s;
    bf16x8 pa[4]; pack_p(p0, p1, pa);
    const LAS unsigned char* vp = Vb + ((lane >> 4) & 1) * 32 + (lane & 3) * 8 + (4 * hi + ((lane & 15) >> 2)) * 64;
    if (!(VAR & 2)) pv_mma<4>(o, vp, pa); else { o[0][0] += __builtin_bit_cast(f32x4, pa[0])[0] + __builtin_bit_cast(f32x4, pa[3])[1]; }
}

template <int VAR>
__device__ __forceinline__ void diff_unit(Frame& F, int b, int h, int qb, const float* subg, float lam, float lam_init, bf16* Odst) {
    const int lane = F.lane, r32 = lane & 31, hi = lane >> 5, wid = F.wave, js = wid >> 2, wq = wid & 3;
    bf16* DQ = (bf16*)(F.ws + WS_DQ); const bf16* DK = (const bf16*)(F.ws + WS_DK); const bf16* VA = (const bf16*)(F.ws + WS_VA);
    const long rowbase = (long)b * SEQ; const int q0 = qb * 128, qw = q0 + 32 * wq;
    LAS unsigned char* kv = F.lds;
    LAS float* wsf = (LAS float*)(F.lds + WSF_OFF) + wid * 64; const LAS float* lut = (const LAS float*)(F.lds + LUT_OFF) + h * 128;
    const int NT = (q0 + 128) / 64;
    const int krow_ = 8 * wid + (lane >> 3);
    const bf16* k1src = DK + (rowbase + krow_) * 512 + h * 128 + (((lane & 7) ^ ((krow_ >> 1) & 7)) * 8);
    const bf16* vsrc0 = VA + (rowbase + 16 * (wid & 3) + (lane >> 2)) * 512 + h * 128 + (wid >> 2) * 32 + (lane & 3) * 8;
#define DIFF_ISSUE(t, bufi) do { LAS unsigned char* bb_ = kv + (bufi) * 32768; const long ro_ = (long)(t) * 64 * 512; \
        glds(k1src + ro_, bb_ + wid * 1024); glds(k1src + ro_ + 64, bb_ + 8192 + wid * 1024); \
        glds(vsrc0 + ro_, bb_ + 16384 + wid * 1024); glds(vsrc0 + ro_ + 64, bb_ + 16384 + (wid + 8) * 1024); } while (0)
    bf16x8 qr[4];
#pragma unroll
    for (int d0 = 0; d0 < 4; ++d0) qr[d0] = *(const bf16x8*)(DQ + (rowbase + qw + r32) * 512 + h * 128 + js * 64 + d0 * 16 + hi * 8);
    asm volatile("" ::: "memory");
    if (!(VAR & 8)) { DIFF_ISSUE(0, 0);
    if (NT > 1) DIFF_ISSUE(1, 1); }
    f32x16 o[4];
#pragma unroll
    for (int i = 0; i < 4; ++i)
#pragma unroll
        for (int r = 0; r < 16; ++r) o[i][r] = 0.f;
    float l = 0.f;
    const float cfar = lut[127];
    if (NT > 1) asm volatile("s_waitcnt vmcnt(4)" ::: "memory"); else asm volatile("s_waitcnt vmcnt(0)" ::: "memory");
    __builtin_amdgcn_s_barrier(); asm volatile("" ::: "memory");
    int sc_ = 0, sn2 = 2;
    for (int t = 0; t < NT; ++t) {
        if (!(VAR & 8)) { if (t + 2 < NT) DIFF_ISSUE(t + 2, sn2); }
        const int kmin = 64 * t;
        if (kmin <= qw + 31) {
            const bool near = (qw - (kmin + 63)) < 113;
            const LAS unsigned char* bb = kv + sc_ * 32768;
            diff_stream<VAR>(o, l, bb + js * 8192, bb + 16384, qr, lut, near, cfar, qw + r32, kmin, lane, r32, hi);
        }
        if (t + 2 < NT) asm volatile("s_waitcnt vmcnt(4) lgkmcnt(0)" ::: "memory"); else asm volatile("s_waitcnt vmcnt(0) lgkmcnt(0)" ::: "memory");
        if (!(VAR & 16)) __builtin_amdgcn_s_barrier(); asm volatile("" ::: "memory");
        sn2 = sc_; sc_ = (sc_ == 2) ? 0 : sc_ + 1;
    }
#undef DIFF_ISSUE
    l += __shfl_xor(l, 32);
    if (hi == 0) wsf[r32] = l;
    LDS_WAIT();
    const float sc = js ? lam : 1.0f;
#pragma unroll
    for (int r = 0; r < 16; ++r) { const float rl = sc * __builtin_amdgcn_rcpf(wsf[crow(r, hi)]);
#pragma unroll
        for (int db = 0; db < 4; ++db) o[db][r] *= rl; }
    LAS float* xch = (LAS float*)(F.lds + wq * 16384);
    if (js) {
#pragma unroll
        for (int db = 0; db < 4; ++db)
#pragma unroll
            for (int r = 0; r < 16; ++r) xch[(db * 16 + r) * 64 + lane] = o[db][r];
    }
    asm volatile("s_waitcnt lgkmcnt(0)" ::: "memory"); __syncthreads();
    if (!js && !(VAR & 32)) diff_epilogue(F, o, xch, subg, lam_init, Odst + (rowbase + qw) * 512 + h * 128);
    asm volatile("s_waitcnt lgkmcnt(0)" ::: "memory"); __syncthreads();
}
__device__ __forceinline__ void diff_epilogue(Frame& F, f32x16 (&o)[4], LAS float* xch, const float* subg, float lam_init, bf16* Ow) {
    int lane = F.lane; asm volatile("" : "+v"(lane));
    const int r32 = lane & 31, hi = lane >> 5;
    float ssq[16];
#pragma unroll
    for (int r = 0; r < 16; ++r) { float s = 0.f;
#pragma unroll
        for (int db = 0; db < 4; ++db) { const float v = o[db][r] - xch[(db * 16 + r) * 64 + lane]; o[db][r] = v; s += v * v; }
        ssq[r] = s; }
#pragma unroll
    for (int r = 0; r < 16; ++r) { float s = ssq[r]; s += __shfl_xor(s, 1); s += __shfl_xor(s, 2); s += __shfl_xor(s, 4); s += __shfl_xor(s, 8); s += __shfl_xor(s, 16);
        ssq[r] = (1.0f - lam_init) * __builtin_amdgcn_rsqf(s * (1.0f / 128.0f) + EPS); }
    float sg[4];
#pragma unroll
    for (int db = 0; db < 4; ++db) sg[db] = subg[32 * db + r32];
    LDS_WAIT();
    LAS bf16* stl = (LAS bf16*)xch;
#pragma unroll
    for (int r = 0; r < 16; ++r) { const int orow = crow(r, hi);
#pragma unroll
        for (int db = 0; db < 4; ++db) stl[orow * 128 + db * 32 + r32] = (bf16)(cvt_pk_bf16(o[db][r] * ssq[r] * sg[db], 0.f) & 0xffffu); }
    LDS_WAIT();
#pragma unroll
    for (int i = 0; i < 8; ++i) { const int row = i * 4 + (lane >> 4), ch = lane & 15; const u32x4 v = *(const LAS u32x4*)(stl + row * 128 + ch * 8); *(u32x4*)(Ow + (long)row * 512 + ch * 8) = v; }
}

__device__ __forceinline__ void sb_unit(Frame& F, int b, int h, int blk) {
    const int lane = F.lane, r32 = lane & 31, hi = lane >> 5, wid = F.wave;
    bf16* SBQ = (bf16*)(F.ws + WS_SBQ); const bf16* SBK = (const bf16*)(F.ws + WS_SBK); const bf16* SBV = (const bf16*)(F.ws + WS_SBV);
    const long rowbase = (long)b * SEQ; const int qw = 32 * blk; const int qrow = qw + r32;
    LAS unsigned char* kb_ = F.lds + wid * 16384; LAS unsigned char* vb_ = kb_ + 8192;
    bf16x8 qr[4];
#pragma unroll
    for (int d0 = 0; d0 < 4; ++d0) qr[d0] = *(const bf16x8*)(SBQ + (rowbase + qrow) * 512 + h * 64 + d0 * 16 + hi * 8);
    f32x16 o[2];
#pragma unroll
    for (int i = 0; i < 2; ++i)
#pragma unroll
        for (int r = 0; r < 16; ++r) o[i][r] = 0.f;
    float carry = 0.f;
    const bf16* ksrc = SBK + (rowbase + (lane >> 3)) * 512 + h * 64;
    const bf16* vsrc = SBV + (rowbase + (lane >> 2)) * 512 + h * 64 + (lane & 3) * 8;
    const LAS unsigned char* kp = kb_ + r32 * 128; const int ksw = (r32 >> 1) & 7;
    const LAS unsigned char* vp = vb_ + ((lane >> 4) & 1) * 32 + (lane & 3) * 8 + (4 * hi + ((lane & 15) >> 2)) * 64;
#define SB_ISSUE_K(t_) do { _Pragma("unroll") for (int c = 0; c < 8; ++c) { const int kr_ = 8 * c + (lane >> 3); glds(ksrc + (long)(64 * (t_) + 8 * c) * 512 + (((lane & 7) ^ ((kr_ >> 1) & 7)) * 8), kb_ + c * 1024); } } while (0)
#define SB_ISSUE_V(t_) do { _Pragma("unroll") for (int p = 0; p < 8; ++p) glds(vsrc + (long)(64 * (t_) + 16 * (p & 3)) * 512 + (p >> 2) * 32, vb_ + p * 1024); } while (0)
    const int t0 = qw >> 6;
    asm volatile("s_waitcnt lgkmcnt(0)" ::: "memory");
    SB_ISSUE_K(t0); SB_ISSUE_V(t0);
    for (int t = t0; t >= 0; --t) {
        const int kmin = 64 * t;
        asm volatile("s_waitcnt vmcnt(8)" ::: "memory");
        bf16x8 kf[8];
#pragma unroll
        for (int d0 = 0; d0 < 4; ++d0) { const int so = (((2 * d0 + hi) ^ ksw) << 4); kf[2 * d0] = *(const LAS bf16x8*)(kp + so); kf[2 * d0 + 1] = *(const LAS bf16x8*)(kp + 4096 + so); }
        asm volatile("s_waitcnt lgkmcnt(0)" ::: "memory");
        if (t > 0) SB_ISSUE_K(t - 1);
        f32x16 p0, p1;
#pragma unroll
        for (int r = 0; r < 16; ++r) { p0[r] = 0.f; p1[r] = 0.f; }
#pragma unroll
        for (int d0 = 0; d0 < 4; ++d0) { p0 = __builtin_amdgcn_mfma_f32_32x32x16_bf16(kf[2 * d0], qr[d0], p0, 0, 0, 0); p1 = __builtin_amdgcn_mfma_f32_32x32x16_bf16(kf[2 * d0 + 1], qr[d0], p1, 0, 0, 0); }
        float Lb[8][4], T_own[8], T_oth[8];
#pragma unroll
        for (int i = 0; i < 8; ++i) {
#pragma unroll
            for (int e = 0; e < 4; ++e) { const float y = (i < 4) ? p0[4 * i + e] : p1[4 * (i - 4) + e]; const int key = kmin + 8 * i + 4 * hi + e;
                const float sp = fmaxf(y, 0.f) + flog2(1.f + fexp2(-fabsf(y)));
                Lb[i][e] = (key < qrow) ? sp : 0.f; }
            T_own[i] = (Lb[i][0] + Lb[i][1]) + (Lb[i][2] + Lb[i][3]);
        }
#pragma unroll
        for (int i = 0; i < 8; ++i) T_oth[i] = __shfl_xor(T_own[i], 32);
        float after = carry;
#pragma unroll
        for (int i = 7; i >= 0; --i) {
            const float off = after + (hi == 0 ? T_oth[i] : 0.f);
            after += T_own[i] + T_oth[i];
            float suf = off;
#pragma unroll
            for (int e = 3; e >= 0; --e) { const float y = (i < 4) ? p0[4 * i + e] : p1[4 * (i - 4) + e]; const int key = kmin + 8 * i + 4 * hi + e;
                const float a = (key < qrow) ? fexp2(y - Lb[i][e] - suf) : 0.f; suf += Lb[i][e];
                if (i < 4) p0[4 * i + e] = a; else p1[4 * (i - 4) + e] = a; }
        }
        carry = after;
        bf16x8 pa[4]; pack_p(p0, p1, pa);
        if (t > 0) asm volatile("s_waitcnt vmcnt(8)" ::: "memory"); else asm volatile("s_waitcnt vmcnt(0)" ::: "memory");
        pv_mma<2>(o, vp, pa);
        asm volatile("s_waitcnt lgkmcnt(0)" ::: "memory");
#if SB_EARLY_EXIT
        if (__all(carry > 150.f)) break;
#endif
        if (t > 0) SB_ISSUE_V(t - 1);
    }
#undef SB_ISSUE_K
#undef SB_ISSUE_V
    asm volatile("s_waitcnt vmcnt(0) lgkmcnt(0)" ::: "memory");
    LAS bf16* stl = (LAS bf16*)kb_;
#pragma unroll
    for (int r = 0; r < 16; ++r) { const int orow = crow(r, hi);
#pragma unroll
        for (int db = 0; db < 2; ++db) stl[orow * 64 + db * 32 + r32] = (bf16)(cvt_pk_bf16(o[db][r], 0.f) & 0xffffu); }
    LDS_WAIT();
    bf16* Ow = SBQ + (rowbase + qw) * 512 + h * 64;
#pragma unroll
    for (int i = 0; i < 4; ++i) { const int row = i * 8 + (lane >> 3), ch = lane & 7; const u32x4 v = *(const LAS u32x4*)(stl + row * 64 + ch * 8); *(u32x4*)(Ow + (long)row * 512 + ch * 8) = v; }
    asm volatile("s_waitcnt lgkmcnt(0)" ::: "memory");
}

__device__ __forceinline__ int t5_bucket(int n) {
    if (n < 16) return n;
    int b = 16;
    const int thr[15] = {19, 21, 24, 27, 31, 35, 40, 46, 52, 59, 67, 77, 87, 99, 113};
#pragma unroll
    for (int j = 0; j < 15; ++j) b += (n >= thr[j]) ? 1 : 0;
    return b;
}

__device__ __forceinline__ void attention_phase(Frame& F, int l) {
    const float* relb = KIN(1); const float* gq = KIN(4) + l * 64; const float* gk = KIN(5) + l * 64;
    LAS float* scal = (LAS float*)(F.lds + WSF_OFF);
    if (F.wave == 0) { const int d = F.lane;
        float a1 = KIN(6)[l * 64 + d] * KIN(7)[l * 64 + d], a2 = KIN(8)[l * 64 + d] * KIN(9)[l * 64 + d], mq = fabsf(gq[d]), mk = fabsf(gk[d]);
        a1 = wave_sum(a1); a2 = wave_sum(a2);
#pragma unroll
        for (int o = 1; o < 64; o <<= 1) { mq = fmaxf(mq, __shfl_xor(mq, o)); mk = fmaxf(mk, __shfl_xor(mk, o)); }
        if (d == 0) { scal[0] = a1; scal[1] = a2; scal[2] = mq; scal[3] = mk; } }
    if (F.tid >= 64 && F.tid < 192) scal[16 + F.tid - 64] = relb[F.tid - 64];
    __syncthreads();
    const float s1 = scal[0], s2 = scal[1], gqm = scal[2], gkm = scal[3];
    const float lam_init = 0.8f - 0.6f * expf(-0.3f * (float)l);
    const float lam = expf(s1) - expf(s2) + lam_init;
    float lutv;
    {
        const int h = F.tid >> 7, d = F.tid & 127; float mb = -3.0e38f;
        for (int bkt = 0; bkt < 32; ++bkt) mb = fmaxf(mb, scal[16 + bkt * 4 + h]);
        const float M = 8.f * gqm * gkm + mb;
        lutv = (scal[16 + t5_bucket(d) * 4 + h] - M) * LOG2E;
    }
    __syncthreads();
    ((LAS float*)(F.lds + LUT_OFF))[F.tid] = lutv;
    __syncthreads();
    const float* subg = KIN(10) + l * 128;
#ifndef ATT_MASK
#define ATT_MASK 3
#endif
#ifndef DIFF_VARIANT
#define DIFF_VARIANT -1
#endif
    if (DIFF_VARIANT >= 0) { for (int i = 0;; ++i) { const long L = (long)i * F.G + F.vcu; if (L >= 1024) break;
        const int Lm = (int)(L & 255), bh = Lm >> 3, s = Lm & 7, k = (int)(L >> 8), qb = (k == 0) ? 31 - s : (k == 1) ? 16 + s : (k == 2) ? 15 - s : s;
        diff_unit<(DIFF_VARIANT >= 0 ? DIFF_VARIANT : 0)>(F, bh >> 2, bh & 3, qb, subg, lam, lam_init, (bf16*)(F.ws + WS_XB)); }
        __syncthreads(); }
    PB_START(10);
    const int vcu = F.vcu;
    if (ATT_MASK & 1) for (int i = 0;; ++i) { const long L = (long)i * F.G + vcu; if (L >= 1024) break;
        const int Lm = (int)(L & 255), bh = Lm >> 3, s = Lm & 7, k = (int)(L >> 8), qb = (k == 0) ? 31 - s : (k == 1) ? 16 + s : (k == 2) ? 15 - s : s;
        diff_unit<0>(F, bh >> 2, bh & 3, qb, subg, lam, lam_init, (bf16*)(F.ws + WS_DQ)); }
    __syncthreads();
    PB_END(10);
    PB_START(11);
    const int gw = F.vcu * NWAVES + F.wave, NGW = F.G * NWAVES;
    if ((ATT_MASK & 2) && F.local_ok) {
        const int xg = F.vcu >> 5; unsigned* q = (unsigned*)(F.ctl + CW_SBQ) + 64 * (2 * xg + l);
        unsigned nxt = 0; if (F.lane == 0) nxt = xb_add(q, 1u);
        nxt = (unsigned)__builtin_amdgcn_readfirstlane((int)nxt);
        for (;;) { const unsigned u = nxt; if (u >= 1024u) break;
            unsigned n2 = 0; if (F.lane == 0) n2 = xb_add(q, 1u);
            sb_unit(F, xg, (int)(u & 7u), 127 - (int)(u >> 3));
            nxt = (unsigned)__builtin_amdgcn_readfirstlane((int)n2); }
    } else if (ATT_MASK & 2) for (int i = 0;; ++i) { int bh, x;
        if (F.G == 256) { const int xg = F.vcu >> 5, lw = (F.vcu & 31) * NWAVES + F.wave, pp = (i >> 1) * 256 + lw; if (pp >= 512) break; bh = 8 * xg + (pp >> 6); x = pp & 63; }
        else { const long p = (long)(i >> 1) * NGW + gw; if (p >= 4096) break; bh = (int)(p >> 6); x = (int)(p & 63); }
        const int blk = (i & 1) ? 127 - x : x;
        sb_unit(F, bh >> 3, bh & 7, blk); }
    __syncthreads();
    PB_END(11);
}

constexpr int NPHASE = 1 + 8 * DEPTH;
__global__ void __launch_bounds__(NWAVES * 64, 2) mk_fwd(Args args) {
    extern __shared__ __attribute__((aligned(16))) unsigned char lds_raw[];
    Frame F;
    F.lds = (LAS unsigned char*)lds_raw;
    F.MISC = (volatile LAS unsigned*)(F.lds + MISC_OFF);
    F.tid = threadIdx.x; F.lane = F.tid & 63; F.wave = __builtin_amdgcn_readfirstlane(F.tid >> 6); F.G = gridDim.x;
    F.ws = args.ws; F.ctl = (gu32*)(args.ws + WS_CTL); F.out = args.out;
    for (int u = F.tid; u < (LDS_BYTES - LDSCTL_OFF) / 4; u += NWAVES * 64) ((LAS unsigned*)(F.lds + LDSCTL_OFF))[u] = 0u;
    __syncthreads();
    const unsigned my_xcc = xb_xcc_id(); unsigned my_rank = 0;
    if (F.tid == 0) my_rank = __hip_atomic_fetch_add((unsigned*)(F.ctl + CW_XRANK) + my_xcc, 1u, RLX_AGENT);
    my_rank = (unsigned)__builtin_amdgcn_readfirstlane((int)my_rank);
    if (F.tid == 0) ((volatile LAS unsigned*)(F.lds + MISC_OFF))[12] = my_rank;
    __syncthreads();
    my_rank = ((volatile LAS unsigned*)(F.lds + MISC_OFF))[12];
    F.vcu = (int)blockIdx.x; F.cx = (int)blockIdx.x; F.local_ok = 0;
    XcdBarrier bar; bar.bar = (unsigned*)(F.ctl + CW_BAR); bar.x = 0; bar.st = nullptr;
    if (!MK_SPLIT) bar = xcd_barrier_post((unsigned*)(F.ctl + CW_BAR), F.MISC + 8);
    F.pb_t0 = 0; F.pb_acc = 0;
    const int lo = args.ph_lo, hi = args.ph_hi;
#define IN(k) (lo <= (k) && (k) < hi)
#define SEAM(k) do { if (IN(k) && IN((k) + 1)) xcd_barrier(bar); } while (0)
#define SEAM_L(k) do { if (IN(k) && IN((k) + 1)) { if (F.local_ok) xcc_barrier((unsigned*)(F.ctl + CW_LBAR), my_xcc, (unsigned)F.G / 8u, (unsigned*)(F.ctl + CW_BAR) + XB_TMO); else xcd_barrier(bar); } } while (0)
#define REFRESH() int gw, NGW, c; do { int t_ = threadIdx.x; asm volatile("" : "+v"(t_)); F.tid = t_; F.lane = t_ & 63; F.wave = __builtin_amdgcn_readfirstlane(t_ >> 6); \
        gw = F.vcu * NWAVES + F.wave; NGW = F.G * NWAVES; c = F.cx; (void)gw; (void)NGW; (void)c; } while (0)

    PB_START(0);
    if (PH_ON(0) && IN(0)) { REFRESH();
        convert_small_weights(F, gw, NGW);
        convert_moe_weights(F, 0, gw, NGW);
        rows_phase<false, false, false, true>(F, KIN(0), nullptr, 2 * gw, 2 * NGW, T);
    }
    SEAM(0);
    PB_END(0);
    if (!MK_SPLIT) {
        LAS unsigned* xc = (LAS unsigned*)(F.lds + WSF_OFF);
        if (F.tid < 16) xc[F.tid] = __hip_atomic_load((unsigned*)(F.ctl + CW_XRANK) + F.tid, RLX_AGENT);
        __syncthreads();
        unsigned pre = 0, tot = 0, uni = 1u;
#pragma unroll
        for (unsigned j = 0; j < 16; ++j) { const unsigned cj = xc[j]; pre += (j < my_xcc) ? cj : 0u; tot += cj; uni &= (cj == 0u || cj * 8u == (unsigned)F.G) ? 1u : 0u; }
        F.local_ok = (uni && tot == (unsigned)F.G && F.G == 256) ? 1 : 0;
        if (tot == (unsigned)F.G) { F.vcu = (int)(pre + my_rank); const int per = F.G / 8; F.cx = (F.G % 8 == 0) ? (F.vcu % per) * 8 + F.vcu / per : F.vcu; }
        __syncthreads(); }
#pragma nounroll
    for (int l = 0; l < DEPTH; ++l) {
        const int pb = 1 + 8 * l;
        PB_START(1);
        if (PH_ON(1) && IN(pb + 0)) {   REFRESH();
            SchedPlain S{(const char*)(F.ws + WS_XB), (const char*)(F.ws + WS_WIN_T) + (size_t)l * NIN * D * 2, 128, 20, D, F.G, c, (const int*)(F.ws + WS_RSTD1), nullptr};
            LAS float* gl = (LAS float*)(F.lds + LUT_OFF);
            if (F.tid < 128) gl[F.tid] = (F.tid < 64) ? KIN(4)[l * 64 + F.tid] * C2 : KIN(5)[l * 64 + F.tid - 64];
            __syncthreads();
            EpiInProj E{F.ws, gl, (const LAS float*)(F.lds + AUX_OFF)};
            pg8::gemm_phase<EpiInProj, SchedPlain>(F.lds, D, S, E);
        }
        SEAM_L(pb + 0);
        PB_END(1);
        PB_START(2);
        if (PH_ON(2) && IN(pb + 1)) { REFRESH(); attention_phase(F, l); }
        SEAM_L(pb + 1);
        PB_END(2);
        PB_START(3);
        if (PH_ON(3) && IN(pb + 2)) {   REFRESH();
            SchedBranch S{(const char*)(F.ws + WS_DQ), (const char*)(F.ws + WS_SBQ), (const char*)(F.ws + WS_WBD_T) + (size_t)l * D * 512 * 2, (const char*)(F.ws + WS_WBS_T) + (size_t)l * D * 512 * 2, F.G, c};
            EpiBranch E{(const unsigned char*)(F.ws + WS_G1), (bf16*)(F.ws + WS_MIXED)};
            pg8::gemm_phase<EpiBranch, SchedBranch>(F.lds, 512, S, E);
        }
        SEAM_L(pb + 2);
        PB_END(3);
        PB_START(4);
        if (PH_ON(4) && IN(pb + 3)) {   REFRESH();
            SchedPlain S{(const char*)(F.ws + WS_MIXED), (const char*)(F.ws + WS_WOUT_T) + (size_t)l * D * D * 2, 128, 4, D, F.G, c};
            EpiOutProj E{(bf16*)(F.ws + WS_XB), (unsigned char*)(F.ws + WS_XB8)};
            pg8::gemm_phase<EpiOutProj, SchedPlain>(F.lds, D, S, E);
        }
        SEAM_L(pb + 3);
        PB_END(4);
        PB_START(5);
        if (PH_ON(5) && IN(pb + 4)) { REFRESH(); router_phase(F, l); }
        SEAM(pb + 4);
        PB_END(5);
        PB_START(7);
        if (PH_ON(7) && IN(pb + 5)) {   REFRESH();
            build_ust(F, l);
            SchedMoe<true> S{(const char*)(F.ws + WS_XB8), (const char*)(F.ws + WS_WGU_T), (const LAS int*)(F.lds + MOE_OFF), (const int*)(F.ws + WS_ENT_TOK), (const int*)(F.ws + WS_ENT_RS), nullptr, D / 2, (size_t)1024 * 1024, F.G, c};
            EpiMoe1 E{(const LAS float*)(F.lds + AUX_OFF), (unsigned char*)(F.ws + WS_ACT)};
            pg8::gemm_phase<EpiMoe1, SchedMoe<true>>(F.lds, D / 2, S, E);
        }
        SEAM_L(pb + 5);
        PB_END(7);
        PB_START(8);
        if (PH_ON(8) && IN(pb + 6)) {   REFRESH();
            build_ust(F, l);
            SchedMoe<false> S{(const char*)(F.ws + WS_ACT), (const char*)(F.ws + WS_WDN_T), (const LAS int*)(F.lds + MOE_OFF), (const int*)(F.ws + WS_IDENT), (const int*)(F.ws + WS_ENT_TOK), (const int*)(F.ws + WS_ENT_W), DFF / 2, (size_t)1024 * 512, F.G, c};
            EpiMoe2 E{(const LAS int*)(F.lds + AUX_OFF), (unsigned char*)(F.ws + WS_CONTRIB)};
            pg8::gemm_phase<EpiMoe2, SchedMoe<false>>(F.lds, DFF / 2, S, E);
        }
        SEAM(pb + 6);
        PB_END(8);
        PB_START(9);
        if (PH_ON(9) && IN(pb + 7)) {   REFRESH();
            const int per = F.G / 8, xg = F.vcu / per, lw = (F.vcu % per) * NWAVES + F.wave; const bool al = (F.G == 256);
            const int mf = al ? 4096 * xg + 2 * lw : 2 * gw, ms = al ? 512 : 2 * NGW, me = al ? 4096 * xg + 4096 : T;
            if (l + 1 < DEPTH) { rows_phase<true, true, false, true>(F, nullptr, nullptr, mf, ms, me); convert_moe_weights(F, l + 1, gw, NGW); }
            else rows_phase<true, true, true, false>(F, nullptr, F.out, mf, ms, me);
        }
        if (l + 1 < DEPTH) SEAM_L(pb + 7);
        PB_END(9);
    }
    if (PROBE_TYPE >= 0 && blockIdx.x == 0 && threadIdx.x == 0) { const unsigned long long te = __builtin_amdgcn_s_memrealtime();
        while (__builtin_amdgcn_s_memrealtime() - te < PROBE_AMP * F.pb_acc) __builtin_amdgcn_s_sleep(8); }
#undef IN
#undef SEAM
}

extern "C" void kernel_launch(void* const* d_in, const int* in_sizes, int n_in, void* d_out, int out_size, void* d_ws, size_t ws_size, hipStream_t stream) {
    static int grid = 0;
    if (grid == 0) {
        if (n_in != 20 || in_sizes[0] != T * D || out_size != T * D || ws_size < WS_END) { fprintf(stderr, "kernel_launch: unexpected shapes / workspace (n_in %d, ws %zu, need %zu)\n", n_in, ws_size, (size_t)WS_END); grid = -1; return; }
        int dev = 0, cus = 0, per_cu = 0;
        if (hipGetDevice(&dev) != hipSuccess || hipDeviceGetAttribute(&cus, hipDeviceAttributeMultiprocessorCount, dev) != hipSuccess) { grid = -1; return; }
        if (hipFuncSetAttribute((const void*)mk_fwd, hipFuncAttributeMaxDynamicSharedMemorySize, LDS_BYTES) != hipSuccess) { fprintf(stderr, "kernel_launch: hipFuncSetAttribute failed\n"); grid = -1; return; }
        if (hipOccupancyMaxActiveBlocksPerMultiprocessor(&per_cu, (const void*)mk_fwd, NWAVES * 64, LDS_BYTES) != hipSuccess || per_cu < 1) fprintf(stderr, "kernel_launch: occupancy query reports %d\n", per_cu);
        (void)hipGetLastError();
        grid = cus;
    }
    if (grid < 0) return;
    if (hipMemsetAsync((char*)d_ws + WS_CTL, 0, CTL_ZERO_BYTES, stream) != hipSuccess) return;
    Args a{};
    for (int i = 0; i < 20; ++i) a.in[i] = (const float*)d_in[i];
    a.out = (float*)d_out; a.ws = (unsigned char*)d_ws;
#if MK_SPLIT
    for (int p = 0; p < NPHASE; ++p) { a.ph_lo = p; a.ph_hi = p + 1; hipLaunchKernelGGL(mk_fwd, dim3(grid), dim3(NWAVES * 64), LDS_BYTES, stream, a); }
#else
    a.ph_lo = 0; a.ph_hi = NPHASE;
    hipLaunchKernelGGL(mk_fwd, dim3(grid), dim3(NWAVES * 64), LDS_BYTES, stream, a);
#endif
}
```

```cpp
#include <hip/hip_runtime.h>
#include <cstdio>
#include <cstdint>

#define GAS __attribute__((address_space(1)))
#define LAS __attribute__((address_space(3)))
typedef unsigned short bf16;
typedef short bf16x8 __attribute__((ext_vector_type(8)));
typedef short s16x4 __attribute__((ext_vector_type(4)));
typedef short v4i16_t __attribute__((ext_vector_type(4)));
typedef float f32x2 __attribute__((ext_vector_type(2)));
typedef float f32x4 __attribute__((ext_vector_type(4)));
typedef float f32x16 __attribute__((ext_vector_type(16)));
typedef unsigned u32x2 __attribute__((ext_vector_type(2)));
typedef unsigned u32x4 __attribute__((ext_vector_type(4)));
typedef int v4i_t __attribute__((ext_vector_type(4)));
typedef GAS unsigned gu32;

constexpr int T = 32768, SEQ = 4096, NB = 8, D = 1024, NIN = 5120, DEPTH = 2;
constexpr int NE = 32, DFF = 512;
constexpr float EPS = 1e-6f;
constexpr float LOG2E = 1.4426950408889634f;
constexpr float C2 = 0.125f * LOG2E;
constexpr int NWAVES = 8;
#ifndef SB_EARLY_EXIT
#define SB_EARLY_EXIT 1
#endif
#ifndef MK_SPLIT
#define MK_SPLIT 0
#endif
#ifndef PH_MASK
#define PH_MASK 0x3ff
#endif
#define PH_ON(k) (((PH_MASK) >> (k)) & 1)
#ifndef PROBE_TYPE
#define PROBE_TYPE -1
#endif
#define PROBE_AMP 8
#define PB_START(k) do { if (PROBE_TYPE == (k)) F.pb_t0 = __builtin_amdgcn_s_memrealtime(); } while (0)
#define PB_END(k) do { if (PROBE_TYPE == (k)) F.pb_acc += __builtin_amdgcn_s_memrealtime() - F.pb_t0; } while (0)

constexpr size_t MiB = 1u << 20;
constexpr size_t WS_CTL = 0, CTL_ZERO_BYTES = 1 * MiB;
constexpr size_t WS_RSTD1 = 1 * MiB;
constexpr size_t WS_IDENT = 2 * MiB;
constexpr size_t WS_WR_T = 5 * MiB;
constexpr size_t WS_WIN_T = 8 * MiB;
constexpr size_t WS_WBD_T = 28 * MiB;
constexpr size_t WS_WBS_T = 30 * MiB;
constexpr size_t WS_WOUT_T = 32 * MiB;
constexpr size_t WS_WGU_T = 36 * MiB;
constexpr size_t WS_WDN_T = 100 * MiB;
constexpr size_t WS_XB = 132 * MiB;
constexpr size_t WS_R0 = 196 * MiB;
constexpr size_t WS_DQ = WS_R0;
constexpr size_t WS_DK = WS_R0 + 32 * MiB;
constexpr size_t WS_VA = WS_R0 + 64 * MiB;
constexpr size_t WS_SBQ = WS_R0 + 96 * MiB;
constexpr size_t WS_SBK = WS_R0 + 128 * MiB;
constexpr size_t WS_SBV = WS_R0 + 160 * MiB;
constexpr size_t WS_G1 = WS_R0 + 192 * MiB;
constexpr size_t WS_MIXED = WS_G1;
constexpr int PMAX = 65536 + 32 * 256;
constexpr size_t WS_ACT = WS_SBK;
constexpr size_t WS_XB8 = WS_DK;
constexpr float W8_SCALE = 64.f, A8_SCALE = 2.f, C8_SCALE = 32.f;
constexpr size_t WS_CONTRIB = WS_G1;
constexpr int ECAP = 32768;
constexpr size_t WS_ENT_TOK = 68 * MiB;
constexpr size_t WS_ENT_W = 72 * MiB;
constexpr size_t WS_ENT_RS = 76 * MiB;
constexpr size_t WS_END = WS_R0 + 256 * MiB;

constexpr int CW_BAR = 4096;
constexpr int CW_LBAR = 20480;
constexpr int CW_XRANK = 12288;
constexpr int CW_CNT = 16384;
constexpr int CW_SBQ = 24576;

constexpr int RING_BYTES = 131072;
constexpr int LDSCTL_OFF = RING_BYTES, MISC_OFF = LDSCTL_OFF + 320;
constexpr int LUT_OFF = LDSCTL_OFF + 512;
constexpr int WSF_OFF = LDSCTL_OFF + 2560;
constexpr int MOE_OFF = LDSCTL_OFF + 4608;
constexpr int AUX_OFF = LDSCTL_OFF + 7680;
constexpr int IDT_OFF = LDSCTL_OFF + 5632;
constexpr int LDS_BYTES = 147456;

#define RLX_AGENT __ATOMIC_RELAXED, __HIP_MEMORY_SCOPE_AGENT
#define LDS_WAIT() asm volatile("s_waitcnt lgkmcnt(0)" ::: "memory")
#define VM_WAIT() asm volatile("s_waitcnt vmcnt(0)" ::: "memory")
__device__ __forceinline__ unsigned cvt_pk_bf16(float lo, float hi) { unsigned r; asm volatile("v_cvt_pk_bf16_f32 %0, %1, %2" : "=v"(r) : "v"(lo), "v"(hi)); return r; }
__device__ __forceinline__ float bf_lo(unsigned w) { return __uint_as_float(w << 16); }
__device__ __forceinline__ float bf_hi(unsigned w) { return __uint_as_float(w & 0xffff0000u); }
__device__ __forceinline__ float wave_sum(float v) {
#pragma unroll
    for (int o = 1; o < 64; o <<= 1) v += __shfl_xor(v, o);
    return v;
}
__device__ __forceinline__ u32x2 pack8_fp8(const float (&a)[8]) {
    int w0 = 0, w1 = 0;
    w0 = __builtin_amdgcn_cvt_pk_fp8_f32(a[0], a[1], w0, false); w0 = __builtin_amdgcn_cvt_pk_fp8_f32(a[2], a[3], w0, true);
    w1 = __builtin_amdgcn_cvt_pk_fp8_f32(a[4], a[5], w1, false); w1 = __builtin_amdgcn_cvt_pk_fp8_f32(a[6], a[7], w1, true);
    u32x2 r; r.x = (unsigned)w0; r.y = (unsigned)w1; return r;
}
__device__ __forceinline__ float fexp2(float x) { return __builtin_amdgcn_exp2f(x); }
__device__ __forceinline__ float flog2(float x) { return __builtin_amdgcn_logf(x); }

#define XB_TMO      128
#define XB_XCNT(j)  (256  + 64 * (j))
#define XB_XSUB(j)  (1280 + 64 * (j))
#define XB_XGEN(j)  (2304 + 64 * (j))
#define XB_TOP      3328
#define XB_TOPGEN   3392
#define XCD_BAR_WORDS 3456
#define XB_SPIN_CAP (1u << 23)
__device__ __forceinline__ unsigned xb_ld(unsigned* p)              { return __hip_atomic_load(p, __ATOMIC_RELAXED, __HIP_MEMORY_SCOPE_AGENT); }
__device__ __forceinline__ unsigned xb_add(unsigned* p, unsigned v) { return __hip_atomic_fetch_add(p, v, __ATOMIC_RELAXED, __HIP_MEMORY_SCOPE_AGENT); }
__device__ __forceinline__ unsigned xb_xcc_id() { return (unsigned)__builtin_amdgcn_s_getreg((3 << 11) | 20) & 0xFu; }
#define XB_SPIN(cond, bar) do { unsigned _sp = 0; while (cond) { __builtin_amdgcn_s_sleep(1); \
    if ((++_sp & 255u) == 0u) { if (xb_ld(&(bar)[XB_TMO])) break; if (_sp > XB_SPIN_CAP) { atomicAdd(&(bar)[XB_TMO], 1u); break; } } } } while (0)
struct XcdBarrier { unsigned* bar; unsigned x; volatile LAS unsigned* st; };
__device__ __forceinline__ XcdBarrier xcd_barrier_post(unsigned* bar, volatile LAS unsigned* st) {
    XcdBarrier b; b.bar = bar; b.x = xb_xcc_id(); b.st = st;
    if (threadIdx.x == 0) (void)xb_add(&bar[XB_XCNT(b.x)], 1u);
    return b;
}
__device__ __forceinline__ void xcd_barrier_complete(unsigned* bar, unsigned x, unsigned& nloc, unsigned& nx) {
    const unsigned G = gridDim.x * gridDim.y * gridDim.z;
    unsigned sum, cnt, mine, sp = 0u;
    for (;;) {
        sum = 0u; cnt = 0u; mine = 0u;
#pragma unroll
        for (unsigned j = 0; j < 16; ++j) { const unsigned c = xb_ld(&bar[XB_XCNT(j)]); sum += c; cnt += (c > 0u) ? 1u : 0u; mine = (j == x) ? c : mine; }
        if (sum == G) break;
        __builtin_amdgcn_s_sleep(1);
        if ((++sp & 255u) == 0u) { if (xb_ld(&bar[XB_TMO])) break; if (sp > XB_SPIN_CAP) { atomicAdd(&bar[XB_TMO], 1u); break; } }
    }
    nloc = mine > 0u ? mine : 1u; nx = cnt > 0u ? cnt : 1u;
}
__device__ __forceinline__ void xcd_barrier(const XcdBarrier& b) {
    asm volatile("s_waitcnt vmcnt(0)" ::: "memory");
    __syncthreads();
    if (threadIdx.x == 0) {
        unsigned* bar = b.bar;
        __builtin_amdgcn_s_waitcnt(0);
        unsigned nloc = b.st[0], nx = b.st[1];
        if (nloc == 0u) { xcd_barrier_complete(bar, b.x, nloc, nx); b.st[0] = nloc; b.st[1] = nx; }
        const unsigned old = xb_add(&bar[XB_XSUB(b.x)], 1u);
        const unsigned gen = old / nloc;
        if (old + 1u == (gen + 1u) * nloc) {
            __builtin_amdgcn_fence(__ATOMIC_RELEASE, "agent");
            asm volatile("s_waitcnt vmcnt(0)" ::: "memory");
            const unsigned og = xb_add(&bar[XB_TOP], 1u);
            const unsigned tg = og / nx;
            if (og + 1u == (tg + 1u) * nx) xb_add(&bar[XB_TOPGEN], 1u);
            else XB_SPIN(xb_ld(&bar[XB_TOPGEN]) == tg, bar);
            __builtin_amdgcn_fence(__ATOMIC_ACQUIRE, "agent");
            xb_add(&bar[XB_XGEN(b.x)], 1u);
            asm volatile("s_waitcnt vmcnt(0)" ::: "memory");
        } else {
            XB_SPIN(xb_ld(&bar[XB_XGEN(b.x)]) == gen, bar);
            __builtin_amdgcn_fence(__ATOMIC_ACQUIRE, "agent");
            asm volatile("s_waitcnt vmcnt(0)" ::: "memory");
        }
    }
    __syncthreads();
}

__device__ __forceinline__ void xcc_barrier(unsigned* lb, unsigned x, unsigned nloc, unsigned* tmo) {
    asm volatile("s_waitcnt vmcnt(0)" ::: "memory");
    __syncthreads();
    if (threadIdx.x == 0) {
        const unsigned old = xb_add(&lb[64 * x], 1u), gen = old / nloc;
        if (old + 1u == (gen + 1u) * nloc) xb_add(&lb[1024 + 64 * x], 1u);
        else { unsigned sp = 0; while (xb_ld(&lb[1024 + 64 * x]) == gen) { __builtin_amdgcn_s_sleep(1);
                   if ((++sp & 255u) == 0u) { if (xb_ld(tmo)) break; if (sp > XB_SPIN_CAP) { atomicAdd(tmo, 1u); break; } } } }
        __builtin_amdgcn_fence(__ATOMIC_ACQUIRE, "agent");
        asm volatile("s_waitcnt vmcnt(0)" ::: "memory");
    }
    __syncthreads();
}

namespace pg8 {
constexpr int BM = 256, BK = 64, HALF = 128, HTB = HALF * BK * 2, STAGE_BYTES = 8 * HTB, NXCD = 8, WGM = 8;
__host__ __device__ __forceinline__ int lds_byte(int r, int c) { const int st = (r >> 4) * 2 + (c >> 5), rr = r & 15, cc = c & 31, ob = rr * 64 + cc * 2; return st * 1024 + (ob ^ (((ob >> 9) & 1) << 5)); }
__host__ __device__ __forceinline__ void stage_rc(int b, int& R, int& C) { const int st = b / 1024, sb = b % 1024, swz = sb ^ (((sb >> 9) & 1) << 5); R = (st >> 1) * 16 + swz / 64; C = (st & 1) * 32 + (swz % 64) / 2; }
__host__ __device__ __forceinline__ int perm32(int rho) { const int n = rho >> 4, i = rho & 15; return 8 * (i >> 2) + 4 * n + (i & 3); }

struct Unit { const char* A; const char* B; int pm, pn, kind, eoff, nvalid, goff, gnv, slot; };
constexpr int KEEP = 0x100;

__device__ __forceinline__ void tile_order(int L, int nM, int nN, int& pm, int& pn) {
    const int nwg = nM * nN; int wgid = L;
    { const int q = nwg / NXCD, r = nwg % NXCD, xcd = wgid % NXCD, off = wgid / NXCD; wgid = (xcd < r ? xcd * (q + 1) : r * (q + 1) + (xcd - r) * q) + off; }
    const int nig = WGM * nN, gid = wgid / nig, fm = gid * WGM, gsz = (nM - fm) < WGM ? (nM - fm) : WGM;
    pm = fm + ((wgid % nig) % gsz); pn = (wgid % nig) / gsz;
}

template <class Epi, class Sched, bool ALIGN_EPI = true, bool SP2 = true>
__device__ __forceinline__ void gemm_phase(LAS unsigned char* lds, const int K_, const Sched& S, const Epi& E, unsigned long long* pb = nullptr) {
    int tid_ = threadIdx.x; asm volatile("" : "+v"(tid_));
    const int tid = tid_, wid = __builtin_amdgcn_readfirstlane(tid >> 6), lane = tid & 63, wr = wid >> 2, wc = wid & 3, fr = lane & 15, fq = lane >> 4;
    int K = K_; asm volatile("" : "+s"(K));
    const int nt = K / BK;
    unsigned voffA[2], voffB[2]; int gR[2]; unsigned gC[2];
#pragma unroll
    for (int i = 0; i < 2; ++i) { int R, C; stage_rc(tid * 16 + i * 8192, R, C); const int Rb = Epi::PERM ? ((R & ~31) + perm32(R & 31)) : R;
        voffA[i] = (unsigned)(R * K + C) * 2u; voffB[i] = (unsigned)(Rb * K + C) * 2u; gR[i] = R; gC[i] = (unsigned)C * 2u; }
    unsigned voffG[2][2]; (void)gR; (void)gC;
    LAS int* idtab = (LAS int*)(lds + STAGE_BYTES + (IDT_OFF - RING_BYTES));
#define PG8_IDS_DMA(u_, slot) do { if (wid < 4) { int t_ = tid; asm volatile("" : "+v"(t_));   \
        __builtin_amdgcn_global_load_lds((const unsigned*)(S.ids + (u_).goff + t_), (LAS unsigned*)(idtab + (slot) * 256 + wid * 64), 4, 0, 0); } } while (0)
    LAS int* auxt = (LAS int*)(lds + STAGE_BYTES + (AUX_OFF - RING_BYTES));
#define PG8_AUX_DMA(u_) do { if (wid < 4) { int t_ = tid; asm volatile("" : "+v"(t_)); \
        if (S.aux0) __builtin_amdgcn_global_load_lds((const unsigned*)(S.aux0 + (u_).eoff + t_), (LAS unsigned*)(auxt + (u_).slot * 256 + wid * 64), 4, 0, 0); \
        if (S.aux1) __builtin_amdgcn_global_load_lds((const unsigned*)(S.aux1 + (u_).eoff + t_), (LAS unsigned*)(auxt + 768 + (u_).slot * 256 + wid * 64), 4, 0, 0); } } while (0)
#define PG8_IDS_READ(u_, slot) do { _Pragma("unroll") for (int i_ = 0; i_ < 2; ++i_) { int g_ = gR[i_]; asm volatile("" : "+v"(g_)); _Pragma("unroll") for (int h_ = 0; h_ < 2; ++h_) { const int r_ = h_ * 128 + g_; int id_ = idtab[(slot) * 256 + r_]; \
        id_ = (r_ < (u_).gnv) ? (id_ >> 1) : 0; voffG[h_][i_] = (unsigned)id_ * (unsigned)(K * 2) + gC[i_]; } } } while (0)
#define PG8_STAGE_A(buf, h, gbase) do { if constexpr (Sched::GATHER) { PG8_STAGE(PG8_SA(buf, h), gbase, voffG[h]); } else { PG8_STAGE(PG8_SA(buf, h), (gbase) + (h) * hstep, voffA); } } while (0)
    const size_t kstep = (size_t)(BK * 2);
    const size_t hstep = (size_t)HALF * K * 2;
    const unsigned ldsw = (unsigned)wid * 1024u;
    constexpr bool F8 = Sched::FP8;
    const int aoff = lds_byte(wr * 64 + fr, fq * 8), boff = lds_byte(wc * 32 + fr, fq * 8);
    constexpr int KSTEP = 1024;
#define PG8_SA(b, h) (((b) * 2 + (h)) * HTB)
#define PG8_SB(b, h) ((4 + (b) * 2 + (h)) * HTB)
#define PG8_STAGE(bufoff, gbase, voff) do { _Pragma("unroll") for (int _i = 0; _i < 2; ++_i) \
        __builtin_amdgcn_global_load_lds((const unsigned*)((const char*)(gbase) + (voff)[_i]), (LAS unsigned*)(lds + (bufoff) + ldsw + _i * 8192), 16, 0, 0); } while (0)
#define PG8_LDA(dst, b, h) do { _Pragma("unroll") for (int m = 0; m < 4; ++m) _Pragma("unroll") for (int k = 0; k < 2; ++k) dst[m][k] = *(const LAS bf16x8*)(lds + PG8_SA(b, h) + aoff + m * 2048 + k * KSTEP); } while (0)
#define PG8_LDB(dst, b, h) do { _Pragma("unroll") for (int n = 0; n < 2; ++n) _Pragma("unroll") for (int k = 0; k < 2; ++k) dst[n][k] = *(const LAS bf16x8*)(lds + PG8_SB(b, h) + boff + n * 2048 + k * KSTEP); } while (0)
#define PG8_CAT(x) __builtin_shufflevector(__builtin_bit_cast(v4i_t, (x)[0]), __builtin_bit_cast(v4i_t, (x)[1]), 0, 1, 2, 3, 4, 5, 6, 7)
#define PG8_MMA(ai, bj, At, Bt) do { __builtin_amdgcn_s_setprio(1); if constexpr (F8) { _Pragma("unroll") for (int m = 0; m < 4; ++m) _Pragma("unroll") for (int n = 0; n < 2; ++n) \
        acc[ai][bj][m][n] = __builtin_amdgcn_mfma_scale_f32_16x16x128_f8f6f4(PG8_CAT(Bt[n]), PG8_CAT(At[m]), acc[ai][bj][m][n], 0, 0, 0, 0x7f7f7f7f, 0, 0x7f7f7f7f); } else { \
        _Pragma("unroll") for (int m = 0; m < 4; ++m) _Pragma("unroll") for (int n = 0; n < 2; ++n) _Pragma("unroll") for (int k = 0; k < 2; ++k) \
        acc[ai][bj][m][n] = __builtin_amdgcn_mfma_f32_16x16x32_bf16(Bt[n][k], At[m][k], acc[ai][bj][m][n], 0, 0, 0); } __builtin_amdgcn_s_setprio(0); } while (0)
#define PG8_WAIT_V(n) asm volatile("s_waitcnt vmcnt(" #n ")" ::: "memory")
#define PG8_WAIT_L(n) asm volatile("s_waitcnt lgkmcnt(" #n ")" ::: "memory")
#define PG8_BAR __builtin_amdgcn_s_barrier()
#define PG8_SCHED __builtin_amdgcn_sched_barrier(0)
    Unit cur, nxt; int ui = 0;
    if (!S.next(0, cur)) return;
    f32x4 acc[2][2][4][2];
#pragma unroll
    for (int a = 0; a < 2; ++a)
#pragma unroll
        for (int b = 0; b < 2; ++b)
#pragma unroll
            for (int m = 0; m < 4; ++m)
#pragma unroll
                for (int n = 0; n < 2; ++n) acc[a][b][m][n] = (f32x4){0.f, 0.f, 0.f, 0.f};
    bf16x8 At[4][2], B0[2][2], B1[2][2];
    const char* cA = cur.A; const char* cB = cur.B;
    static_assert(SP2, "only the SP2 loop is kept here");
    cur.slot = 0;
    if constexpr (Sched::GATHER) { PG8_IDS_DMA(cur, 0); PG8_AUX_DMA(cur); PG8_WAIT_V(0); __syncthreads(); PG8_IDS_READ(cur, 0); }
    else if (S.aux0) { PG8_AUX_DMA(cur); PG8_WAIT_V(0); __syncthreads(); }
    PG8_STAGE(PG8_SB(0, 0), cB, voffB); PG8_STAGE(PG8_SB(0, 1), cB + hstep, voffB); PG8_STAGE_A(0, 0, cA); PG8_STAGE_A(0, 1, cA);
    if (wr == 1) PG8_BAR;
    PG8_WAIT_V(2); PG8_BAR;
    PG8_STAGE(PG8_SB(1, 0), cB + kstep, voffB); PG8_STAGE_A(1, 0, cA + kstep); PG8_STAGE(PG8_SB(1, 1), cB + hstep + kstep, voffB);
    PG8_WAIT_V(6); PG8_BAR;
    for (;;) {
        const bool has_next = S.next(ui + 1, nxt);
        const char* nA = has_next ? nxt.A : cA; const char* nB = has_next ? nxt.B : cB;
        nxt.slot = (cur.slot == 2) ? 0 : cur.slot + 1;
        if constexpr (Sched::GATHER) { if (has_next) { PG8_IDS_DMA(nxt, (ui + 1) & 1); PG8_AUX_DMA(nxt); } }
        else { if (has_next && S.aux0) PG8_AUX_DMA(nxt); }
#pragma nounroll
        for (int t = 0; t < nt; t += 2) {
            unsigned long long pbt = 0; if (pb && (PROBE_TYPE == 21 || PROBE_TYPE == 22)) pbt = __builtin_amdgcn_s_memrealtime();
            const bool last = (t == nt - 2);
            const char* a1 = cA + (size_t)(t + 1) * kstep;
            const char* a2 = last ? nA : cA + (size_t)(t + 2) * kstep; const char* b2 = last ? nB : cB + (size_t)(t + 2) * kstep;
            const char* a3 = a2 + kstep; const char* b3 = b2 + kstep;
            PG8_LDB(B0, 0, 0); PG8_LDB(B1, 0, 1); PG8_SCHED; PG8_LDA(At, 0, 0); PG8_STAGE_A(1, 1, a1);
            if constexpr (Sched::GATHER) { if (last && has_next) PG8_IDS_READ(nxt, (ui + 1) & 1); }
            PG8_WAIT_V(8); PG8_WAIT_L(0); PG8_BAR; PG8_MMA(0, 0, At, B0); PG8_MMA(0, 1, At, B1); PG8_BAR; PG8_SCHED;
            PG8_LDA(At, 0, 1); PG8_STAGE(PG8_SB(0, 0), b2, voffB); PG8_STAGE(PG8_SB(0, 1), b2 + hstep, voffB); PG8_STAGE_A(0, 0, a2);
            PG8_WAIT_V(8); PG8_WAIT_L(0); PG8_BAR; PG8_MMA(1, 0, At, B0); PG8_MMA(1, 1, At, B1); PG8_BAR; PG8_SCHED;
            PG8_LDB(B0, 1, 0); PG8_LDB(B1, 1, 1); PG8_SCHED; PG8_LDA(At, 1, 0); PG8_STAGE_A(0, 1, a2);
            PG8_WAIT_V(8); PG8_WAIT_L(0); PG8_BAR; PG8_MMA(0, 0, At, B0); PG8_MMA(0, 1, At, B1); PG8_BAR; PG8_SCHED;
            PG8_LDA(At, 1, 1); PG8_STAGE(PG8_SB(1, 0), b3, voffB); PG8_STAGE(PG8_SB(1, 1), b3 + hstep, voffB); PG8_STAGE_A(1, 0, a3);
            PG8_WAIT_V(8); PG8_WAIT_L(0); PG8_BAR; PG8_MMA(1, 0, At, B0); PG8_MMA(1, 1, At, B1); PG8_BAR; PG8_SCHED;
            if (pb && ((PROBE_TYPE == 21 && t == 0) || (PROBE_TYPE == 22 && t != 0))) *pb += __builtin_amdgcn_s_memrealtime() - pbt;
        }
        unsigned long long pbe = 0; if (pb && PROBE_TYPE == 20) pbe = __builtin_amdgcn_s_memrealtime();
        if constexpr (ALIGN_EPI) { if (wr == 0) PG8_BAR; }
        { unsigned z_ = 0u; asm volatile("" : "+v"(z_));
          const int l_ = (int)__builtin_amdgcn_mbcnt_hi(~0u, __builtin_amdgcn_mbcnt_lo(~0u, z_));
          E(acc, cur, wr, wc, l_ & 15, l_ >> 4); }
        if (pb && PROBE_TYPE == 20) *pb += __builtin_amdgcn_s_memrealtime() - pbe;
        if (!has_next) break;
        if (!(cur.kind & KEEP)) {
#pragma unroll
            for (int a = 0; a < 2; ++a)
#pragma unroll
                for (int b = 0; b < 2; ++b)
#pragma unroll
                    for (int m = 0; m < 4; ++m)
#pragma unroll
                        for (int n = 0; n < 2; ++n) acc[a][b][m][n] = (f32x4){0.f, 0.f, 0.f, 0.f};
        }
        cur = nxt; cA = nA; cB = nB; ++ui;
        if constexpr (ALIGN_EPI) { if (wr == 1) PG8_BAR; }
    }
    PG8_WAIT_V(0);
    if constexpr (!ALIGN_EPI) { if (wr == 0) PG8_BAR; }
    PG8_BAR;
#undef PG8_SA
#undef PG8_SB
#undef PG8_STAGE
#undef PG8_STAGE_A
#undef PG8_IDS_DMA
#undef PG8_AUX_DMA
#undef PG8_IDS_READ
#undef PG8_LDA
#undef PG8_LDB
#undef PG8_MMA
#undef PG8_CAT
#undef PG8_WAIT_V
#undef PG8_WAIT_L
#undef PG8_BAR
#undef PG8_SCHED
}
}

struct Args { const float* in[20]; float* out; unsigned char* ws; int ph_lo, ph_hi; };
#define KIN(i) (((const __attribute__((address_space(4))) Args*)__builtin_amdgcn_kernarg_segment_ptr())->in[i])
struct Frame {
    LAS unsigned char* lds;
    volatile LAS unsigned* MISC;
    gu32* ctl;
    int tid, lane, wave, G;
    int vcu, cx, local_ok;
    unsigned char* ws;
    float* out;
    unsigned long long pb_t0, pb_acc;
};

using pg8::Unit;
typedef f32x4 Acc[2][2][4][2];

struct EpiInProj {
    static constexpr bool PERM = true;
    unsigned char* ws; const LAS float* gl; const LAS float* rs_tab;
    __device__ __forceinline__ void operator()(Acc& acc, const Unit& u, int wr, int wc, int fr, int fq) const {
        const int row0 = u.pm * 256 + wr * 64 + fr; const int pn = u.pn;
        float rs[2][4];
#pragma unroll
        for (int ai = 0; ai < 2; ++ai)
#pragma unroll
            for (int m = 0; m < 4; ++m) rs[ai][m] = rs_tab[u.slot * 256 + wr * 64 + fr + ai * 128 + m * 16];
        if (pn < 4) {
            const LAS float* g = gl + (pn >> 1) * 64 + 8 * fq;
            bf16* dst = (bf16*)(ws + WS_DQ + (size_t)(pn >> 1) * (32 * MiB)) + wc * 128 + (pn & 1) * 64 + 8 * fq;
#pragma unroll
            for (int ai = 0; ai < 2; ++ai)
#pragma unroll
                for (int m = 0; m < 4; ++m) {
                    const int row = row0 + ai * 128 + m * 16; const float r_ = rs[ai][m]; float ss = 0.f; f32x4 v[2][2];
#pragma unroll
                    for (int bj = 0; bj < 2; ++bj)
#pragma unroll
                        for (int n = 0; n < 2; ++n) { v[bj][n] = acc[ai][bj][m][n] * r_; ss += (v[bj][n][0] * v[bj][n][0] + v[bj][n][1] * v[bj][n][1]) + (v[bj][n][2] * v[bj][n][2] + v[bj][n][3] * v[bj][n][3]); }
                    ss += __shfl_xor(ss, 16); ss += __shfl_xor(ss, 32);
                    const float inv = __builtin_amdgcn_rsqf(ss * (1.0f / 64.0f) + EPS);
                    bf16* rowp = dst + (size_t)row * 512;
#pragma unroll
                    for (int bj = 0; bj < 2; ++bj) { const f32x4 g0 = *(const LAS f32x4*)(g + 32 * bj) * inv, g1 = *(const LAS f32x4*)(g + 32 * bj + 4) * inv; u32x4 w;
                        w.x = cvt_pk_bf16(v[bj][0][0] * g0[0], v[bj][0][1] * g0[1]); w.y = cvt_pk_bf16(v[bj][0][2] * g0[2], v[bj][0][3] * g0[3]);
                        w.z = cvt_pk_bf16(v[bj][1][0] * g1[0], v[bj][1][1] * g1[1]); w.w = cvt_pk_bf16(v[bj][1][2] * g1[2], v[bj][1][3] * g1[3]);
                        *(u32x4*)(rowp + bj * 32) = w; }
                }
        } else if (pn < 12) {
            const int sec = (pn - 4) >> 1; bf16* dst = (bf16*)(ws + WS_VA + (size_t)sec * (32 * MiB)) + ((pn - 4) & 1) * 256 + wc * 32 + 8 * fq; const float sc = (sec == 1) ? C2 : 1.f;
#pragma unroll
            for (int ai = 0; ai < 2; ++ai)
#pragma unroll
                for (int m = 0; m < 4; ++m) { const int row = row0 + ai * 128 + m * 16; const float r_ = rs[ai][m] * sc; bf16* rowp = dst + (size_t)row * 512;
#pragma unroll
                    for (int bj = 0; bj < 2; ++bj) { const f32x4 v0 = acc[ai][bj][m][0] * r_, v1 = acc[ai][bj][m][1] * r_; u32x4 w;
                        w.x = cvt_pk_bf16(v0[0], v0[1]); w.y = cvt_pk_bf16(v0[2], v0[3]); w.z = cvt_pk_bf16(v1[0], v1[1]); w.w = cvt_pk_bf16(v1[2], v1[3]);
                        *(u32x4*)(rowp + bj * 128) = w; } }
        } else {
            const int col0 = (pn - 12) * 128 + wc * 32 + 8 * fq; unsigned char* G = ws + WS_G1;
#pragma unroll
            for (int ai = 0; ai < 2; ++ai)
#pragma unroll
                for (int m = 0; m < 4; ++m) { const int row = row0 + ai * 128 + m * 16; const float r_ = rs[ai][m];
                    unsigned qa[8], qb[8];
#pragma unroll
                    for (int n = 0; n < 2; ++n)
#pragma unroll
                        for (int j = 0; j < 4; ++j) { const float ga = acc[ai][0][m][n][j] * r_, gb = acc[ai][1][m][n][j] * r_;
                            const float sa = __builtin_amdgcn_rcpf(1.f + fexp2(-ga * LOG2E)), sb = __builtin_amdgcn_rcpf(1.f + fexp2(-gb * LOG2E));
                            qa[n * 4 + j] = (unsigned)(sa * 255.f + 0.5f); qb[n * 4 + j] = max(1u, (unsigned)(sb * 255.f + 0.5f)); }
                    u32x4 w;
                    w.x = qa[0] | (qa[1] << 8) | (qa[2] << 16) | (qa[3] << 24); w.y = qa[4] | (qa[5] << 8) | (qa[6] << 16) | (qa[7] << 24);
                    w.z = qb[0] | (qb[1] << 8) | (qb[2] << 16) | (qb[3] << 24); w.w = qb[4] | (qb[5] << 8) | (qb[6] << 16) | (qb[7] << 24);
                    *(u32x4*)(G + (size_t)row * 2048 + (size_t)col0 * 2) = w; }
        }
    }
};

struct EpiBranch {
    static constexpr bool PERM = true;
    const unsigned char* G; bf16* MIXED;
    __device__ __forceinline__ void operator()(Acc& acc, const Unit& u, int wr, int wc, int fr, int fq) const {
        const int row0 = u.pm * 256 + wr * 64 + fr; const int col0 = u.pn * 256 + wc * 32 + 8 * fq; const bool first = (u.kind & 0xff) == 0;
        const unsigned char* Gp = G + (size_t)row0 * 2048 + (size_t)col0 * 2;
        u32x4 g[2][4][2];
#pragma unroll
        for (int ai = 0; ai < 2; ++ai)
#pragma unroll
            for (int m = 0; m < 4; ++m)
#pragma unroll
                for (int bj = 0; bj < 2; ++bj) g[ai][m][bj] = *(const u32x4*)(Gp + (size_t)(ai * 128 + m * 16) * 2048 + bj * 256);
#define UB(w, k) ((float)(((w) >> (8 * (k))) & 0xffu))
        if (first) {
#pragma unroll
            for (int ai = 0; ai < 2; ++ai)
#pragma unroll
                for (int m = 0; m < 4; ++m)
#pragma unroll
                    for (int bj = 0; bj < 2; ++bj) { u32x4 gg = g[ai][m][bj]; asm volatile("" : "+v"(gg));
                        f32x4 v0 = acc[ai][bj][m][0], v1 = acc[ai][bj][m][1];
                        v0[0] *= UB(gg.x, 0) * __builtin_amdgcn_rcpf(UB(gg.z, 0)); v0[1] *= UB(gg.x, 1) * __builtin_amdgcn_rcpf(UB(gg.z, 1)); v0[2] *= UB(gg.x, 2) * __builtin_amdgcn_rcpf(UB(gg.z, 2)); v0[3] *= UB(gg.x, 3) * __builtin_amdgcn_rcpf(UB(gg.z, 3));
                        v1[0] *= UB(gg.y, 0) * __builtin_amdgcn_rcpf(UB(gg.w, 0)); v1[1] *= UB(gg.y, 1) * __builtin_amdgcn_rcpf(UB(gg.w, 1)); v1[2] *= UB(gg.y, 2) * __builtin_amdgcn_rcpf(UB(gg.w, 2)); v1[3] *= UB(gg.y, 3) * __builtin_amdgcn_rcpf(UB(gg.w, 3));
                        acc[ai][bj][m][0] = v0; acc[ai][bj][m][1] = v1; }
        } else {
            bf16* Mp = MIXED + (size_t)row0 * 1024 + col0; asm volatile("" : "+v"(Mp)); const float q = 1.0f / 255.0f;
#pragma unroll
            for (int ai = 0; ai < 2; ++ai)
#pragma unroll
                for (int m = 0; m < 4; ++m)
#pragma unroll
                    for (int bj = 0; bj < 2; ++bj) { u32x4 gg = g[ai][m][bj]; asm volatile("" : "+v"(gg)); const f32x4 v0 = acc[ai][bj][m][0] * q, v1 = acc[ai][bj][m][1] * q; u32x4 w;
                        w.x = cvt_pk_bf16(v0[0] * UB(gg.z, 0), v0[1] * UB(gg.z, 1)); w.y = cvt_pk_bf16(v0[2] * UB(gg.z, 2), v0[3] * UB(gg.z, 3));
                        w.z = cvt_pk_bf16(v1[0] * UB(gg.w, 0), v1[1] * UB(gg.w, 1)); w.w = cvt_pk_bf16(v1[2] * UB(gg.w, 2), v1[3] * UB(gg.w, 3));
                        *(u32x4*)(Mp + (size_t)(ai * 128 + m * 16) * 1024 + bj * 128) = w; }
        }
#undef UB
    }
};

struct EpiOutProj {
    static constexpr bool PERM = true;
    bf16* XB; unsigned char* XB8;
    __device__ __forceinline__ void operator()(Acc& acc, const Unit& u, int wr, int wc, int fr, int fq) const {
        const int row0 = u.pm * 256 + wr * 64 + fr; const int col0 = u.pn * 256 + wc * 32 + 8 * fq;
        bf16* base = XB + (size_t)row0 * 1024 + col0; unsigned char* base8 = XB8 + (size_t)row0 * 1024 + col0;
        u32x4 g[2][4][2];
#pragma unroll
        for (int ai = 0; ai < 2; ++ai)
#pragma unroll
            for (int m = 0; m < 4; ++m)
#pragma unroll
                for (int bj = 0; bj < 2; ++bj) g[ai][m][bj] = *(const u32x4*)(base + (size_t)(ai * 128 + m * 16) * 1024 + bj * 128);
#pragma unroll
        for (int ai = 0; ai < 2; ++ai)
#pragma unroll
            for (int m = 0; m < 4; ++m)
#pragma unroll
                for (int bj = 0; bj < 2; ++bj) { const u32x4 gg = g[ai][m][bj]; const f32x4 a0 = acc[ai][bj][m][0], a1 = acc[ai][bj][m][1]; u32x4 w;
                    w.x = cvt_pk_bf16(a0[0] + bf_lo(gg.x), a0[1] + bf_hi(gg.x)); w.y = cvt_pk_bf16(a0[2] + bf_lo(gg.y), a0[3] + bf_hi(gg.y));
                    w.z = cvt_pk_bf16(a1[0] + bf_lo(gg.z), a1[1] + bf_hi(gg.z)); w.w = cvt_pk_bf16(a1[2] + bf_lo(gg.w), a1[3] + bf_hi(gg.w));
                    *(u32x4*)(base + (size_t)(ai * 128 + m * 16) * 1024 + bj * 128) = w;
                    const float v8[8] = {bf_lo(w.x), bf_hi(w.x), bf_lo(w.y), bf_hi(w.y), bf_lo(w.z), bf_hi(w.z), bf_lo(w.w), bf_hi(w.w)};
                    *(u32x2*)(base8 + (size_t)(ai * 128 + m * 16) * 1024 + bj * 128) = pack8_fp8(v8); }
    }
};

struct EpiMoe1 {
    static constexpr bool PERM = true;
    const LAS float* rs_tab; unsigned char* ACT;
    __device__ __forceinline__ void operator()(Acc& acc, const Unit& u, int wr, int wc, int fr, int fq) const {
        const int row0 = u.pm * 256 + wr * 64 + fr; const int col0 = u.pn * 128 + wc * 32 + 8 * fq; const int r0 = wr * 64 + fr;
        float rs[2][4];
#pragma unroll
        for (int ai = 0; ai < 2; ++ai)
#pragma unroll
            for (int m = 0; m < 4; ++m) { const int r = r0 + ai * 128 + m * 16; rs[ai][m] = (r < u.nvalid) ? rs_tab[u.slot * 256 + r] * (1.0f / W8_SCALE) : 0.f; }
#pragma unroll
        for (int ai = 0; ai < 2; ++ai)
#pragma unroll
            for (int m = 0; m < 4; ++m) { const int prow = row0 + ai * 128 + m * 16; const float r_ = rs[ai][m]; float a[8];
#pragma unroll
                for (int n = 0; n < 2; ++n)
#pragma unroll
                    for (int j = 0; j < 4; ++j) { const float g = acc[ai][0][m][n][j] * r_, up = acc[ai][1][m][n][j] * r_;
                        a[n * 4 + j] = A8_SCALE * g * up * __builtin_amdgcn_rcpf(1.f + fexp2(-g * LOG2E)); }
                *(u32x2*)(ACT + (size_t)prow * 512 + col0) = pack8_fp8(a); }
    }
};

struct EpiMoe2 {
    static constexpr bool PERM = true;
    const LAS int* tok_tab; unsigned char* CONTRIB;
    __device__ __forceinline__ void operator()(Acc& acc, const Unit& u, int wr, int wc, int fr, int fq) const {
        const int col0 = u.pn * 256 + wc * 32 + 8 * fq; const int r0 = wr * 64 + fr;
        int tk[2][4]; float ww[2][4];
#pragma unroll
        for (int ai = 0; ai < 2; ++ai)
#pragma unroll
            for (int m = 0; m < 4; ++m) { const int r = r0 + ai * 128 + m * 16; const bool ok = r < u.nvalid; tk[ai][m] = ok ? tok_tab[u.slot * 256 + r] : -1; ww[ai][m] = ok ? __int_as_float(tok_tab[768 + u.slot * 256 + r]) * (C8_SCALE / (W8_SCALE * A8_SCALE)) : 0.f; }
#pragma unroll
        for (int ai = 0; ai < 2; ++ai)
#pragma unroll
            for (int m = 0; m < 4; ++m) { const int tok2 = tk[ai][m]; const float w_ = ww[ai][m];
                if (tok2 >= 0) {
#pragma unroll
                    for (int bj = 0; bj < 2; ++bj) { const f32x4 v0 = acc[ai][bj][m][0] * w_, v1 = acc[ai][bj][m][1] * w_;
                        const float v8[8] = {v0[0], v0[1], v0[2], v0[3], v1[0], v1[1], v1[2], v1[3]};
                        *(u32x2*)(CONTRIB + (size_t)tok2 * 1024 + col0 + bj * 128) = pack8_fp8(v8); } } }
    }
};

struct SchedPlain {
    static constexpr bool GATHER = false; static constexpr bool FP8 = false;
    const char* A; const char* Bt; int nM, nN, K, G, c; const int* aux0 = nullptr; const int* aux1 = nullptr;
    __device__ __forceinline__ bool next(int i, Unit& u) const {
        const long L = (long)i * G + c; if (L >= (long)nM * nN) return false;
        pg8::tile_order((int)L, nM, nN, u.pm, u.pn); u.kind = 0; u.eoff = 256 * u.pm; u.nvalid = 256; u.goff = 0; u.gnv = 0;
        u.A = A + (size_t)u.pm * 256 * K * 2; u.B = Bt + (size_t)u.pn * 256 * K * 2; return true;
    }
};
struct SchedBranch {
    static constexpr bool GATHER = false; static constexpr bool FP8 = false;
    const char *OA, *OB, *WBD, *WBS; int G, c; const int* aux0 = nullptr; const int* aux1 = nullptr;
    __device__ __forceinline__ bool next(int i, Unit& u) const {
        const long L = (long)(i >> 1) * G + c; if (L >= 128 * 4) return false;
        pg8::tile_order((int)L, 128, 4, u.pm, u.pn); const int br = i & 1; u.kind = br ? 1 : (0 | pg8::KEEP); u.eoff = 0; u.nvalid = 256; u.goff = 0; u.gnv = 0;
        u.A = (br ? OB : OA) + (size_t)u.pm * 256 * 512 * 2; u.B = (br ? WBS : WBD) + (size_t)u.pn * 256 * 512 * 2; return true;
    }
};
template <bool G>
struct SchedMoe {
    static constexpr bool GATHER = true; static constexpr bool FP8 = true;
    const char* A; const char* W; const LAS int* ust; const int* ids; const int* aux0; const int* aux1; int K; size_t wstride; int Gn, c;
    __device__ __forceinline__ bool next(int i, Unit& u) const {
        const int v = (Gn % 8 == 0) ? (c % 8) * (Gn / 8) + c / 8 : c;
        const long L = (long)i * Gn + v; const int nrb = ust[32]; if (L >= (long)nrb * 4) return false;
        const int rb = (int)(L >> 2), pn = (int)(L & 3); int e = 0;
        for (int j = 1; j < 32; ++j) e += (ust[j] <= rb) ? 1 : 0;
        const int rbl = rb - ust[e]; const int left = ust[64 + e] - 256 * rbl;
        u.pm = rb; u.pn = pn; u.kind = 0; u.eoff = e * ECAP + 256 * rbl; u.nvalid = left < 256 ? left : 256;
        if (G) { u.goff = u.eoff; u.gnv = u.nvalid; } else { u.goff = 256 * rb; u.gnv = 256; }
        u.A = A; u.B = W + (size_t)e * wstride + (size_t)pn * 256 * K * 2; return true;
    }
};

template <class RowMap>
__device__ __forceinline__ void transpose_item(const float* W, int N, bf16* WT, int Kd, const float* gk, LAS unsigned* scr, int kb, int nb, int lane, const RowMap& map) {
    const int k0 = 64 * kb, n0 = 64 * nb, n4 = lane & 15, kq = lane >> 4;
    f32x4 va[8], vb[8];
    const float* wp = W + (size_t)(k0 + 2 * kq) * N + n0 + 4 * n4;
#pragma unroll
    for (int i = 0; i < 8; ++i) { va[i] = __builtin_nontemporal_load((const f32x4*)(wp + (size_t)(8 * i) * N)); vb[i] = __builtin_nontemporal_load((const f32x4*)(wp + (size_t)(8 * i + 1) * N)); }
#pragma unroll
    for (int i = 0; i < 8; ++i) {
        float ga = 1.f, gb = 1.f; if (gk) { ga = gk[k0 + 8 * i + 2 * kq]; gb = gk[k0 + 8 * i + 2 * kq + 1]; }
#pragma unroll
        for (int j = 0; j < 4; ++j) scr[(4 * n4 + j) * 33 + 4 * i + kq] = cvt_pk_bf16(va[i][j] * ga, vb[i][j] * gb);
    }
    LDS_WAIT(); asm volatile("" ::: "memory");
    const int nl = lane >> 3, c = lane & 7;
#pragma unroll
    for (int p = 0; p < 8; ++p) { const int n = 8 * p + nl; const LAS unsigned* sp = scr + n * 33 + 4 * c;
        u32x4 o; o.x = sp[0]; o.y = sp[1]; o.z = sp[2]; o.w = sp[3];
        *(u32x4*)(WT + (size_t)map(n0 + n) * Kd + k0 + 8 * c) = o; }
    LDS_WAIT(); asm volatile("" ::: "memory");
}
template <class RowMap>
__device__ __forceinline__ void transpose_item8(const float* W, int N, unsigned char* WT, int Kd, const float* gk, float scale, LAS unsigned char* scr, int kb, int nb, int lane, const RowMap& map) {
    const int k0 = 64 * kb, n0 = 64 * nb, n4 = lane & 15, kq = lane >> 4;
    f32x4 va[8], vb[8];
    const float* wp = W + (size_t)(k0 + 2 * kq) * N + n0 + 4 * n4;
#pragma unroll
    for (int i = 0; i < 8; ++i) { va[i] = __builtin_nontemporal_load((const f32x4*)(wp + (size_t)(8 * i) * N)); vb[i] = __builtin_nontemporal_load((const f32x4*)(wp + (size_t)(8 * i + 1) * N)); }
#pragma unroll
    for (int i = 0; i < 8; ++i) {
        float ga = scale, gb = scale; if (gk) { ga *= gk[k0 + 8 * i + 2 * kq]; gb *= gk[k0 + 8 * i + 2 * kq + 1]; }
#pragma unroll
        for (int j = 0; j < 4; ++j) *(LAS unsigned short*)(scr + (4 * n4 + j) * 72 + 8 * i + 2 * kq) = (unsigned short)(__builtin_amdgcn_cvt_pk_fp8_f32(va[i][j] * ga, vb[i][j] * gb, 0, false) & 0xffff);
    }
    LDS_WAIT(); asm volatile("" ::: "memory");
    const int nl = lane >> 3, c = lane & 7;
#pragma unroll
    for (int p = 0; p < 8; ++p) { const int n = 8 * p + nl; const u32x2 o = *(const LAS u32x2*)(scr + n * 72 + 8 * c);
        *(u32x2*)(WT + (size_t)map(n0 + n) * Kd + k0 + 8 * c) = o; }
    LDS_WAIT(); asm volatile("" ::: "memory");
}
struct MapPlain { __device__ __forceinline__ int operator()(int c) const { return c; } };
struct MapIn {
    __device__ __forceinline__ int operator()(int c) const {
        if (c < 1024) { const int pn = c >> 8, hh = (c >> 6) & 3, d = c & 63; return 256 * pn + 128 * (d >> 5) + 32 * hh + (d & 31); }
        if (c < 3072) return c;
        if (c < 4096) { const int cc = c - 3072; return 3072 + 256 * (cc >> 7) + (cc & 127); }
        const int cc = c - 4096; return 3072 + 256 * (cc >> 7) + 128 + (cc & 127);
    }
};
struct MapGU { int up; __device__ __forceinline__ int operator()(int c) const { return 256 * (c >> 7) + 128 * up + (c & 127); } };

__device__ __forceinline__ void convert_moe_weights(Frame& F, int l, int gw, int NGW) {
    LAS unsigned char* scr = (LAS unsigned char*)(F.lds + F.wave * 16384);
    const float* g2 = KIN(14) + l * D;
    for (int it = gw; it < NE * 384; it += NGW) {
        const int e = it / 384, r = it % 384;
        if (r < 256) { const int up = r >> 7, q = r & 127, kb = q >> 3, nb = q & 7;
            const float* W = (up ? KIN(18) : KIN(17)) + ((size_t)l * NE + e) * (size_t)D * DFF;
            transpose_item8(W, DFF, (unsigned char*)(F.ws + WS_WGU_T) + (size_t)e * 1024 * 1024, 1024, g2, W8_SCALE, scr, kb, nb, F.lane, MapGU{up});
        } else { const int q = r - 256, kb = q >> 4, nb = q & 15;
            const float* W = KIN(19) + ((size_t)l * NE + e) * (size_t)DFF * D;
            transpose_item8(W, D, (unsigned char*)(F.ws + WS_WDN_T) + (size_t)e * 1024 * 512, 512, nullptr, W8_SCALE, scr, kb, nb, F.lane, MapPlain{});
        }
    }
}
__device__ __forceinline__ void convert_small_weights(Frame& F, int gw, int NGW) {
    LAS unsigned* scr = (LAS unsigned*)(F.lds + F.wave * 16384);
    for (int it = gw; it < 2 * 1792; it += NGW) {
        const int l = it / 1792; int r = it % 1792;
        if (r < 1280) { const int kb = r / 80, nb = r % 80;
            transpose_item(KIN(3) + (size_t)l * D * NIN, NIN, (bf16*)(F.ws + WS_WIN_T) + (size_t)l * NIN * D, D, KIN(2) + l * D, scr, kb, nb, F.lane, MapIn{}); continue; }
        r -= 1280;
        if (r < 128) { transpose_item(KIN(11) + (size_t)l * 512 * D, D, (bf16*)(F.ws + WS_WBD_T) + (size_t)l * D * 512, 512, nullptr, scr, r >> 4, r & 15, F.lane, MapPlain{}); continue; }
        r -= 128;
        if (r < 128) { transpose_item(KIN(12) + (size_t)l * 512 * D, D, (bf16*)(F.ws + WS_WBS_T) + (size_t)l * D * 512, 512, nullptr, scr, r >> 4, r & 15, F.lane, MapPlain{}); continue; }
        r -= 128;
        transpose_item(KIN(13) + (size_t)l * D * D, D, (bf16*)(F.ws + WS_WOUT_T) + (size_t)l * D * D, D, nullptr, scr, r >> 4, r & 15, F.lane, MapPlain{});
    }
    const int gt = (gw * 64 + F.lane), NT_ = NGW * 64;
    for (int i = gt; i < PMAX; i += NT_) ((int*)(F.ws + WS_IDENT))[i] = 2 * i;
    for (int idx = gt; idx < 2 * 48 * 1024; idx += NT_) {
        const int l = idx / (48 * 1024), r = idx % (48 * 1024), n = r >> 10, k = r & 1023; float v = 0.f;
        if (n < 32) v = KIN(16)[((size_t)l * D + k) * 32 + n]; else if (n < 36) v = KIN(15)[((size_t)l * D + k) * 4 + (n - 32)];
        v *= KIN(14)[l * D + k];
        ((bf16*)(F.ws + WS_WR_T))[idx] = (bf16)(cvt_pk_bf16(v, 0.f) & 0xffffu);
    }
}
template <bool INB, bool ADD, bool WX, bool WB>
__device__ __forceinline__ void rows_phase(Frame& F, const float* xin, float* xout, int m_first, int m_step, int m_end) {
    const unsigned char* C = (const unsigned char*)(F.ws + WS_CONTRIB); bf16* XB = (bf16*)(F.ws + WS_XB); float* rstd = (float*)(F.ws + WS_RSTD1);
    for (int m0 = m_first; m0 < m_end; m0 += m_step) {
        f32x4 v[2][4]; u32x2 xa[2][4]; unsigned ca[2][4], cb[2][4];
#pragma unroll
        for (int q = 0; q < 2; ++q) {
            if (INB) { const u32x2* xr = (const u32x2*)(XB + (size_t)(m0 + q) * D) + F.lane;
#pragma unroll
                for (int j = 0; j < 4; ++j) xa[q][j] = xr[64 * j]; }
            else { const f32x4* xr = (const f32x4*)(xin + (size_t)(m0 + q) * D) + F.lane;
#pragma unroll
                for (int j = 0; j < 4; ++j) v[q][j] = __builtin_nontemporal_load(xr + 64 * j); }
            if (ADD) { const unsigned* c0 = (const unsigned*)(C + (size_t)(2 * (m0 + q)) * D) + F.lane; const unsigned* c1 = (const unsigned*)(C + (size_t)(2 * (m0 + q) + 1) * D) + F.lane;
#pragma unroll
                for (int j = 0; j < 4; ++j) { ca[q][j] = c0[64 * j]; cb[q][j] = c1[64 * j]; } } }
#pragma unroll
        for (int q = 0; q < 2; ++q) { const int m = m0 + q;
            if (INB) {
#pragma unroll
                for (int j = 0; j < 4; ++j) { const u32x2 a = xa[q][j]; v[q][j] = (f32x4){bf_lo(a.x), bf_hi(a.x), bf_lo(a.y), bf_hi(a.y)}; } }
            if (ADD) {
#pragma unroll
                for (int j = 0; j < 4; ++j) { const int a = (int)ca[q][j], b = (int)cb[q][j];
                    const f32x2 a0 = __builtin_amdgcn_cvt_pk_f32_fp8(a, false), a1 = __builtin_amdgcn_cvt_pk_f32_fp8(a, true), b0 = __builtin_amdgcn_cvt_pk_f32_fp8(b, false), b1 = __builtin_amdgcn_cvt_pk_f32_fp8(b, true);
                    v[q][j][0] += (a0[0] + b0[0]) * (1.0f / C8_SCALE); v[q][j][1] += (a0[1] + b0[1]) * (1.0f / C8_SCALE); v[q][j][2] += (a1[0] + b1[0]) * (1.0f / C8_SCALE); v[q][j][3] += (a1[1] + b1[1]) * (1.0f / C8_SCALE); } }
            if (WX) { f32x4* xo = (f32x4*)(xout + (size_t)m * D) + F.lane;
#pragma unroll
                for (int j = 0; j < 4; ++j) __builtin_nontemporal_store(v[q][j], xo + 64 * j); }
            if (WB) {
                u32x2 w[4]; float s_ = 0.f;
#pragma unroll
                for (int j = 0; j < 4; ++j) { w[j].x = cvt_pk_bf16(v[q][j][0], v[q][j][1]); w[j].y = cvt_pk_bf16(v[q][j][2], v[q][j][3]);
                    const float r0 = bf_lo(w[j].x), r1 = bf_hi(w[j].x), r2 = bf_lo(w[j].y), r3 = bf_hi(w[j].y); s_ += (r0 * r0 + r1 * r1) + (r2 * r2 + r3 * r3); }
                s_ = wave_sum(s_);
                if (F.lane == 0) rstd[m] = 1.0f / sqrtf(s_ * (1.0f / D) + EPS);
                u32x2* o = (u32x2*)(XB + (size_t)m * D) + F.lane;
#pragma unroll
                for (int j = 0; j < 4; ++j) o[64 * j] = w[j];
            } }
    }
}

__device__ __forceinline__ void router_phase(Frame& F, int l) {
    const bf16* XB = (const bf16*)(F.ws + WS_XB); const bf16* WR = (const bf16*)(F.ws + WS_WR_T) + (size_t)l * 48 * 1024;
    int* ent_tok = (int*)(F.ws + WS_ENT_TOK); float* ent_w = (float*)(F.ws + WS_ENT_W); float* ent_rs = (float*)(F.ws + WS_ENT_RS);
    unsigned* gcnt = (unsigned*)(F.ctl + CW_CNT + 64 * l);
    LAS int* lcnt = (LAS int*)(F.lds + MOE_OFF) + 64; LAS int* lbase = lcnt + 32;
    const int fr = F.lane & 15, fq = F.lane >> 4;
    { LAS u32x4* wl = (LAS u32x4*)F.lds; u32x4 tmp[12];
#pragma unroll
        for (int j = 0; j < 12; ++j) { const int f = F.tid + 512 * j, ln = f & 63, kk = (f >> 6) & 31, nb = f >> 11; tmp[j] = *(const u32x4*)(WR + (size_t)(16 * nb + (ln & 15)) * D + 32 * kk + 8 * (ln >> 4)); }
#pragma unroll
        for (int j = 0; j < 12; ++j) wl[F.tid + 512 * j] = tmp[j];
    }
    __syncthreads();
    for (int chunk = F.vcu; chunk < T / 128; chunk += F.G) {
        if (F.tid < 32) lcnt[F.tid] = 0;
        __syncthreads();
        const int row = chunk * 128 + F.wave * 16 + fr;
        f32x4 a0 = {0.f, 0.f, 0.f, 0.f}, a1 = a0, a2 = a0; float ss = 0.f;
        const bf16* xp = XB + (size_t)row * D + 8 * fq; const LAS bf16x8* wl = (const LAS bf16x8*)F.lds + F.lane;
#pragma unroll
        for (int kb_ = 0; kb_ < 2; ++kb_) {
        u32x4 xa[16];
#pragma unroll
        for (int kk = 0; kk < 16; ++kk) xa[kk] = *(const u32x4*)(xp + 32 * (16 * kb_ + kk));
#pragma unroll
        for (int k_ = 0; k_ < 16; ++k_) { const int kk = 16 * kb_ + k_;
            { const u32x4 x_ = xa[k_]; float t0 = bf_lo(x_.x), t1 = bf_hi(x_.x), t2 = bf_lo(x_.y), t3 = bf_hi(x_.y), t4 = bf_lo(x_.z), t5 = bf_hi(x_.z), t6 = bf_lo(x_.w), t7 = bf_hi(x_.w);
              ss += (t0 * t0 + t1 * t1) + (t2 * t2 + t3 * t3) + (t4 * t4 + t5 * t5) + (t6 * t6 + t7 * t7); }
            const bf16x8 xf = __builtin_bit_cast(bf16x8, xa[k_]);
            a0 = __builtin_amdgcn_mfma_f32_16x16x32_bf16(wl[(0 * 32 + kk) * 64], xf, a0, 0, 0, 0);
            a1 = __builtin_amdgcn_mfma_f32_16x16x32_bf16(wl[(1 * 32 + kk) * 64], xf, a1, 0, 0, 0);
            a2 = __builtin_amdgcn_mfma_f32_16x16x32_bf16(wl[(2 * 32 + kk) * 64], xf, a2, 0, 0, 0);
            if ((k_ & 3) == 3) __builtin_amdgcn_sched_barrier(0);
        }
        asm volatile("" ::: "memory");
        }
        ss += __shfl_xor(ss, 16); ss += __shfl_xor(ss, 32);
        const float rstd = 1.0f / sqrtf(ss * (1.0f / D) + EPS);
        float gl[4];
#pragma unroll
        for (int j = 0; j < 4; ++j) gl[j] = __shfl(a2[j], fr) * rstd;
        int g = 0; float gm = gl[0];
#pragma unroll
        for (int j = 1; j < 4; ++j) if (gl[j] > gm) { gm = gl[j]; g = j; }
        float gs = 0.f;
#pragma unroll
        for (int j = 0; j < 4; ++j) gs += __expf(gl[j] - gm);
        const float pg = 1.0f / gs;
        f32x4 sel = (g >> 1) ? a1 : a0;
        float el[8];
#pragma unroll
        for (int i = 0; i < 8; ++i) { const int src = fr + 16 * (2 * (g & 1) + (i >> 2)); el[i] = __shfl(sel[i & 3], src) * rstd; }
        int i1 = 0; float m1 = el[0];
#pragma unroll
        for (int i = 1; i < 8; ++i) if (el[i] > m1) { m1 = el[i]; i1 = i; }
        int i2 = -1; float m2 = -3.0e38f;
#pragma unroll
        for (int i = 0; i < 8; ++i) if (i != i1 && el[i] > m2) { m2 = el[i]; i2 = i; }
        const float p2 = __expf(m2 - m1); const float w0 = pg / (1.f + p2), w1 = pg * p2 / (1.f + p2);
        const int e0 = 8 * g + i1, e1 = 8 * g + i2;
        int lp0 = 0, lp1 = 0;
        if (fq == 0) { lp0 = __hip_atomic_fetch_add(lcnt + e0, 1, __ATOMIC_RELAXED, __HIP_MEMORY_SCOPE_WORKGROUP); lp1 = __hip_atomic_fetch_add(lcnt + e1, 1, __ATOMIC_RELAXED, __HIP_MEMORY_SCOPE_WORKGROUP); }
        __syncthreads();
        if (F.tid < 32) lbase[F.tid] = (int)__hip_atomic_fetch_add(gcnt + F.tid, (unsigned)lcnt[F.tid], RLX_AGENT);
        __syncthreads();
        if (fq == 0) {
            const int s0 = e0 * ECAP + lbase[e0] + lp0, s1 = e1 * ECAP + lbase[e1] + lp1;
            ent_tok[s0] = 2 * row; ent_tok[s1] = 2 * row + 1; ent_w[s0] = w0; ent_w[s1] = w1; ent_rs[s0] = rstd; ent_rs[s1] = rstd;
        }
        __syncthreads();
    }
}
__device__ __forceinline__ void build_ust(Frame& F, int l) {
    LAS int* ust = (LAS int*)(F.lds + MOE_OFF); LAS int* cnt = ust + 64;
    if (F.tid < 32) cnt[F.tid] = (int)__hip_atomic_load((unsigned*)(F.ctl + CW_CNT + 64 * l) + F.tid, RLX_AGENT);
    __syncthreads();
    if (F.tid == 0) { int acc = 0;
        for (int e = 0; e < 32; ++e) { ust[e] = acc; acc += (cnt[e] + 255) >> 8; }
        ust[32] = acc; }
    __syncthreads();
}
__device__ __forceinline__ int crow(int r, int hi) { return (r & 3) + 8 * (r >> 2) + 4 * hi; }
__device__ __forceinline__ s16x4 vtr(const LAS unsigned char* p) { return __builtin_bit_cast(s16x4, __builtin_amdgcn_ds_read_tr16_b64_v4i16((LAS v4i16_t*)p)); }
__device__ __forceinline__ void glds(const void* g, LAS unsigned char* l) { __builtin_amdgcn_global_load_lds((const unsigned*)g, (LAS unsigned*)l, 16, 0, 0); }
#define PKV(lo, hi4) (bf16x8){lo[0], lo[1], lo[2], lo[3], hi4[0], hi4[1], hi4[2], hi4[3]}

__device__ __forceinline__ void pack_p(const f32x16& p0, const f32x16& p1, bf16x8 (&pa)[4]) {
    u32x4 w0, w1, w2, w3;
    w0.x = cvt_pk_bf16(p0[0], p0[1]); w0.y = cvt_pk_bf16(p0[2], p0[3]); w0.z = cvt_pk_bf16(p0[4], p0[5]); w0.w = cvt_pk_bf16(p0[6], p0[7]);
    w1.x = cvt_pk_bf16(p0[8], p0[9]); w1.y = cvt_pk_bf16(p0[10], p0[11]); w1.z = cvt_pk_bf16(p0[12], p0[13]); w1.w = cvt_pk_bf16(p0[14], p0[15]);
    w2.x = cvt_pk_bf16(p1[0], p1[1]); w2.y = cvt_pk_bf16(p1[2], p1[3]); w2.z = cvt_pk_bf16(p1[4], p1[5]); w2.w = cvt_pk_bf16(p1[6], p1[7]);
    w3.x = cvt_pk_bf16(p1[8], p1[9]); w3.y = cvt_pk_bf16(p1[10], p1[11]); w3.z = cvt_pk_bf16(p1[12], p1[13]); w3.w = cvt_pk_bf16(p1[14], p1[15]);
    pa[0] = __builtin_bit_cast(bf16x8, w0); pa[1] = __builtin_bit_cast(bf16x8, w1); pa[2] = __builtin_bit_cast(bf16x8, w2); pa[3] = __builtin_bit_cast(bf16x8, w3);
}
template <int NDB>
__device__ __forceinline__ void pv_mma(f32x16 (&o)[NDB], const LAS unsigned char* vp, const bf16x8 (&pa)[4]) {
    s16x4 lo[2][4], hi4[2][4];
#pragma unroll
    for (int ks = 0; ks < 4; ++ks) { lo[0][ks] = vtr(vp + ks * 1024); hi4[0][ks] = vtr(vp + ks * 1024 + 512); }
#pragma unroll
    for (int db = 0; db < NDB; ++db) {
        if (db + 1 < NDB) {
#pragma unroll
            for (int ks = 0; ks < 4; ++ks) { lo[(db + 1) & 1][ks] = vtr(vp + (db + 1) * 4096 + ks * 1024); hi4[(db + 1) & 1][ks] = vtr(vp + (db + 1) * 4096 + ks * 1024 + 512); }
        }
        __builtin_amdgcn_sched_barrier(0);
#pragma unroll
        for (int ks = 0; ks < 4; ++ks) o[db] = __builtin_amdgcn_mfma_f32_32x32x16_bf16(pa[ks], PKV(lo[db & 1][ks], hi4[db & 1][ks]), o[db], 0, 0, 0);
        __builtin_amdgcn_sched_barrier(0);
    }
}
__device__ __forceinline__ void qk_mma(f32x16& p0, f32x16& p1, const LAS unsigned char* Kb, const LAS unsigned char* Qs, int lane, int r32, int hi) {
    const LAS unsigned char* kb = Kb + hi * 1024 + r32 * 16;
#pragma unroll
    for (int d0 = 0; d0 < 4; ++d0) {
        const bf16x8 b0 = *(const LAS bf16x8*)(kb + d0 * 2048), b1 = *(const LAS bf16x8*)(kb + d0 * 2048 + 512), q = *(const LAS bf16x8*)(Qs + d0 * 1024 + lane * 16);
        p0 = __builtin_amdgcn_mfma_f32_32x32x16_bf16(b0, q, p0, 0, 0, 0); p1 = __builtin_amdgcn_mfma_f32_32x32x16_bf16(b1, q, p1, 0, 0, 0);
    }
}

__device__ __forceinline__ void diff_epilogue(Frame& F, f32x16 (&o)[4], LAS float* xch, const float* subg, float lam_init, bf16* Ow);
template <int VAR>
__device__ __forceinline__ void diff_stream(f32x16 (&o)[4], float& l, const LAS unsigned char* Kb, const LAS unsigned char* Vb, const bf16x8 (&qr)[4], const LAS float* lut,
                                            bool near, float cfar, int qrow, int kmin, int lane, int r32, int hi) {
    f32x16 p0, p1; const float init = near ? 0.f : cfar;
#pragma unroll
    for (int r = 0; r < 16; ++r) { p0[r] = init; p1[r] = init; }
    const LAS unsigned char* kb = Kb + r32 * 128; const int sw = (r32 >> 1) & 7;
    bf16x8 kf[8];
#pragma unroll
    for (int d0 = 0; d0 < 4; ++d0) { const int so = (((2 * d0 + hi) ^ sw) << 4); kf[2 * d0] = *(const LAS bf16x8*)(kb + so); kf[2 * d0 + 1] = *(const LAS bf16x8*)(kb + 4096 + so); }
    __builtin_amdgcn_sched_barrier(0);
#pragma unroll
    for (int d0 = 0; d0 < 4; ++d0) { if (!(VAR & 4)) { p0 = __builtin_amdgcn_mfma_f32_32x32x16_bf16(kf[2 * d0], qr[d0], p0, 0, 0, 0); p1 = __builtin_amdgcn_mfma_f32_32x32x16_bf16(kf[2 * d0 + 1], qr[d0], p1, 0, 0, 0); }
        else { p0[d0] += __builtin_bit_cast(f32x4, kf[2 * d0])[0]; p1[d0] += __builtin_bit_cast(f32x4, kf[2 * d0 + 1])[0]; } }
    if (VAR & 1) { } else if (near) {
#pragma unroll
        for (int r = 0; r < 16; ++r) { const int d0 = qrow - (kmin + crow(r, hi)), d1 = d0 - 32;
            const float b0 = lut[min(max(d0, 0), 127)], b1 = lut[min(max(d1, 0), 127)];
            p0[r] = d0 < 0 ? 0.f : fexp2(p0[r] + b0); p1[r] = d1 < 0 ? 0.f : fexp2(p1[r] + b1); }
    } else {
#pragma unroll
        for (int r = 0; r < 16; ++r) { p0[r] = fexp2(p0[r]); p1[r] = fexp2(p1[r]); }
    }
    float s = 0.f;
#pragma unroll
    for (int r = 0; r < 16; ++r) s += p0[r] + p1[r];
    l += s;
    bf16x8 pa[4]; pack_p(p0, p1, pa);
    const LAS unsigned char* vp = Vb + ((lane >> 4) & 1) * 32 + (lane & 3) * 8 + (4 * hi + ((lane & 15) >> 2)) * 64;
    if (!(VAR & 2)) pv_mma<4>(o, vp, pa); else { o[0][0] += __builtin_bit_cast(f32x4, pa[0])[0] + __builtin_bit_cast(f32x4, pa[3])[1]; }
}

template <int VAR>
__device__ __forceinline__ void diff_unit(Frame& F, int b, int h, int qb, const float* subg, float lam, float lam_init, bf16* Odst) {
    const int lane = F.lane, r32 = lane & 31, hi = lane >> 5, wid = F.wave, js = wid >> 2, wq = wid & 3;
    bf16* DQ = (bf16*)(F.ws + WS_DQ); const bf16* DK = (const bf16*)(F.ws + WS_DK); const bf16* VA = (const bf16*)(F.ws + WS_VA);
    const long rowbase = (long)b * SEQ; const int q0 = qb * 128, qw = q0 + 32 * wq;
    LAS unsigned char* kv = F.lds;
    LAS float* wsf = (LAS float*)(F.lds + WSF_OFF) + wid * 64; const LAS float* lut = (const LAS float*)(F.lds + LUT_OFF) + h * 128;
    const int NT = (q0 + 128) / 64;
    const int krow_ = 8 * wid + (lane >> 3);
    const bf16* k1src = DK + (rowbase + krow_) * 512 + h * 128 + (((lane & 7) ^ ((krow_ >> 1) & 7)) * 8);
    const bf16* vsrc0 = VA + (rowbase + 16 * (wid & 3) + (lane >> 2)) * 512 + h * 128 + (wid >> 2) * 32 + (lane & 3) * 8;
#define DIFF_ISSUE(t, bufi) do { LAS unsigned char* bb_ = kv + (bufi) * 32768; const long ro_ = (long)(t) * 64 * 512; \
        glds(k1src + ro_, bb_ + wid * 1024); glds(k1src + ro_ + 64, bb_ + 8192 + wid * 1024); \
        glds(vsrc0 + ro_, bb_ + 16384 + wid * 1024); glds(vsrc0 + ro_ + 64, bb_ + 16384 + (wid + 8) * 1024); } while (0)
    bf16x8 qr[4];
#pragma unroll
    for (int d0 = 0; d0 < 4; ++d0) qr[d0] = *(const bf16x8*)(DQ + (rowbase + qw + r32) * 512 + h * 128 + js * 64 + d0 * 16 + hi * 8);
    asm volatile("" ::: "memory");
    if (!(VAR & 8)) { DIFF_ISSUE(0, 0);
    if (NT > 1) DIFF_ISSUE(1, 1); }
    f32x16 o[4];
#pragma unroll
    for (int i = 0; i < 4; ++i)
#pragma unroll
        for (int r = 0; r < 16; ++r) o[i][r] = 0.f;
    float l = 0.f;
    const float cfar = lut[127];
    if (NT > 1) asm volatile("s_waitcnt vmcnt(4)" ::: "memory"); else asm volatile("s_waitcnt vmcnt(0)" ::: "memory");
    __builtin_amdgcn_s_barrier(); asm volatile("" ::: "memory");
    int sc_ = 0, sn2 = 2;
    for (int t = 0; t < NT; ++t) {
        if (!(VAR & 8)) { if (t + 2 < NT) DIFF_ISSUE(t + 2, sn2); }
        const int kmin = 64 * t;
        if (kmin <= qw + 31) {
            const bool near = (qw - (kmin + 63)) < 113;
            const LAS unsigned char* bb = kv + sc_ * 32768;
            diff_stream<VAR>(o, l, bb + js * 8192, bb + 16384, qr, lut, near, cfar, qw + r32, kmin, lane, r32, hi);
        }
        if (t + 2 < NT) asm volatile("s_waitcnt vmcnt(4) lgkmcnt(0)" ::: "memory"); else asm volatile("s_waitcnt vmcnt(0) lgkmcnt(0)" ::: "memory");
        if (!(VAR & 16)) __builtin_amdgcn_s_barrier(); asm volatile("" ::: "memory");
        sn2 = sc_; sc_ = (sc_ == 2) ? 0 : sc_ + 1;
    }
#undef DIFF_ISSUE
    l += __shfl_xor(l, 32);
    if (hi == 0) wsf[r32] = l;
    LDS_WAIT();
    const float sc = js ? lam : 1.0f;
#pragma unroll
    for (int r = 0; r < 16; ++r) { const float rl = sc * __builtin_amdgcn_rcpf(wsf[crow(r, hi)]);
#pragma unroll
        for (int db = 0; db < 4; ++db) o[db][r] *= rl; }
    LAS float* xch = (LAS float*)(F.lds + wq * 16384);
    if (js) {
#pragma unroll
        for (int db = 0; db < 4; ++db)
#pragma unroll
            for (int r = 0; r < 16; ++r) xch[(db * 16 + r) * 64 + lane] = o[db][r];
    }
    asm volatile("s_waitcnt lgkmcnt(0)" ::: "memory"); __syncthreads();
    if (!js && !(VAR & 32)) diff_epilogue(F, o, xch, subg, lam_init, Odst + (rowbase + qw) * 512 + h * 128);
    asm volatile("s_waitcnt lgkmcnt(0)" ::: "memory"); __syncthreads();
}
__device__ __forceinline__ void diff_epilogue(Frame& F, f32x16 (&o)[4], LAS float* xch, const float* subg, float lam_init, bf16* Ow) {
    int lane = F.lane; asm volatile("" : "+v"(lane));
    const int r32 = lane & 31, hi = lane >> 5;
    float ssq[16];
#pragma unroll
    for (int r = 0; r < 16; ++r) { float s = 0.f;
#pragma unroll
        for (int db = 0; db < 4; ++db) { const float v = o[db][r] - xch[(db * 16 + r) * 64 + lane]; o[db][r] = v; s += v * v; }
        ssq[r] = s; }
#pragma unroll
    for (int r = 0; r < 16; ++r) { float s = ssq[r]; s += __shfl_xor(s, 1); s += __shfl_xor(s, 2); s += __shfl_xor(s, 4); s += __shfl_xor(s, 8); s += __shfl_xor(s, 16);
        ssq[r] = (1.0f - lam_init) * __builtin_amdgcn_rsqf(s * (1.0f / 128.0f) + EPS); }
    float sg[4];
#pragma unroll
    for (int db = 0; db < 4; ++db) sg[db] = subg[32 * db + r32];
    LDS_WAIT();
    LAS bf16* stl = (LAS bf16*)xch;
#pragma unroll
    for (int r = 0; r < 16; ++r) { const int orow = crow(r, hi);
#pragma unroll
        for (int db = 0; db < 4; ++db) stl[orow * 128 + db * 32 + r32] = (bf16)(cvt_pk_bf16(o[db][r] * ssq[r] * sg[db], 0.f) & 0xffffu); }
    LDS_WAIT();
#pragma unroll
    for (int i = 0; i < 8; ++i) { const int row = i * 4 + (lane >> 4), ch = lane & 15; const u32x4 v = *(const LAS u32x4*)(stl + row * 128 + ch * 8); *(u32x4*)(Ow + (long)row * 512 + ch * 8) = v; }
}

__device__ __forceinline__ void sb_unit(Frame& F, int b, int h, int blk) {
    const int lane = F.lane, r32 = lane & 31, hi = lane >> 5, wid = F.wave;
    bf16* SBQ = (bf16*)(F.ws + WS_SBQ); const bf16* SBK = (const bf16*)(F.ws + WS_SBK); const bf16* SBV = (const bf16*)(F.ws + WS_SBV);
    const long rowbase = (long)b * SEQ; const int qw = 32 * blk; const int qrow = qw + r32;
    LAS unsigned char* kb_ = F.lds + wid * 16384; LAS unsigned char* vb_ = kb_ + 8192;
    bf16x8 qr[4];
#pragma unroll
    for (int d0 = 0; d0 < 4; ++d0) qr[d0] = *(const bf16x8*)(SBQ + (rowbase + qrow) * 512 + h * 64 + d0 * 16 + hi * 8);
    f32x16 o[2];
#pragma unroll
    for (int i = 0; i < 2; ++i)
#pragma unroll
        for (int r = 0; r < 16; ++r) o[i][r] = 0.f;
    float carry = 0.f;
    const bf16* ksrc = SBK + (rowbase + (lane >> 3)) * 512 + h * 64;
    const bf16* vsrc = SBV + (rowbase + (lane >> 2)) * 512 + h * 64 + (lane & 3) * 8;
    const LAS unsigned char* kp = kb_ + r32 * 128; const int ksw = (r32 >> 1) & 7;
    const LAS unsigned char* vp = vb_ + ((lane >> 4) & 1) * 32 + (lane & 3) * 8 + (4 * hi + ((lane & 15) >> 2)) * 64;
#define SB_ISSUE_K(t_) do { _Pragma("unroll") for (int c = 0; c < 8; ++c) { const int kr_ = 8 * c + (lane >> 3); glds(ksrc + (long)(64 * (t_) + 8 * c) * 512 + (((lane & 7) ^ ((kr_ >> 1) & 7)) * 8), kb_ + c * 1024); } } while (0)
#define SB_ISSUE_V(t_) do { _Pragma("unroll") for (int p = 0; p < 8; ++p) glds(vsrc + (long)(64 * (t_) + 16 * (p & 3)) * 512 + (p >> 2) * 32, vb_ + p * 1024); } while (0)
    const int t0 = qw >> 6;
    asm volatile("s_waitcnt lgkmcnt(0)" ::: "memory");
    SB_ISSUE_K(t0); SB_ISSUE_V(t0);
    for (int t = t0; t >= 0; --t) {
        const int kmin = 64 * t;
        asm volatile("s_waitcnt vmcnt(8)" ::: "memory");
        bf16x8 kf[8];
#pragma unroll
        for (int d0 = 0; d0 < 4; ++d0) { const int so = (((2 * d0 + hi) ^ ksw) << 4); kf[2 * d0] = *(const LAS bf16x8*)(kp + so); kf[2 * d0 + 1] = *(const LAS bf16x8*)(kp + 4096 + so); }
        asm volatile("s_waitcnt lgkmcnt(0)" ::: "memory");
        if (t > 0) SB_ISSUE_K(t - 1);
        f32x16 p0, p1;
#pragma unroll
        for (int r = 0; r < 16; ++r) { p0[r] = 0.f; p1[r] = 0.f; }
#pragma unroll
        for (int d0 = 0; d0 < 4; ++d0) { p0 = __builtin_amdgcn_mfma_f32_32x32x16_bf16(kf[2 * d0], qr[d0], p0, 0, 0, 0); p1 = __builtin_amdgcn_mfma_f32_32x32x16_bf16(kf[2 * d0 + 1], qr[d0], p1, 0, 0, 0); }
        float Lb[8][4], T_own[8], T_oth[8];
#pragma unroll
        for (int i = 0; i < 8; ++i) {
#pragma unroll
            for (int e = 0; e < 4; ++e) { const float y = (i < 4) ? p0[4 * i + e] : p1[4 * (i - 4) + e]; const int key = kmin + 8 * i + 4 * hi + e;
                const float sp = fmaxf(y, 0.f) + flog2(1.f + fexp2(-fabsf(y)));
                Lb[i][e] = (key < qrow) ? sp : 0.f; }
            T_own[i] = (Lb[i][0] + Lb[i][1]) + (Lb[i][2] + Lb[i][3]);
        }
#pragma unroll
        for (int i = 0; i < 8; ++i) T_oth[i] = __shfl_xor(T_own[i], 32);
        float after = carry;
#pragma unroll
        for (int i = 7; i >= 0; --i) {
            const float off = after + (hi == 0 ? T_oth[i] : 0.f);
            after += T_own[i] + T_oth[i];
            float suf = off;
#pragma unroll
            for (int e = 3; e >= 0; --e) { const float y = (i < 4) ? p0[4 * i + e] : p1[4 * (i - 4) + e]; const int key = kmin + 8 * i + 4 * hi + e;
                const float a = (key < qrow) ? fexp2(y - Lb[i][e] - suf) : 0.f; suf += Lb[i][e];
                if (i < 4) p0[4 * i + e] = a; else p1[4 * (i - 4) + e] = a; }
        }
        carry = after;
        bf16x8 pa[4]; pack_p(p0, p1, pa);
        if (t > 0) asm volatile("s_waitcnt vmcnt(8)" ::: "memory"); else asm volatile("s_waitcnt vmcnt(0)" ::: "memory");
        pv_mma<2>(o, vp, pa);
        asm volatile("s_waitcnt lgkmcnt(0)" ::: "memory");
#if SB_EARLY_EXIT
        if (__all(carry > 150.f)) break;
#endif
        if (t > 0) SB_ISSUE_V(t - 1);
    }
#undef SB_ISSUE_K
#undef SB_ISSUE_V
    asm volatile("s_waitcnt vmcnt(0) lgkmcnt(0)" ::: "memory");
    LAS bf16* stl = (LAS bf16*)kb_;
#pragma unroll
    for (int r = 0; r < 16; ++r) { const int orow = crow(r, hi);
#pragma unroll
        for (int db = 0; db < 2; ++db) stl[orow * 64 + db * 32 + r32] = (bf16)(cvt_pk_bf16(o[db][r], 0.f) & 0xffffu); }
    LDS_WAIT();
    bf16* Ow = SBQ + (rowbase + qw) * 512 + h * 64;
#pragma unroll
    for (int i = 0; i < 4; ++i) { const int row = i * 8 + (lane >> 3), ch = lane & 7; const u32x4 v = *(const LAS u32x4*)(stl + row * 64 + ch * 8); *(u32x4*)(Ow + (long)row * 512 + ch * 8) = v; }
    asm volatile("s_waitcnt lgkmcnt(0)" ::: "memory");
}

__device__ __forceinline__ int t5_bucket(int n) {
    if (n < 16) return n;
    int b = 16;
    const int thr[15] = {19, 21, 24, 27, 31, 35, 40, 46, 52, 59, 67, 77, 87, 99, 113};
#pragma unroll
    for (int j = 0; j < 15; ++j) b += (n >= thr[j]) ? 1 : 0;
    return b;
}

__device__ __forceinline__ void attention_phase(Frame& F, int l) {
    const float* relb = KIN(1); const float* gq = KIN(4) + l * 64; const float* gk = KIN(5) + l * 64;
    LAS float* scal = (LAS float*)(F.lds + WSF_OFF);
    if (F.wave == 0) { const int d = F.lane;
        float a1 = KIN(6)[l * 64 + d] * KIN(7)[l * 64 + d], a2 = KIN(8)[l * 64 + d] * KIN(9)[l * 64 + d], mq = fabsf(gq[d]), mk = fabsf(gk[d]);
        a1 = wave_sum(a1); a2 = wave_sum(a2);
#pragma unroll
        for (int o = 1; o < 64; o <<= 1) { mq = fmaxf(mq, __shfl_xor(mq, o)); mk = fmaxf(mk, __shfl_xor(mk, o)); }
        if (d == 0) { scal[0] = a1; scal[1] = a2; scal[2] = mq; scal[3] = mk; } }
    if (F.tid >= 64 && F.tid < 192) scal[16 + F.tid - 64] = relb[F.tid - 64];
    __syncthreads();
    const float s1 = scal[0], s2 = scal[1], gqm = scal[2], gkm = scal[3];
    const float lam_init = 0.8f - 0.6f * expf(-0.3f * (float)l);
    const float lam = expf(s1) - expf(s2) + lam_init;
    float lutv;
    {
        const int h = F.tid >> 7, d = F.tid & 127; float mb = -3.0e38f;
        for (int bkt = 0; bkt < 32; ++bkt) mb = fmaxf(mb, scal[16 + bkt * 4 + h]);
        const float M = 8.f * gqm * gkm + mb;
        lutv = (scal[16 + t5_bucket(d) * 4 + h] - M) * LOG2E;
    }
    __syncthreads();
    ((LAS float*)(F.lds + LUT_OFF))[F.tid] = lutv;
    __syncthreads();
    const float* subg = KIN(10) + l * 128;
#ifndef ATT_MASK
#define ATT_MASK 3
#endif
#ifndef DIFF_VARIANT
#define DIFF_VARIANT -1
#endif
    if (DIFF_VARIANT >= 0) { for (int i = 0;; ++i) { const long L = (long)i * F.G + F.vcu; if (L >= 1024) break;
        const int Lm = (int)(L & 255), bh = Lm >> 3, s = Lm & 7, k = (int)(L >> 8), qb = (k == 0) ? 31 - s : (k == 1) ? 16 + s : (k == 2) ? 15 - s : s;
        diff_unit<(DIFF_VARIANT >= 0 ? DIFF_VARIANT : 0)>(F, bh >> 2, bh & 3, qb, subg, lam, lam_init, (bf16*)(F.ws + WS_XB)); }
        __syncthreads(); }
    PB_START(10);
    const int vcu = F.vcu;
    if (ATT_MASK & 1) for (int i = 0;; ++i) { const long L = (long)i * F.G + vcu; if (L >= 1024) break;
        const int Lm = (int)(L & 255), bh = Lm >> 3, s = Lm & 7, k = (int)(L >> 8), qb = (k == 0) ? 31 - s : (k == 1) ? 16 + s : (k == 2) ? 15 - s : s;
        diff_unit<0>(F, bh >> 2, bh & 3, qb, subg, lam, lam_init, (bf16*)(F.ws + WS_DQ)); }
    __syncthreads();
    PB_END(10);
    PB_START(11);
    const int gw = F.vcu * NWAVES + F.wave, NGW = F.G * NWAVES;
    if ((ATT_MASK & 2) && F.local_ok) {
        const int xg = F.vcu >> 5; unsigned* q = (unsigned*)(F.ctl + CW_SBQ) + 64 * (2 * xg + l);
        unsigned nxt = 0; if (F.lane == 0) nxt = xb_add(q, 1u);
        nxt = (unsigned)__builtin_amdgcn_readfirstlane((int)nxt);
        for (;;) { const unsigned u = nxt; if (u >= 1024u) break;
            unsigned n2 = 0; if (F.lane == 0) n2 = xb_add(q, 1u);
            sb_unit(F, xg, (int)((u >> 3) & 7u), 127 - (int)(8u * (u >> 6) + (u & 7u)));
            nxt = (unsigned)__builtin_amdgcn_readfirstlane((int)n2); }
    } else if (ATT_MASK & 2) for (int i = 0;; ++i) { int bh, x;
        if (F.G == 256) { const int xg = F.vcu >> 5, lw = (F.vcu & 31) * NWAVES + F.wave, pp = (i >> 1) * 256 + lw; if (pp >= 512) break; bh = 8 * xg + (pp >> 6); x = pp & 63; }
        else { const long p = (long)(i >> 1) * NGW + gw; if (p >= 4096) break; bh = (int)(p >> 6); x = (int)(p & 63); }
        const int blk = (i & 1) ? 127 - x : x;
        sb_unit(F, bh >> 3, bh & 7, blk); }
    __syncthreads();
    PB_END(11);
}

constexpr int NPHASE = 1 + 8 * DEPTH;
__global__ void __launch_bounds__(NWAVES * 64, 2) mk_fwd(Args args) {
    extern __shared__ __attribute__((aligned(16))) unsigned char lds_raw[];
    Frame F;
    F.lds = (LAS unsigned char*)lds_raw;
    F.MISC = (volatile LAS unsigned*)(F.lds + MISC_OFF);
    F.tid = threadIdx.x; F.lane = F.tid & 63; F.wave = __builtin_amdgcn_readfirstlane(F.tid >> 6); F.G = gridDim.x;
    F.ws = args.ws; F.ctl = (gu32*)(args.ws + WS_CTL); F.out = args.out;
    for (int u = F.tid; u < (LDS_BYTES - LDSCTL_OFF) / 4; u += NWAVES * 64) ((LAS unsigned*)(F.lds + LDSCTL_OFF))[u] = 0u;
    __syncthreads();
    const unsigned my_xcc = xb_xcc_id(); unsigned my_rank = 0;
    if (F.tid == 0) my_rank = __hip_atomic_fetch_add((unsigned*)(F.ctl + CW_XRANK) + my_xcc, 1u, RLX_AGENT);
    my_rank = (unsigned)__builtin_amdgcn_readfirstlane((int)my_rank);
    if (F.tid == 0) ((volatile LAS unsigned*)(F.lds + MISC_OFF))[12] = my_rank;
    __syncthreads();
    my_rank = ((volatile LAS unsigned*)(F.lds + MISC_OFF))[12];
    F.vcu = (int)blockIdx.x; F.cx = (int)blockIdx.x; F.local_ok = 0;
    XcdBarrier bar; bar.bar = (unsigned*)(F.ctl + CW_BAR); bar.x = 0; bar.st = nullptr;
    if (!MK_SPLIT) bar = xcd_barrier_post((unsigned*)(F.ctl + CW_BAR), F.MISC + 8);
    F.pb_t0 = 0; F.pb_acc = 0;
    const int lo = args.ph_lo, hi = args.ph_hi;
#define IN(k) (lo <= (k) && (k) < hi)
#define SEAM(k) do { if (IN(k) && IN((k) + 1)) xcd_barrier(bar); } while (0)
#define SEAM_L(k) do { if (IN(k) && IN((k) + 1)) { if (F.local_ok) xcc_barrier((unsigned*)(F.ctl + CW_LBAR), my_xcc, (unsigned)F.G / 8u, (unsigned*)(F.ctl + CW_BAR) + XB_TMO); else xcd_barrier(bar); } } while (0)
#define REFRESH() int gw, NGW, c; do { int t_ = threadIdx.x; asm volatile("" : "+v"(t_)); F.tid = t_; F.lane = t_ & 63; F.wave = __builtin_amdgcn_readfirstlane(t_ >> 6); \
        gw = F.vcu * NWAVES + F.wave; NGW = F.G * NWAVES; c = F.cx; (void)gw; (void)NGW; (void)c; } while (0)

    PB_START(0);
    if (PH_ON(0) && IN(0)) { REFRESH();
        convert_small_weights(F, gw, NGW);
        convert_moe_weights(F, 0, gw, NGW);
        rows_phase<false, false, false, true>(F, KIN(0), nullptr, 2 * gw, 2 * NGW, T);
    }
    SEAM(0);
    PB_END(0);
    if (!MK_SPLIT) {
        LAS unsigned* xc = (LAS unsigned*)(F.lds + WSF_OFF);
        if (F.tid < 16) xc[F.tid] = __hip_atomic_load((unsigned*)(F.ctl + CW_XRANK) + F.tid, RLX_AGENT);
        __syncthreads();
        unsigned pre = 0, tot = 0, uni = 1u;
#pragma unroll
        for (unsigned j = 0; j < 16; ++j) { const unsigned cj = xc[j]; pre += (j < my_xcc) ? cj : 0u; tot += cj; uni &= (cj == 0u || cj * 8u == (unsigned)F.G) ? 1u : 0u; }
        F.local_ok = (uni && tot == (unsigned)F.G && F.G == 256) ? 1 : 0;
        if (tot == (unsigned)F.G) { F.vcu = (int)(pre + my_rank); const int per = F.G / 8; F.cx = (F.G % 8 == 0) ? (F.vcu % per) * 8 + F.vcu / per : F.vcu; }
        __syncthreads(); }
#pragma nounroll
    for (int l = 0; l < DEPTH; ++l) {
        const int pb = 1 + 8 * l;
        PB_START(1);
        if (PH_ON(1) && IN(pb + 0)) {   REFRESH();
            SchedPlain S{(const char*)(F.ws + WS_XB), (const char*)(F.ws + WS_WIN_T) + (size_t)l * NIN * D * 2, 128, 20, D, F.G, c, (const int*)(F.ws + WS_RSTD1), nullptr};
            LAS float* gl = (LAS float*)(F.lds + LUT_OFF);
            if (F.tid < 128) gl[F.tid] = (F.tid < 64) ? KIN(4)[l * 64 + F.tid] * C2 : KIN(5)[l * 64 + F.tid - 64];
            __syncthreads();
            EpiInProj E{F.ws, gl, (const LAS float*)(F.lds + AUX_OFF)};
            pg8::gemm_phase<EpiInProj, SchedPlain>(F.lds, D, S, E);
        }
        SEAM_L(pb + 0);
        PB_END(1);
        PB_START(2);
        if (PH_ON(2) && IN(pb + 1)) { REFRESH(); attention_phase(F, l); }
        SEAM_L(pb + 1);
        PB_END(2);
        PB_START(3);
        if (PH_ON(3) && IN(pb + 2)) {   REFRESH();
            SchedBranch S{(const char*)(F.ws + WS_DQ), (const char*)(F.ws + WS_SBQ), (const char*)(F.ws + WS_WBD_T) + (size_t)l * D * 512 * 2, (const char*)(F.ws + WS_WBS_T) + (size_t)l * D * 512 * 2, F.G, c};
            EpiBranch E{(const unsigned char*)(F.ws + WS_G1), (bf16*)(F.ws + WS_MIXED)};
            pg8::gemm_phase<EpiBranch, SchedBranch>(F.lds, 512, S, E);
        }
        SEAM_L(pb + 2);
        PB_END(3);
        PB_START(4);
        if (PH_ON(4) && IN(pb + 3)) {   REFRESH();
            SchedPlain S{(const char*)(F.ws + WS_MIXED), (const char*)(F.ws + WS_WOUT_T) + (size_t)l * D * D * 2, 128, 4, D, F.G, c};
            EpiOutProj E{(bf16*)(F.ws + WS_XB), (unsigned char*)(F.ws + WS_XB8)};
            pg8::gemm_phase<EpiOutProj, SchedPlain>(F.lds, D, S, E);
        }
        SEAM_L(pb + 3);
        PB_END(4);
        PB_START(5);
        if (PH_ON(5) && IN(pb + 4)) { REFRESH(); router_phase(F, l); }
        SEAM(pb + 4);
        PB_END(5);
        PB_START(7);
        if (PH_ON(7) && IN(pb + 5)) {   REFRESH();
            build_ust(F, l);
            SchedMoe<true> S{(const char*)(F.ws + WS_XB8), (const char*)(F.ws + WS_WGU_T), (const LAS int*)(F.lds + MOE_OFF), (const int*)(F.ws + WS_ENT_TOK), (const int*)(F.ws + WS_ENT_RS), nullptr, D / 2, (size_t)1024 * 1024, F.G, c};
            EpiMoe1 E{(const LAS float*)(F.lds + AUX_OFF), (unsigned char*)(F.ws + WS_ACT)};
            pg8::gemm_phase<EpiMoe1, SchedMoe<true>>(F.lds, D / 2, S, E);
        }
        SEAM_L(pb + 5);
        PB_END(7);
        PB_START(8);
        if (PH_ON(8) && IN(pb + 6)) {   REFRESH();
            build_ust(F, l);
            SchedMoe<false> S{(const char*)(F.ws + WS_ACT), (const char*)(F.ws + WS_WDN_T), (const LAS int*)(F.lds + MOE_OFF), (const int*)(F.ws + WS_IDENT), (const int*)(F.ws + WS_ENT_TOK), (const int*)(F.ws + WS_ENT_W), DFF / 2, (size_t)1024 * 512, F.G, c};
            EpiMoe2 E{(const LAS int*)(F.lds + AUX_OFF), (unsigned char*)(F.ws + WS_CONTRIB)};
            pg8::gemm_phase<EpiMoe2, SchedMoe<false>>(F.lds, DFF / 2, S, E);
        }
        SEAM(pb + 6);
        PB_END(8);
        PB_START(9);
        if (PH_ON(9) && IN(pb + 7)) {   REFRESH();
            const int per = F.G / 8, xg = F.vcu / per, lw = (F.vcu % per) * NWAVES + F.wave; const bool al = (F.G == 256);
            const int mf = al ? 4096 * xg + 2 * lw : 2 * gw, ms = al ? 512 : 2 * NGW, me = al ? 4096 * xg + 4096 : T;
            if (l + 1 < DEPTH) { rows_phase<true, true, false, true>(F, nullptr, nullptr, mf, ms, me); convert_moe_weights(F, l + 1, gw, NGW); }
            else rows_phase<true, true, true, false>(F, nullptr, F.out, mf, ms, me);
        }
        if (l + 1 < DEPTH) SEAM_L(pb + 7);
        PB_END(9);
    }
    if (PROBE_TYPE >= 0 && blockIdx.x == 0 && threadIdx.x == 0) { const unsigned long long te = __builtin_amdgcn_s_memrealtime();
        while (__builtin_amdgcn_s_memrealtime() - te < PROBE_AMP * F.pb_acc) __builtin_amdgcn_s_sleep(8); }
#undef IN
#undef SEAM
}

extern "C" void kernel_launch(void* const* d_in, const int* in_sizes, int n_in, void* d_out, int out_size, void* d_ws, size_t ws_size, hipStream_t stream) {
    static int grid = 0;
    if (grid == 0) {
        if (n_in != 20 || in_sizes[0] != T * D || out_size != T * D || ws_size < WS_END) { fprintf(stderr, "kernel_launch: unexpected shapes / workspace (n_in %d, ws %zu, need %zu)\n", n_in, ws_size, (size_t)WS_END); grid = -1; return; }
        int dev = 0, cus = 0, per_cu = 0;
        if (hipGetDevice(&dev) != hipSuccess || hipDeviceGetAttribute(&cus, hipDeviceAttributeMultiprocessorCount, dev) != hipSuccess) { grid = -1; return; }
        if (hipFuncSetAttribute((const void*)mk_fwd, hipFuncAttributeMaxDynamicSharedMemorySize, LDS_BYTES) != hipSuccess) { fprintf(stderr, "kernel_launch: hipFuncSetAttribute failed\n"); grid = -1; return; }
        if (hipOccupancyMaxActiveBlocksPerMultiprocessor(&per_cu, (const void*)mk_fwd, NWAVES * 64, LDS_BYTES) != hipSuccess || per_cu < 1) fprintf(stderr, "kernel_launch: occupancy query reports %d\n", per_cu);
        (void)hipGetLastError();
        grid = cus;
    }
    if (grid < 0) return;
    if (hipMemsetAsync((char*)d_ws + WS_CTL, 0, CTL_ZERO_BYTES, stream) != hipSuccess) return;
    Args a{};
    for (int i = 0; i < 20; ++i) a.in[i] = (const float*)d_in[i];
    a.out = (float*)d_out; a.ws = (unsigned char*)d_ws;
#if MK_SPLIT
    for (int p = 0; p < NPHASE; ++p) { a.ph_lo = p; a.ph_hi = p + 1; hipLaunchKernelGGL(mk_fwd, dim3(grid), dim3(NWAVES * 64), LDS_BYTES, stream, a); }
#else
    a.ph_lo = 0; a.ph_hi = NPHASE;
    hipLaunchKernelGGL(mk_fwd, dim3(grid), dim3(NWAVES * 64), LDS_BYTES, stream, a);
#endif
}
```

```cpp
#include <hip/hip_runtime.h>
#include <cstdio>
#include <cstdint>

#define GAS __attribute__((address_space(1)))
#define LAS __attribute__((address_space(3)))
typedef unsigned short bf16;
typedef short bf16x8 __attribute__((ext_vector_type(8)));
typedef short s16x4 __attribute__((ext_vector_type(4)));
typedef short v4i16_t __attribute__((ext_vector_type(4)));
typedef float f32x2 __attribute__((ext_vector_type(2)));
typedef float f32x4 __attribute__((ext_vector_type(4)));
typedef float f32x16 __attribute__((ext_vector_type(16)));
typedef unsigned u32x2 __attribute__((ext_vector_type(2)));
typedef unsigned u32x4 __attribute__((ext_vector_type(4)));
typedef int v4i_t __attribute__((ext_vector_type(4)));
typedef GAS unsigned gu32;

constexpr int T = 32768, SEQ = 4096, NB = 8, D = 1024, NIN = 5120, DEPTH = 2;
constexpr int NE = 32, DFF = 512;
constexpr float EPS = 1e-6f;
constexpr float LOG2E = 1.4426950408889634f;
constexpr float C2 = 0.125f * LOG2E;
constexpr int NWAVES = 8;
#ifndef SB_EARLY_EXIT
#define SB_EARLY_EXIT 1
#endif
#define SB_EXIT_LOG2 64.f
#ifndef MK_SPLIT
#define MK_SPLIT 0
#endif
#ifndef PH_MASK
#define PH_MASK 0x3ff
#endif
#define PH_ON(k) (((PH_MASK) >> (k)) & 1)
#ifndef PROBE_TYPE
#define PROBE_TYPE -1
#endif
#define PROBE_AMP 8
#define PB_START(k) do { if (PROBE_TYPE == (k)) F.pb_t0 = __builtin_amdgcn_s_memrealtime(); } while (0)
#define PB_END(k) do { if (PROBE_TYPE == (k)) F.pb_acc += __builtin_amdgcn_s_memrealtime() - F.pb_t0; } while (0)

constexpr size_t MiB = 1u << 20;
constexpr size_t WS_CTL = 0, CTL_ZERO_BYTES = 1 * MiB;
constexpr size_t WS_RSTD1 = 1 * MiB;
constexpr size_t WS_IDENT = 2 * MiB;
constexpr size_t WS_WR_T = 5 * MiB;
constexpr size_t WS_WIN_T = 8 * MiB;
constexpr size_t WS_WBD_T = 28 * MiB;
constexpr size_t WS_WBS_T = 30 * MiB;
constexpr size_t WS_WOUT_T = 32 * MiB;
constexpr size_t WS_WGU_T = 36 * MiB;
constexpr size_t WS_WDN_T = 100 * MiB;
constexpr size_t WS_XB = 132 * MiB;
constexpr size_t WS_R0 = 196 * MiB;
constexpr size_t WS_DQ = WS_R0;
constexpr size_t WS_DK = WS_R0 + 32 * MiB;
constexpr size_t WS_VA = WS_R0 + 64 * MiB;
constexpr size_t WS_SBQ = WS_R0 + 96 * MiB;
constexpr size_t WS_SBK = WS_R0 + 128 * MiB;
constexpr size_t WS_SBV = WS_R0 + 160 * MiB;
constexpr size_t WS_G1 = WS_R0 + 192 * MiB;
constexpr size_t WS_MIXED = WS_G1;
constexpr int PMAX = 65536 + 32 * 256;
constexpr size_t WS_ACT = WS_SBK;
constexpr size_t WS_XB8 = WS_DK;
constexpr float W8_SCALE = 64.f, A8_SCALE = 2.f, C8_SCALE = 32.f;
constexpr size_t WS_CONTRIB = WS_G1;
constexpr int ECAP = 32768;
constexpr size_t WS_ENT_TOK = 68 * MiB;
constexpr size_t WS_ENT_W = 72 * MiB;
constexpr size_t WS_ENT_RS = 76 * MiB;
constexpr size_t WS_END = WS_R0 + 256 * MiB;

constexpr int CW_BAR = 4096;
constexpr int CW_LBAR = 20480;
constexpr int CW_XRANK = 12288;
constexpr int CW_CNT = 16384;

constexpr int RING_BYTES = 131072;
constexpr int LDSCTL_OFF = RING_BYTES, MISC_OFF = LDSCTL_OFF + 320;
constexpr int LUT_OFF = LDSCTL_OFF + 512;
constexpr int WSF_OFF = LDSCTL_OFF + 2560;
constexpr int MOE_OFF = LDSCTL_OFF + 4608;
constexpr int AUX_OFF = LDSCTL_OFF + 7680;
constexpr int IDT_OFF = LDSCTL_OFF + 5632;
constexpr int LDS_BYTES = 147456;

#define RLX_AGENT __ATOMIC_RELAXED, __HIP_MEMORY_SCOPE_AGENT
#define LDS_WAIT() asm volatile("s_waitcnt lgkmcnt(0)" ::: "memory")
#define VM_WAIT() asm volatile("s_waitcnt vmcnt(0)" ::: "memory")
__device__ __forceinline__ unsigned cvt_pk_bf16(float lo, float hi) { unsigned r; asm volatile("v_cvt_pk_bf16_f32 %0, %1, %2" : "=v"(r) : "v"(lo), "v"(hi)); return r; }
__device__ __forceinline__ float bf_lo(unsigned w) { return __uint_as_float(w << 16); }
__device__ __forceinline__ float bf_hi(unsigned w) { return __uint_as_float(w & 0xffff0000u); }
__device__ __forceinline__ float wave_sum(float v) {
#pragma unroll
    for (int o = 1; o < 64; o <<= 1) v += __shfl_xor(v, o);
    return v;
}
__device__ __forceinline__ u32x2 pack8_fp8(const float (&a)[8]) {
    int w0 = 0, w1 = 0;
    w0 = __builtin_amdgcn_cvt_pk_fp8_f32(a[0], a[1], w0, false); w0 = __builtin_amdgcn_cvt_pk_fp8_f32(a[2], a[3], w0, true);
    w1 = __builtin_amdgcn_cvt_pk_fp8_f32(a[4], a[5], w1, false); w1 = __builtin_amdgcn_cvt_pk_fp8_f32(a[6], a[7], w1, true);
    u32x2 r; r.x = (unsigned)w0; r.y = (unsigned)w1; return r;
}
__device__ __forceinline__ float fexp2(float x) { return __builtin_amdgcn_exp2f(x); }
__device__ __forceinline__ float flog2(float x) { return __builtin_amdgcn_logf(x); }

#define XB_TMO      128
#define XB_XCNT(j)  (256  + 64 * (j))
#define XB_XSUB(j)  (1280 + 64 * (j))
#define XB_XGEN(j)  (2304 + 64 * (j))
#define XB_TOP      3328
#define XB_TOPGEN   3392
#define XCD_BAR_WORDS 3456
#define XB_SPIN_CAP (1u << 23)
__device__ __forceinline__ unsigned xb_ld(unsigned* p)              { return __hip_atomic_load(p, __ATOMIC_RELAXED, __HIP_MEMORY_SCOPE_AGENT); }
__device__ __forceinline__ unsigned xb_add(unsigned* p, unsigned v) { return __hip_atomic_fetch_add(p, v, __ATOMIC_RELAXED, __HIP_MEMORY_SCOPE_AGENT); }
__device__ __forceinline__ unsigned xb_xcc_id() { return (unsigned)__builtin_amdgcn_s_getreg((3 << 11) | 20) & 0xFu; }
#define XB_SPIN(cond, bar) do { unsigned _sp = 0; while (cond) { __builtin_amdgcn_s_sleep(1); \
    if ((++_sp & 255u) == 0u) { if (xb_ld(&(bar)[XB_TMO])) break; if (_sp > XB_SPIN_CAP) { atomicAdd(&(bar)[XB_TMO], 1u); break; } } } } while (0)
struct XcdBarrier { unsigned* bar; unsigned x; volatile LAS unsigned* st; };
__device__ __forceinline__ XcdBarrier xcd_barrier_post(unsigned* bar, volatile LAS unsigned* st) {
    XcdBarrier b; b.bar = bar; b.x = xb_xcc_id(); b.st = st;
    if (threadIdx.x == 0) (void)xb_add(&bar[XB_XCNT(b.x)], 1u);
    return b;
}
__device__ __forceinline__ void xcd_barrier_complete(unsigned* bar, unsigned x, unsigned& nloc, unsigned& nx) {
    const unsigned G = gridDim.x * gridDim.y * gridDim.z;
    unsigned sum, cnt, mine, sp = 0u;
    for (;;) {
        sum = 0u; cnt = 0u; mine = 0u;
#pragma unroll
        for (unsigned j = 0; j < 16; ++j) { const unsigned c = xb_ld(&bar[XB_XCNT(j)]); sum += c; cnt += (c > 0u) ? 1u : 0u; mine = (j == x) ? c : mine; }
        if (sum == G) break;
        __builtin_amdgcn_s_sleep(1);
        if ((++sp & 255u) == 0u) { if (xb_ld(&bar[XB_TMO])) break; if (sp > XB_SPIN_CAP) { atomicAdd(&bar[XB_TMO], 1u); break; } }
    }
    nloc = mine > 0u ? mine : 1u; nx = cnt > 0u ? cnt : 1u;
}
__device__ __forceinline__ void xcd_barrier(const XcdBarrier& b) {
    asm volatile("s_waitcnt vmcnt(0)" ::: "memory");
    __syncthreads();
    if (threadIdx.x == 0) {
        unsigned* bar = b.bar;
        __builtin_amdgcn_s_waitcnt(0);
        unsigned nloc = b.st[0], nx = b.st[1];
        if (nloc == 0u) { xcd_barrier_complete(bar, b.x, nloc, nx); b.st[0] = nloc; b.st[1] = nx; }
        const unsigned old = xb_add(&bar[XB_XSUB(b.x)], 1u);
        const unsigned gen = old / nloc;
        if (old + 1u == (gen + 1u) * nloc) {
            __builtin_amdgcn_fence(__ATOMIC_RELEASE, "agent");
            asm volatile("s_waitcnt vmcnt(0)" ::: "memory");
            const unsigned og = xb_add(&bar[XB_TOP], 1u);
            const unsigned tg = og / nx;
            if (og + 1u == (tg + 1u) * nx) xb_add(&bar[XB_TOPGEN], 1u);
            else XB_SPIN(xb_ld(&bar[XB_TOPGEN]) == tg, bar);
            __builtin_amdgcn_fence(__ATOMIC_ACQUIRE, "agent");
            xb_add(&bar[XB_XGEN(b.x)], 1u);
            asm volatile("s_waitcnt vmcnt(0)" ::: "memory");
        } else {
            XB_SPIN(xb_ld(&bar[XB_XGEN(b.x)]) == gen, bar);
            __builtin_amdgcn_fence(__ATOMIC_ACQUIRE, "agent");
            asm volatile("s_waitcnt vmcnt(0)" ::: "memory");
        }
    }
    __syncthreads();
}

__device__ __forceinline__ void xcc_barrier(unsigned* lb, unsigned x, unsigned nloc, unsigned* tmo) {
    asm volatile("s_waitcnt vmcnt(0)" ::: "memory");
    __syncthreads();
    if (threadIdx.x == 0) {
        const unsigned old = xb_add(&lb[64 * x], 1u), gen = old / nloc;
        if (old + 1u == (gen + 1u) * nloc) xb_add(&lb[1024 + 64 * x], 1u);
        else { unsigned sp = 0; while (xb_ld(&lb[1024 + 64 * x]) == gen) { __builtin_amdgcn_s_sleep(1);
                   if ((++sp & 255u) == 0u) { if (xb_ld(tmo)) break; if (sp > XB_SPIN_CAP) { atomicAdd(tmo, 1u); break; } } } }
        __builtin_amdgcn_fence(__ATOMIC_ACQUIRE, "agent");
        asm volatile("s_waitcnt vmcnt(0)" ::: "memory");
    }
    __syncthreads();
}

namespace pg8 {
constexpr int BM = 256, BK = 64, HALF = 128, HTB = HALF * BK * 2, STAGE_BYTES = 8 * HTB, NXCD = 8, WGM = 8;
__host__ __device__ __forceinline__ int lds_byte(int r, int c) { const int st = (r >> 4) * 2 + (c >> 5), rr = r & 15, cc = c & 31, ob = rr * 64 + cc * 2; return st * 1024 + (ob ^ (((ob >> 9) & 1) << 5)); }
__host__ __device__ __forceinline__ void stage_rc(int b, int& R, int& C) { const int st = b / 1024, sb = b % 1024, swz = sb ^ (((sb >> 9) & 1) << 5); R = (st >> 1) * 16 + swz / 64; C = (st & 1) * 32 + (swz % 64) / 2; }
__host__ __device__ __forceinline__ int perm32(int rho) { const int n = rho >> 4, i = rho & 15; return 8 * (i >> 2) + 4 * n + (i & 3); }

struct Unit { const char* A; const char* B; int pm, pn, kind, eoff, nvalid, goff, gnv, slot; };
constexpr int KEEP = 0x100;

__device__ __forceinline__ void tile_order(int L, int nM, int nN, int& pm, int& pn) {
    const int nwg = nM * nN; int wgid = L;
    { const int q = nwg / NXCD, r = nwg % NXCD, xcd = wgid % NXCD, off = wgid / NXCD; wgid = (xcd < r ? xcd * (q + 1) : r * (q + 1) + (xcd - r) * q) + off; }
    const int nig = WGM * nN, gid = wgid / nig, fm = gid * WGM, gsz = (nM - fm) < WGM ? (nM - fm) : WGM;
    pm = fm + ((wgid % nig) % gsz); pn = (wgid % nig) / gsz;
}

template <class Epi, class Sched, bool ALIGN_EPI = true, bool SP2 = true>
__device__ __forceinline__ void gemm_phase(LAS unsigned char* lds, const int K_, const Sched& S, const Epi& E, unsigned long long* pb = nullptr) {
    int tid_ = threadIdx.x; asm volatile("" : "+v"(tid_));
    const int tid = tid_, wid = __builtin_amdgcn_readfirstlane(tid >> 6), lane = tid & 63, wr = wid >> 2, wc = wid & 3, fr = lane & 15, fq = lane >> 4;
    int K = K_; asm volatile("" : "+s"(K));
    const int nt = K / BK;
    unsigned voffA[2], voffB[2]; int gR[2]; unsigned gC[2];
#pragma unroll
    for (int i = 0; i < 2; ++i) { int R, C; stage_rc(tid * 16 + i * 8192, R, C); const int Rb = Epi::PERM ? ((R & ~31) + perm32(R & 31)) : R;
        voffA[i] = (unsigned)(R * K + C) * 2u; voffB[i] = (unsigned)(Rb * K + C) * 2u; gR[i] = R; gC[i] = (unsigned)C * 2u; }
    unsigned voffG[2][2]; (void)gR; (void)gC;
    LAS int* idtab = (LAS int*)(lds + STAGE_BYTES + (IDT_OFF - RING_BYTES));
#define PG8_IDS_DMA(u_, slot) do { if (wid < 4) { int t_ = tid; asm volatile("" : "+v"(t_));   \
        __builtin_amdgcn_global_load_lds((const unsigned*)(S.ids + (u_).goff + t_), (LAS unsigned*)(idtab + (slot) * 256 + wid * 64), 4, 0, 0); } } while (0)
    LAS int* auxt = (LAS int*)(lds + STAGE_BYTES + (AUX_OFF - RING_BYTES));
#define PG8_AUX_DMA(u_) do { if (wid < 4) { int t_ = tid; asm volatile("" : "+v"(t_)); \
        if (S.aux0) __builtin_amdgcn_global_load_lds((const unsigned*)(S.aux0 + (u_).eoff + t_), (LAS unsigned*)(auxt + (u_).slot * 256 + wid * 64), 4, 0, 0); \
        if (S.aux1) __builtin_amdgcn_global_load_lds((const unsigned*)(S.aux1 + (u_).eoff + t_), (LAS unsigned*)(auxt + 768 + (u_).slot * 256 + wid * 64), 4, 0, 0); } } while (0)
#define PG8_IDS_READ(u_, slot) do { _Pragma("unroll") for (int i_ = 0; i_ < 2; ++i_) { int g_ = gR[i_]; asm volatile("" : "+v"(g_)); _Pragma("unroll") for (int h_ = 0; h_ < 2; ++h_) { const int r_ = h_ * 128 + g_; int id_ = idtab[(slot) * 256 + r_]; \
        id_ = (r_ < (u_).gnv) ? (id_ >> 1) : 0; voffG[h_][i_] = (unsigned)id_ * (unsigned)(K * 2) + gC[i_]; } } } while (0)
#define PG8_STAGE_A(buf, h, gbase) do { if constexpr (Sched::GATHER) { PG8_STAGE(PG8_SA(buf, h), gbase, voffG[h]); } else { PG8_STAGE(PG8_SA(buf, h), (gbase) + (h) * hstep, voffA); } } while (0)
    const size_t kstep = (size_t)(BK * 2);
    const size_t hstep = (size_t)HALF * K * 2;
    const unsigned ldsw = (unsigned)wid * 1024u;
    constexpr bool F8 = Sched::FP8;
    const int aoff = lds_byte(wr * 64 + fr, fq * 8), boff = lds_byte(wc * 32 + fr, fq * 8);
    constexpr int KSTEP = 1024;
#define PG8_SA(b, h) (((b) * 2 + (h)) * HTB)
#define PG8_SB(b, h) ((4 + (b) * 2 + (h)) * HTB)
#define PG8_STAGE(bufoff, gbase, voff) do { _Pragma("unroll") for (int _i = 0; _i < 2; ++_i) \
        __builtin_amdgcn_global_load_lds((const unsigned*)((const char*)(gbase) + (voff)[_i]), (LAS unsigned*)(lds + (bufoff) + ldsw + _i * 8192), 16, 0, 0); } while (0)
#define PG8_LDA(dst, b, h) do { _Pragma("unroll") for (int m = 0; m < 4; ++m) _Pragma("unroll") for (int k = 0; k < 2; ++k) dst[m][k] = *(const LAS bf16x8*)(lds + PG8_SA(b, h) + aoff + m * 2048 + k * KSTEP); } while (0)
#define PG8_LDB(dst, b, h) do { _Pragma("unroll") for (int n = 0; n < 2; ++n) _Pragma("unroll") for (int k = 0; k < 2; ++k) dst[n][k] = *(const LAS bf16x8*)(lds + PG8_SB(b, h) + boff + n * 2048 + k * KSTEP); } while (0)
#define PG8_CAT(x) __builtin_shufflevector(__builtin_bit_cast(v4i_t, (x)[0]), __builtin_bit_cast(v4i_t, (x)[1]), 0, 1, 2, 3, 4, 5, 6, 7)
#define PG8_MMA(ai, bj, At, Bt) do { __builtin_amdgcn_s_setprio(1); if constexpr (F8) { _Pragma("unroll") for (int m = 0; m < 4; ++m) _Pragma("unroll") for (int n = 0; n < 2; ++n) \
        acc[ai][bj][m][n] = __builtin_amdgcn_mfma_scale_f32_16x16x128_f8f6f4(PG8_CAT(Bt[n]), PG8_CAT(At[m]), acc[ai][bj][m][n], 0, 0, 0, 0x7f7f7f7f, 0, 0x7f7f7f7f); } else { \
        _Pragma("unroll") for (int m = 0; m < 4; ++m) _Pragma("unroll") for (int n = 0; n < 2; ++n) _Pragma("unroll") for (int k = 0; k < 2; ++k) \
        acc[ai][bj][m][n] = __builtin_amdgcn_mfma_f32_16x16x32_bf16(Bt[n][k], At[m][k], acc[ai][bj][m][n], 0, 0, 0); } __builtin_amdgcn_s_setprio(0); } while (0)
#define PG8_WAIT_V(n) asm volatile("s_waitcnt vmcnt(" #n ")" ::: "memory")
#define PG8_WAIT_L(n) asm volatile("s_waitcnt lgkmcnt(" #n ")" ::: "memory")
#define PG8_BAR __builtin_amdgcn_s_barrier()
#define PG8_SCHED __builtin_amdgcn_sched_barrier(0)
    Unit cur, nxt; int ui = 0;
    if (!S.next(0, cur)) return;
    f32x4 acc[2][2][4][2];
#pragma unroll
    for (int a = 0; a < 2; ++a)
#pragma unroll
        for (int b = 0; b < 2; ++b)
#pragma unroll
            for (int m = 0; m < 4; ++m)
#pragma unroll
                for (int n = 0; n < 2; ++n) acc[a][b][m][n] = (f32x4){0.f, 0.f, 0.f, 0.f};
    bf16x8 At[4][2], B0[2][2], B1[2][2];
    const char* cA = cur.A; const char* cB = cur.B;
    static_assert(SP2, "only the SP2 loop is kept here");
    cur.slot = 0;
    if constexpr (Sched::GATHER) { PG8_IDS_DMA(cur, 0); PG8_AUX_DMA(cur); PG8_WAIT_V(0); __syncthreads(); PG8_IDS_READ(cur, 0); }
    else if (S.aux0) { PG8_AUX_DMA(cur); PG8_WAIT_V(0); __syncthreads(); }
    PG8_STAGE(PG8_SB(0, 0), cB, voffB); PG8_STAGE(PG8_SB(0, 1), cB + hstep, voffB); PG8_STAGE_A(0, 0, cA); PG8_STAGE_A(0, 1, cA);
    if (wr == 1) PG8_BAR;
    PG8_WAIT_V(2); PG8_BAR;
    PG8_STAGE(PG8_SB(1, 0), cB + kstep, voffB); PG8_STAGE_A(1, 0, cA + kstep); PG8_STAGE(PG8_SB(1, 1), cB + hstep + kstep, voffB);
    PG8_WAIT_V(6); PG8_BAR;
    for (;;) {
        const bool has_next = S.next(ui + 1, nxt);
        const char* nA = has_next ? nxt.A : cA; const char* nB = has_next ? nxt.B : cB;
        nxt.slot = (cur.slot == 2) ? 0 : cur.slot + 1;
        if constexpr (Sched::GATHER) { if (has_next) { PG8_IDS_DMA(nxt, (ui + 1) & 1); PG8_AUX_DMA(nxt); } }
        else { if (has_next && S.aux0) PG8_AUX_DMA(nxt); }
#pragma nounroll
        for (int t = 0; t < nt; t += 2) {
            unsigned long long pbt = 0; if (pb && (PROBE_TYPE == 21 || PROBE_TYPE == 22)) pbt = __builtin_amdgcn_s_memrealtime();
            const bool last = (t == nt - 2);
            const char* a1 = cA + (size_t)(t + 1) * kstep;
            const char* a2 = last ? nA : cA + (size_t)(t + 2) * kstep; const char* b2 = last ? nB : cB + (size_t)(t + 2) * kstep;
            const char* a3 = a2 + kstep; const char* b3 = b2 + kstep;
            PG8_LDB(B0, 0, 0); PG8_LDB(B1, 0, 1); PG8_SCHED; PG8_LDA(At, 0, 0); PG8_STAGE_A(1, 1, a1);
            if constexpr (Sched::GATHER) { if (last && has_next) PG8_IDS_READ(nxt, (ui + 1) & 1); }
            PG8_WAIT_V(8); PG8_WAIT_L(0); PG8_BAR; PG8_MMA(0, 0, At, B0); PG8_MMA(0, 1, At, B1); PG8_BAR; PG8_SCHED;
            PG8_LDA(At, 0, 1); PG8_STAGE(PG8_SB(0, 0), b2, voffB); PG8_STAGE(PG8_SB(0, 1), b2 + hstep, voffB); PG8_STAGE_A(0, 0, a2);
            PG8_WAIT_V(8); PG8_WAIT_L(0); PG8_BAR; PG8_MMA(1, 0, At, B0); PG8_MMA(1, 1, At, B1); PG8_BAR; PG8_SCHED;
            PG8_LDB(B0, 1, 0); PG8_LDB(B1, 1, 1); PG8_SCHED; PG8_LDA(At, 1, 0); PG8_STAGE_A(0, 1, a2);
            PG8_WAIT_V(8); PG8_WAIT_L(0); PG8_BAR; PG8_MMA(0, 0, At, B0); PG8_MMA(0, 1, At, B1); PG8_BAR; PG8_SCHED;
            PG8_LDA(At, 1, 1); PG8_STAGE(PG8_SB(1, 0), b3, voffB); PG8_STAGE(PG8_SB(1, 1), b3 + hstep, voffB); PG8_STAGE_A(1, 0, a3);
            PG8_WAIT_V(8); PG8_WAIT_L(0); PG8_BAR; PG8_MMA(1, 0, At, B0); PG8_MMA(1, 1, At, B1); PG8_BAR; PG8_SCHED;
            if (pb && ((PROBE_TYPE == 21 && t == 0) || (PROBE_TYPE == 22 && t != 0))) *pb += __builtin_amdgcn_s_memrealtime() - pbt;
        }
        unsigned long long pbe = 0; if (pb && PROBE_TYPE == 20) pbe = __builtin_amdgcn_s_memrealtime();
        if constexpr (ALIGN_EPI) { if (wr == 0) PG8_BAR; }
        { unsigned z_ = 0u; asm volatile("" : "+v"(z_));
          const int l_ = (int)__builtin_amdgcn_mbcnt_hi(~0u, __builtin_amdgcn_mbcnt_lo(~0u, z_));
          E(acc, cur, wr, wc, l_ & 15, l_ >> 4); }
        if (pb && PROBE_TYPE == 20) *pb += __builtin_amdgcn_s_memrealtime() - pbe;
        if (!has_next) break;
        if (!(cur.kind & KEEP)) {
#pragma unroll
            for (int a = 0; a < 2; ++a)
#pragma unroll
                for (int b = 0; b < 2; ++b)
#pragma unroll
                    for (int m = 0; m < 4; ++m)
#pragma unroll
                        for (int n = 0; n < 2; ++n) acc[a][b][m][n] = (f32x4){0.f, 0.f, 0.f, 0.f};
        }
        cur = nxt; cA = nA; cB = nB; ++ui;
        if constexpr (ALIGN_EPI) { if (wr == 1) PG8_BAR; }
    }
    PG8_WAIT_V(0);
    if constexpr (!ALIGN_EPI) { if (wr == 0) PG8_BAR; }
    PG8_BAR;
#undef PG8_SA
#undef PG8_SB
#undef PG8_STAGE
#undef PG8_STAGE_A
#undef PG8_IDS_DMA
#undef PG8_AUX_DMA
#undef PG8_IDS_READ
#undef PG8_LDA
#undef PG8_LDB
#undef PG8_MMA
#undef PG8_CAT
#undef PG8_WAIT_V
#undef PG8_WAIT_L
#undef PG8_BAR
#undef PG8_SCHED
}
}

struct Args { const float* in[20]; float* out; unsigned char* ws; int ph_lo, ph_hi; };
#define KIN(i) (((const __attribute__((address_space(4))) Args*)__builtin_amdgcn_kernarg_segment_ptr())->in[i])
struct Frame {
    LAS unsigned char* lds;
    volatile LAS unsigned* MISC;
    gu32* ctl;
    int tid, lane, wave, G;
    int vcu, cx, local_ok;
    unsigned char* ws;
    float* out;
    unsigned long long pb_t0, pb_acc;
};

using pg8::Unit;
typedef f32x4 Acc[2][2][4][2];

struct EpiInProj {
    static constexpr bool PERM = true;
    unsigned char* ws; const LAS float* gl; const LAS float* rs_tab;
    __device__ __forceinline__ void operator()(Acc& acc, const Unit& u, int wr, int wc, int fr, int fq) const {
        const int row0 = u.pm * 256 + wr * 64 + fr; const int pn = u.pn;
        float rs[2][4];
#pragma unroll
        for (int ai = 0; ai < 2; ++ai)
#pragma unroll
            for (int m = 0; m < 4; ++m) rs[ai][m] = rs_tab[u.slot * 256 + wr * 64 + fr + ai * 128 + m * 16];
        if (pn < 4) {
            const LAS float* g = gl + (pn >> 1) * 64 + 8 * fq;
            bf16* dst = (bf16*)(ws + WS_DQ + (size_t)(pn >> 1) * (32 * MiB)) + wc * 128 + (pn & 1) * 64 + 8 * fq;
#pragma unroll
            for (int ai = 0; ai < 2; ++ai)
#pragma unroll
                for (int m = 0; m < 4; ++m) {
                    const int row = row0 + ai * 128 + m * 16; const float r_ = rs[ai][m]; float ss = 0.f; f32x4 v[2][2];
#pragma unroll
                    for (int bj = 0; bj < 2; ++bj)
#pragma unroll
                        for (int n = 0; n < 2; ++n) { v[bj][n] = acc[ai][bj][m][n] * r_; ss += (v[bj][n][0] * v[bj][n][0] + v[bj][n][1] * v[bj][n][1]) + (v[bj][n][2] * v[bj][n][2] + v[bj][n][3] * v[bj][n][3]); }
                    ss += __shfl_xor(ss, 16); ss += __shfl_xor(ss, 32);
                    const float inv = __builtin_amdgcn_rsqf(ss * (1.0f / 64.0f) + EPS);
                    bf16* rowp = dst + (size_t)row * 512;
#pragma unroll
                    for (int bj = 0; bj < 2; ++bj) { const f32x4 g0 = *(const LAS f32x4*)(g + 32 * bj) * inv, g1 = *(const LAS f32x4*)(g + 32 * bj + 4) * inv; u32x4 w;
                        w.x = cvt_pk_bf16(v[bj][0][0] * g0[0], v[bj][0][1] * g0[1]); w.y = cvt_pk_bf16(v[bj][0][2] * g0[2], v[bj][0][3] * g0[3]);
                        w.z = cvt_pk_bf16(v[bj][1][0] * g1[0], v[bj][1][1] * g1[1]); w.w = cvt_pk_bf16(v[bj][1][2] * g1[2], v[bj][1][3] * g1[3]);
                        *(u32x4*)(rowp + bj * 32) = w; }
                }
        } else if (pn < 12) {
            const int sec = (pn - 4) >> 1; bf16* dst = (bf16*)(ws + WS_VA + (size_t)sec * (32 * MiB)) + ((pn - 4) & 1) * 256 + wc * 32 + 8 * fq; const float sc = (sec == 1) ? C2 : 1.f;
#pragma unroll
            for (int ai = 0; ai < 2; ++ai)
#pragma unroll
                for (int m = 0; m < 4; ++m) { const int row = row0 + ai * 128 + m * 16; const float r_ = rs[ai][m] * sc; bf16* rowp = dst + (size_t)row * 512;
#pragma unroll
                    for (int bj = 0; bj < 2; ++bj) { const f32x4 v0 = acc[ai][bj][m][0] * r_, v1 = acc[ai][bj][m][1] * r_; u32x4 w;
                        w.x = cvt_pk_bf16(v0[0], v0[1]); w.y = cvt_pk_bf16(v0[2], v0[3]); w.z = cvt_pk_bf16(v1[0], v1[1]); w.w = cvt_pk_bf16(v1[2], v1[3]);
                        *(u32x4*)(rowp + bj * 128) = w; } }
        } else {
            const int col0 = (pn - 12) * 128 + wc * 32 + 8 * fq; unsigned char* G = ws + WS_G1;
#pragma unroll
            for (int ai = 0; ai < 2; ++ai)
#pragma unroll
                for (int m = 0; m < 4; ++m) { const int row = row0 + ai * 128 + m * 16; const float r_ = rs[ai][m];
                    unsigned qa[8], qb[8];
#pragma unroll
                    for (int n = 0; n < 2; ++n)
#pragma unroll
                        for (int j = 0; j < 4; ++j) { const float ga = acc[ai][0][m][n][j] * r_, gb = acc[ai][1][m][n][j] * r_;
                            const float sa = __builtin_amdgcn_rcpf(1.f + fexp2(-ga * LOG2E)), sb = __builtin_amdgcn_rcpf(1.f + fexp2(-gb * LOG2E));
                            qa[n * 4 + j] = (unsigned)(sa * 255.f + 0.5f); qb[n * 4 + j] = max(1u, (unsigned)(sb * 255.f + 0.5f)); }
                    u32x4 w;
                    w.x = qa[0] | (qa[1] << 8) | (qa[2] << 16) | (qa[3] << 24); w.y = qa[4] | (qa[5] << 8) | (qa[6] << 16) | (qa[7] << 24);
                    w.z = qb[0] | (qb[1] << 8) | (qb[2] << 16) | (qb[3] << 24); w.w = qb[4] | (qb[5] << 8) | (qb[6] << 16) | (qb[7] << 24);
                    *(u32x4*)(G + (size_t)row * 2048 + (size_t)col0 * 2) = w; }
        }
    }
};

struct EpiBranch {
    static constexpr bool PERM = true;
    const unsigned char* G; bf16* MIXED;
    __device__ __forceinline__ void operator()(Acc& acc, const Unit& u, int wr, int wc, int fr, int fq) const {
        const int row0 = u.pm * 256 + wr * 64 + fr; const int col0 = u.pn * 256 + wc * 32 + 8 * fq; const bool first = (u.kind & 0xff) == 0;
        const unsigned char* Gp = G + (size_t)row0 * 2048 + (size_t)col0 * 2;
        u32x4 g[2][4][2];
#pragma unroll
        for (int ai = 0; ai < 2; ++ai)
#pragma unroll
            for (int m = 0; m < 4; ++m)
#pragma unroll
                for (int bj = 0; bj < 2; ++bj) g[ai][m][bj] = *(const u32x4*)(Gp + (size_t)(ai * 128 + m * 16) * 2048 + bj * 256);
#define UB(w, k) ((float)(((w) >> (8 * (k))) & 0xffu))
        if (first) {
#pragma unroll
            for (int ai = 0; ai < 2; ++ai)
#pragma unroll
                for (int m = 0; m < 4; ++m)
#pragma unroll
                    for (int bj = 0; bj < 2; ++bj) { u32x4 gg = g[ai][m][bj]; asm volatile("" : "+v"(gg));
                        f32x4 v0 = acc[ai][bj][m][0], v1 = acc[ai][bj][m][1];
                        v0[0] *= UB(gg.x, 0) * __builtin_amdgcn_rcpf(UB(gg.z, 0)); v0[1] *= UB(gg.x, 1) * __builtin_amdgcn_rcpf(UB(gg.z, 1)); v0[2] *= UB(gg.x, 2) * __builtin_amdgcn_rcpf(UB(gg.z, 2)); v0[3] *= UB(gg.x, 3) * __builtin_amdgcn_rcpf(UB(gg.z, 3));
                        v1[0] *= UB(gg.y, 0) * __builtin_amdgcn_rcpf(UB(gg.w, 0)); v1[1] *= UB(gg.y, 1) * __builtin_amdgcn_rcpf(UB(gg.w, 1)); v1[2] *= UB(gg.y, 2) * __builtin_amdgcn_rcpf(UB(gg.w, 2)); v1[3] *= UB(gg.y, 3) * __builtin_amdgcn_rcpf(UB(gg.w, 3));
                        acc[ai][bj][m][0] = v0; acc[ai][bj][m][1] = v1; }
        } else {
            bf16* Mp = MIXED + (size_t)row0 * 1024 + col0; asm volatile("" : "+v"(Mp)); const float q = 1.0f / 255.0f;
#pragma unroll
            for (int ai = 0; ai < 2; ++ai)
#pragma unroll
                for (int m = 0; m < 4; ++m)
#pragma unroll
                    for (int bj = 0; bj < 2; ++bj) { u32x4 gg = g[ai][m][bj]; asm volatile("" : "+v"(gg)); const f32x4 v0 = acc[ai][bj][m][0] * q, v1 = acc[ai][bj][m][1] * q; u32x4 w;
                        w.x = cvt_pk_bf16(v0[0] * UB(gg.z, 0), v0[1] * UB(gg.z, 1)); w.y = cvt_pk_bf16(v0[2] * UB(gg.z, 2), v0[3] * UB(gg.z, 3));
                        w.z = cvt_pk_bf16(v1[0] * UB(gg.w, 0), v1[1] * UB(gg.w, 1)); w.w = cvt_pk_bf16(v1[2] * UB(gg.w, 2), v1[3] * UB(gg.w, 3));
                        *(u32x4*)(Mp + (size_t)(ai * 128 + m * 16) * 1024 + bj * 128) = w; }
        }
#undef UB
    }
};

struct EpiOutProj {
    static constexpr bool PERM = true;
    bf16* XB; unsigned char* XB8;
    __device__ __forceinline__ void operator()(Acc& acc, const Unit& u, int wr, int wc, int fr, int fq) const {
        const int row0 = u.pm * 256 + wr * 64 + fr; const int col0 = u.pn * 256 + wc * 32 + 8 * fq;
        bf16* base = XB + (size_t)row0 * 1024 + col0; unsigned char* base8 = XB8 + (size_t)row0 * 1024 + col0;
        u32x4 g[2][4][2];
#pragma unroll
        for (int ai = 0; ai < 2; ++ai)
#pragma unroll
            for (int m = 0; m < 4; ++m)
#pragma unroll
                for (int bj = 0; bj < 2; ++bj) g[ai][m][bj] = *(const u32x4*)(base + (size_t)(ai * 128 + m * 16) * 1024 + bj * 128);
#pragma unroll
        for (int ai = 0; ai < 2; ++ai)
#pragma unroll
            for (int m = 0; m < 4; ++m)
#pragma unroll
                for (int bj = 0; bj < 2; ++bj) { const u32x4 gg = g[ai][m][bj]; const f32x4 a0 = acc[ai][bj][m][0], a1 = acc[ai][bj][m][1]; u32x4 w;
                    w.x = cvt_pk_bf16(a0[0] + bf_lo(gg.x), a0[1] + bf_hi(gg.x)); w.y = cvt_pk_bf16(a0[2] + bf_lo(gg.y), a0[3] + bf_hi(gg.y));
                    w.z = cvt_pk_bf16(a1[0] + bf_lo(gg.z), a1[1] + bf_hi(gg.z)); w.w = cvt_pk_bf16(a1[2] + bf_lo(gg.w), a1[3] + bf_hi(gg.w));
                    *(u32x4*)(base + (size_t)(ai * 128 + m * 16) * 1024 + bj * 128) = w;
                    const float v8[8] = {bf_lo(w.x), bf_hi(w.x), bf_lo(w.y), bf_hi(w.y), bf_lo(w.z), bf_hi(w.z), bf_lo(w.w), bf_hi(w.w)};
                    *(u32x2*)(base8 + (size_t)(ai * 128 + m * 16) * 1024 + bj * 128) = pack8_fp8(v8); }
    }
};

struct EpiMoe1 {
    static constexpr bool PERM = true;
    const LAS float* rs_tab; unsigned char* ACT;
    __device__ __forceinline__ void operator()(Acc& acc, const Unit& u, int wr, int wc, int fr, int fq) const {
        const int row0 = u.pm * 256 + wr * 64 + fr; const int col0 = u.pn * 128 + wc * 32 + 8 * fq; const int r0 = wr * 64 + fr;
        float rs[2][4];
#pragma unroll
        for (int ai = 0; ai < 2; ++ai)
#pragma unroll
            for (int m = 0; m < 4; ++m) { const int r = r0 + ai * 128 + m * 16; rs[ai][m] = (r < u.nvalid) ? rs_tab[u.slot * 256 + r] * (1.0f / W8_SCALE) : 0.f; }
#pragma unroll
        for (int ai = 0; ai < 2; ++ai)
#pragma unroll
            for (int m = 0; m < 4; ++m) { const int prow = row0 + ai * 128 + m * 16; const float r_ = rs[ai][m]; float a[8];
#pragma unroll
                for (int n = 0; n < 2; ++n)
#pragma unroll
                    for (int j = 0; j < 4; ++j) { const float g = acc[ai][0][m][n][j] * r_, up = acc[ai][1][m][n][j] * r_;
                        a[n * 4 + j] = A8_SCALE * g * up * __builtin_amdgcn_rcpf(1.f + fexp2(-g * LOG2E)); }
                *(u32x2*)(ACT + (size_t)prow * 512 + col0) = pack8_fp8(a); }
    }
};

struct EpiMoe2 {
    static constexpr bool PERM = true;
    const LAS int* tok_tab; unsigned char* CONTRIB;
    __device__ __forceinline__ void operator()(Acc& acc, const Unit& u, int wr, int wc, int fr, int fq) const {
        const int col0 = u.pn * 256 + wc * 32 + 8 * fq; const int r0 = wr * 64 + fr;
        int tk[2][4]; float ww[2][4];
#pragma unroll
        for (int ai = 0; ai < 2; ++ai)
#pragma unroll
            for (int m = 0; m < 4; ++m) { const int r = r0 + ai * 128 + m * 16; const bool ok = r < u.nvalid; tk[ai][m] = ok ? tok_tab[u.slot * 256 + r] : -1; ww[ai][m] = ok ? __int_as_float(tok_tab[768 + u.slot * 256 + r]) * (C8_SCALE / (W8_SCALE * A8_SCALE)) : 0.f; }
#pragma unroll
        for (int ai = 0; ai < 2; ++ai)
#pragma unroll
            for (int m = 0; m < 4; ++m) { const int tok2 = tk[ai][m]; const float w_ = ww[ai][m];
                if (tok2 >= 0) {
#pragma unroll
                    for (int bj = 0; bj < 2; ++bj) { const f32x4 v0 = acc[ai][bj][m][0] * w_, v1 = acc[ai][bj][m][1] * w_;
                        const float v8[8] = {v0[0], v0[1], v0[2], v0[3], v1[0], v1[1], v1[2], v1[3]};
                        *(u32x2*)(CONTRIB + (size_t)tok2 * 1024 + col0 + bj * 128) = pack8_fp8(v8); } } }
    }
};

struct SchedPlain {
    static constexpr bool GATHER = false; static constexpr bool FP8 = false;
    const char* A; const char* Bt; int nM, nN, K, G, c; const int* aux0 = nullptr; const int* aux1 = nullptr;
    __device__ __forceinline__ bool next(int i, Unit& u) const {
        const long L = (long)i * G + c; if (L >= (long)nM * nN) return false;
        pg8::tile_order((int)L, nM, nN, u.pm, u.pn); u.kind = 0; u.eoff = 256 * u.pm; u.nvalid = 256; u.goff = 0; u.gnv = 0;
        u.A = A + (size_t)u.pm * 256 * K * 2; u.B = Bt + (size_t)u.pn * 256 * K * 2; return true;
    }
};
struct SchedBranch {
    static constexpr bool GATHER = false; static constexpr bool FP8 = false;
    const char *OA, *OB, *WBD, *WBS; int G, c; const int* aux0 = nullptr; const int* aux1 = nullptr;
    __device__ __forceinline__ bool next(int i, Unit& u) const {
        const long L = (long)(i >> 1) * G + c; if (L >= 128 * 4) return false;
        pg8::tile_order((int)L, 128, 4, u.pm, u.pn); const int br = i & 1; u.kind = br ? 1 : (0 | pg8::KEEP); u.eoff = 0; u.nvalid = 256; u.goff = 0; u.gnv = 0;
        u.A = (br ? OB : OA) + (size_t)u.pm * 256 * 512 * 2; u.B = (br ? WBS : WBD) + (size_t)u.pn * 256 * 512 * 2; return true;
    }
};
template <bool G>
struct SchedMoe {
    static constexpr bool GATHER = true; static constexpr bool FP8 = true;
    const char* A; const char* W; const LAS int* ust; const int* ids; const int* aux0; const int* aux1; int K; size_t wstride; int Gn, c;
    __device__ __forceinline__ bool next(int i, Unit& u) const {
        const int v = (Gn % 8 == 0) ? (c % 8) * (Gn / 8) + c / 8 : c;
        const long L = (long)i * Gn + v; const int nrb = ust[32]; if (L >= (long)nrb * 4) return false;
        const int rb = (int)(L >> 2), pn = (int)(L & 3); int e = 0;
        for (int j = 1; j < 32; ++j) e += (ust[j] <= rb) ? 1 : 0;
        const int rbl = rb - ust[e]; const int left = ust[64 + e] - 256 * rbl;
        u.pm = rb; u.pn = pn; u.kind = 0; u.eoff = e * ECAP + 256 * rbl; u.nvalid = left < 256 ? left : 256;
        if (G) { u.goff = u.eoff; u.gnv = u.nvalid; } else { u.goff = 256 * rb; u.gnv = 256; }
        u.A = A; u.B = W + (size_t)e * wstride + (size_t)pn * 256 * K * 2; return true;
    }
};

template <class RowMap>
__device__ __forceinline__ void transpose_item(const float* W, int N, bf16* WT, int Kd, const float* gk, LAS unsigned* scr, int kb, int nb, int lane, const RowMap& map) {
    const int k0 = 64 * kb, n0 = 64 * nb, n4 = lane & 15, kq = lane >> 4;
    f32x4 va[8], vb[8];
    const float* wp = W + (size_t)(k0 + 2 * kq) * N + n0 + 4 * n4;
#pragma unroll
    for (int i = 0; i < 8; ++i) { va[i] = __builtin_nontemporal_load((const f32x4*)(wp + (size_t)(8 * i) * N)); vb[i] = __builtin_nontemporal_load((const f32x4*)(wp + (size_t)(8 * i + 1) * N)); }
#pragma unroll
    for (int i = 0; i < 8; ++i) {
        float ga = 1.f, gb = 1.f; if (gk) { ga = gk[k0 + 8 * i + 2 * kq]; gb = gk[k0 + 8 * i + 2 * kq + 1]; }
#pragma unroll
        for (int j = 0; j < 4; ++j) scr[(4 * n4 + j) * 33 + 4 * i + kq] = cvt_pk_bf16(va[i][j] * ga, vb[i][j] * gb);
    }
    LDS_WAIT(); asm volatile("" ::: "memory");
    const int nl = lane >> 3, c = lane & 7;
#pragma unroll
    for (int p = 0; p < 8; ++p) { const int n = 8 * p + nl; const LAS unsigned* sp = scr + n * 33 + 4 * c;
        u32x4 o; o.x = sp[0]; o.y = sp[1]; o.z = sp[2]; o.w = sp[3];
        *(u32x4*)(WT + (size_t)map(n0 + n) * Kd + k0 + 8 * c) = o; }
    LDS_WAIT(); asm volatile("" ::: "memory");
}
template <class RowMap>
__device__ __forceinline__ void transpose_item8(const float* W, int N, unsigned char* WT, int Kd, const float* gk, float scale, LAS unsigned char* scr, int kb, int nb, int lane, const RowMap& map) {
    const int k0 = 64 * kb, n0 = 64 * nb, n4 = lane & 15, kq = lane >> 4;
    f32x4 va[8], vb[8];
    const float* wp = W + (size_t)(k0 + 2 * kq) * N + n0 + 4 * n4;
#pragma unroll
    for (int i = 0; i < 8; ++i) { va[i] = __builtin_nontemporal_load((const f32x4*)(wp + (size_t)(8 * i) * N)); vb[i] = __builtin_nontemporal_load((const f32x4*)(wp + (size_t)(8 * i + 1) * N)); }
#pragma unroll
    for (int i = 0; i < 8; ++i) {
        float ga = scale, gb = scale; if (gk) { ga *= gk[k0 + 8 * i + 2 * kq]; gb *= gk[k0 + 8 * i + 2 * kq + 1]; }
#pragma unroll
        for (int j = 0; j < 4; ++j) *(LAS unsigned short*)(scr + (4 * n4 + j) * 72 + 8 * i + 2 * kq) = (unsigned short)(__builtin_amdgcn_cvt_pk_fp8_f32(va[i][j] * ga, vb[i][j] * gb, 0, false) & 0xffff);
    }
    LDS_WAIT(); asm volatile("" ::: "memory");
    const int nl = lane >> 3, c = lane & 7;
#pragma unroll
    for (int p = 0; p < 8; ++p) { const int n = 8 * p + nl; const u32x2 o = *(const LAS u32x2*)(scr + n * 72 + 8 * c);
        *(u32x2*)(WT + (size_t)map(n0 + n) * Kd + k0 + 8 * c) = o; }
    LDS_WAIT(); asm volatile("" ::: "memory");
}
struct MapPlain { __device__ __forceinline__ int operator()(int c) const { return c; } };
struct MapIn {
    __device__ __forceinline__ int operator()(int c) const {
        if (c < 1024) { const int pn = c >> 8, hh = (c >> 6) & 3, d = c & 63; return 256 * pn + 128 * (d >> 5) + 32 * hh + (d & 31); }
        if (c < 3072) return c;
        if (c < 4096) { const int cc = c - 3072; return 3072 + 256 * (cc >> 7) + (cc & 127); }
        const int cc = c - 4096; return 3072 + 256 * (cc >> 7) + 128 + (cc & 127);
    }
};
struct MapGU { int up; __device__ __forceinline__ int operator()(int c) const { return 256 * (c >> 7) + 128 * up + (c & 127); } };

__device__ __forceinline__ void convert_moe_weights(Frame& F, int l, int gw, int NGW) {
    LAS unsigned char* scr = (LAS unsigned char*)(F.lds + F.wave * 16384);
    const float* g2 = KIN(14) + l * D;
    for (int it = gw; it < NE * 384; it += NGW) {
        const int e = it / 384, r = it % 384;
        if (r < 256) { const int up = r >> 7, q = r & 127, kb = q >> 3, nb = q & 7;
            const float* W = (up ? KIN(18) : KIN(17)) + ((size_t)l * NE + e) * (size_t)D * DFF;
            transpose_item8(W, DFF, (unsigned char*)(F.ws + WS_WGU_T) + (size_t)e * 1024 * 1024, 1024, g2, W8_SCALE, scr, kb, nb, F.lane, MapGU{up});
        } else { const int q = r - 256, kb = q >> 4, nb = q & 15;
            const float* W = KIN(19) + ((size_t)l * NE + e) * (size_t)DFF * D;
            transpose_item8(W, D, (unsigned char*)(F.ws + WS_WDN_T) + (size_t)e * 1024 * 512, 512, nullptr, W8_SCALE, scr, kb, nb, F.lane, MapPlain{});
        }
    }
}
__device__ __forceinline__ void convert_small_weights(Frame& F, int gw, int NGW) {
    LAS unsigned* scr = (LAS unsigned*)(F.lds + F.wave * 16384);
    for (int it = gw; it < 2 * 1792; it += NGW) {
        const int l = it / 1792; int r = it % 1792;
        if (r < 1280) { const int kb = r / 80, nb = r % 80;
            transpose_item(KIN(3) + (size_t)l * D * NIN, NIN, (bf16*)(F.ws + WS_WIN_T) + (size_t)l * NIN * D, D, KIN(2) + l * D, scr, kb, nb, F.lane, MapIn{}); continue; }
        r -= 1280;
        if (r < 128) { transpose_item(KIN(11) + (size_t)l * 512 * D, D, (bf16*)(F.ws + WS_WBD_T) + (size_t)l * D * 512, 512, nullptr, scr, r >> 4, r & 15, F.lane, MapPlain{}); continue; }
        r -= 128;
        if (r < 128) { transpose_item(KIN(12) + (size_t)l * 512 * D, D, (bf16*)(F.ws + WS_WBS_T) + (size_t)l * D * 512, 512, nullptr, scr, r >> 4, r & 15, F.lane, MapPlain{}); continue; }
        r -= 128;
        transpose_item(KIN(13) + (size_t)l * D * D, D, (bf16*)(F.ws + WS_WOUT_T) + (size_t)l * D * D, D, nullptr, scr, r >> 4, r & 15, F.lane, MapPlain{});
    }
    const int gt = (gw * 64 + F.lane), NT_ = NGW * 64;
    for (int i = gt; i < PMAX; i += NT_) ((int*)(F.ws + WS_IDENT))[i] = 2 * i;
    for (int idx = gt; idx < 2 * 48 * 1024; idx += NT_) {
        const int l = idx / (48 * 1024), r = idx % (48 * 1024), n = r >> 10, k = r & 1023; float v = 0.f;
        if (n < 32) v = KIN(16)[((size_t)l * D + k) * 32 + n]; else if (n < 36) v = KIN(15)[((size_t)l * D + k) * 4 + (n - 32)];
        v *= KIN(14)[l * D + k];
        ((bf16*)(F.ws + WS_WR_T))[idx] = (bf16)(cvt_pk_bf16(v, 0.f) & 0xffffu);
    }
}
template <bool INB, bool ADD, bool WX, bool WB>
__device__ __forceinline__ void rows_phase(Frame& F, const float* xin, float* xout, int m_first, int m_step, int m_end) {
    const unsigned char* C = (const unsigned char*)(F.ws + WS_CONTRIB); bf16* XB = (bf16*)(F.ws + WS_XB); float* rstd = (float*)(F.ws + WS_RSTD1);
    for (int m0 = m_first; m0 < m_end; m0 += m_step) {
        f32x4 v[2][4]; u32x2 xa[2][4]; unsigned ca[2][4], cb[2][4];
#pragma unroll
        for (int q = 0; q < 2; ++q) {
            if (INB) { const u32x2* xr = (const u32x2*)(XB + (size_t)(m0 + q) * D) + F.lane;
#pragma unroll
                for (int j = 0; j < 4; ++j) xa[q][j] = xr[64 * j]; }
            else { const f32x4* xr = (const f32x4*)(xin + (size_t)(m0 + q) * D) + F.lane;
#pragma unroll
                for (int j = 0; j < 4; ++j) v[q][j] = __builtin_nontemporal_load(xr + 64 * j); }
            if (ADD) { const unsigned* c0 = (const unsigned*)(C + (size_t)(2 * (m0 + q)) * D) + F.lane; const unsigned* c1 = (const unsigned*)(C + (size_t)(2 * (m0 + q) + 1) * D) + F.lane;
#pragma unroll
                for (int j = 0; j < 4; ++j) { ca[q][j] = c0[64 * j]; cb[q][j] = c1[64 * j]; } } }
#pragma unroll
        for (int q = 0; q < 2; ++q) { const int m = m0 + q;
            if (INB) {
#pragma unroll
                for (int j = 0; j < 4; ++j) { const u32x2 a = xa[q][j]; v[q][j] = (f32x4){bf_lo(a.x), bf_hi(a.x), bf_lo(a.y), bf_hi(a.y)}; } }
            if (ADD) {
#pragma unroll
                for (int j = 0; j < 4; ++j) { const int a = (int)ca[q][j], b = (int)cb[q][j];
                    const f32x2 a0 = __builtin_amdgcn_cvt_pk_f32_fp8(a, false), a1 = __builtin_amdgcn_cvt_pk_f32_fp8(a, true), b0 = __builtin_amdgcn_cvt_pk_f32_fp8(b, false), b1 = __builtin_amdgcn_cvt_pk_f32_fp8(b, true);
                    v[q][j][0] += (a0[0] + b0[0]) * (1.0f / C8_SCALE); v[q][j][1] += (a0[1] + b0[1]) * (1.0f / C8_SCALE); v[q][j][2] += (a1[0] + b1[0]) * (1.0f / C8_SCALE); v[q][j][3] += (a1[1] + b1[1]) * (1.0f / C8_SCALE); } }
            if (WX) { f32x4* xo = (f32x4*)(xout + (size_t)m * D) + F.lane;
#pragma unroll
                for (int j = 0; j < 4; ++j) __builtin_nontemporal_store(v[q][j], xo + 64 * j); }
            if (WB) {
                u32x2 w[4]; float s_ = 0.f;
#pragma unroll
                for (int j = 0; j < 4; ++j) { w[j].x = cvt_pk_bf16(v[q][j][0], v[q][j][1]); w[j].y = cvt_pk_bf16(v[q][j][2], v[q][j][3]);
                    const float r0 = bf_lo(w[j].x), r1 = bf_hi(w[j].x), r2 = bf_lo(w[j].y), r3 = bf_hi(w[j].y); s_ += (r0 * r0 + r1 * r1) + (r2 * r2 + r3 * r3); }
                s_ = wave_sum(s_);
                if (F.lane == 0) rstd[m] = 1.0f / sqrtf(s_ * (1.0f / D) + EPS);
                u32x2* o = (u32x2*)(XB + (size_t)m * D) + F.lane;
#pragma unroll
                for (int j = 0; j < 4; ++j) o[64 * j] = w[j];
            } }
    }
}

__device__ __forceinline__ void router_phase(Frame& F, int l) {
    const bf16* XB = (const bf16*)(F.ws + WS_XB); const bf16* WR = (const bf16*)(F.ws + WS_WR_T) + (size_t)l * 48 * 1024;
    int* ent_tok = (int*)(F.ws + WS_ENT_TOK); float* ent_w = (float*)(F.ws + WS_ENT_W); float* ent_rs = (float*)(F.ws + WS_ENT_RS);
    unsigned* gcnt = (unsigned*)(F.ctl + CW_CNT + 64 * l);
    LAS int* lcnt = (LAS int*)(F.lds + MOE_OFF) + 64; LAS int* lbase = lcnt + 32;
    const int fr = F.lane & 15, fq = F.lane >> 4;
    { LAS u32x4* wl = (LAS u32x4*)F.lds; u32x4 tmp[12];
#pragma unroll
        for (int j = 0; j < 12; ++j) { const int f = F.tid + 512 * j, ln = f & 63, kk = (f >> 6) & 31, nb = f >> 11; tmp[j] = *(const u32x4*)(WR + (size_t)(16 * nb + (ln & 15)) * D + 32 * kk + 8 * (ln >> 4)); }
#pragma unroll
        for (int j = 0; j < 12; ++j) wl[F.tid + 512 * j] = tmp[j];
    }
    __syncthreads();
    for (int chunk = F.vcu; chunk < T / 128; chunk += F.G) {
        if (F.tid < 32) lcnt[F.tid] = 0;
        __syncthreads();
        const int row = chunk * 128 + F.wave * 16 + fr;
        f32x4 a0 = {0.f, 0.f, 0.f, 0.f}, a1 = a0, a2 = a0; float ss = 0.f;
        const bf16* xp = XB + (size_t)row * D + 8 * fq; const LAS bf16x8* wl = (const LAS bf16x8*)F.lds + F.lane;
#pragma unroll
        for (int kb_ = 0; kb_ < 2; ++kb_) {
        u32x4 xa[16];
#pragma unroll
        for (int kk = 0; kk < 16; ++kk) xa[kk] = *(const u32x4*)(xp + 32 * (16 * kb_ + kk));
#pragma unroll
        for (int k_ = 0; k_ < 16; ++k_) { const int kk = 16 * kb_ + k_;
            { const u32x4 x_ = xa[k_]; float t0 = bf_lo(x_.x), t1 = bf_hi(x_.x), t2 = bf_lo(x_.y), t3 = bf_hi(x_.y), t4 = bf_lo(x_.z), t5 = bf_hi(x_.z), t6 = bf_lo(x_.w), t7 = bf_hi(x_.w);
              ss += (t0 * t0 + t1 * t1) + (t2 * t2 + t3 * t3) + (t4 * t4 + t5 * t5) + (t6 * t6 + t7 * t7); }
            const bf16x8 xf = __builtin_bit_cast(bf16x8, xa[k_]);
            a0 = __builtin_amdgcn_mfma_f32_16x16x32_bf16(wl[(0 * 32 + kk) * 64], xf, a0, 0, 0, 0);
            a1 = __builtin_amdgcn_mfma_f32_16x16x32_bf16(wl[(1 * 32 + kk) * 64], xf, a1, 0, 0, 0);
            a2 = __builtin_amdgcn_mfma_f32_16x16x32_bf16(wl[(2 * 32 + kk) * 64], xf, a2, 0, 0, 0);
            if ((k_ & 3) == 3) __builtin_amdgcn_sched_barrier(0);
        }
        asm volatile("" ::: "memory");
        }
        ss += __shfl_xor(ss, 16); ss += __shfl_xor(ss, 32);
        const float rstd = 1.0f / sqrtf(ss * (1.0f / D) + EPS);
        float gl[4];
#pragma unroll
        for (int j = 0; j < 4; ++j) gl[j] = __shfl(a2[j], fr) * rstd;
        int g = 0; float gm = gl[0];
#pragma unroll
        for (int j = 1; j < 4; ++j) if (gl[j] > gm) { gm = gl[j]; g = j; }
        float gs = 0.f;
#pragma unroll
        for (int j = 0; j < 4; ++j) gs += __expf(gl[j] - gm);
        const float pg = 1.0f / gs;
        f32x4 sel = (g >> 1) ? a1 : a0;
        float el[8];
#pragma unroll
        for (int i = 0; i < 8; ++i) { const int src = fr + 16 * (2 * (g & 1) + (i >> 2)); el[i] = __shfl(sel[i & 3], src) * rstd; }
        int i1 = 0; float m1 = el[0];
#pragma unroll
        for (int i = 1; i < 8; ++i) if (el[i] > m1) { m1 = el[i]; i1 = i; }
        int i2 = -1; float m2 = -3.0e38f;
#pragma unroll
        for (int i = 0; i < 8; ++i) if (i != i1 && el[i] > m2) { m2 = el[i]; i2 = i; }
        const float p2 = __expf(m2 - m1); const float w0 = pg / (1.f + p2), w1 = pg * p2 / (1.f + p2);
        const int e0 = 8 * g + i1, e1 = 8 * g + i2;
        int lp0 = 0, lp1 = 0;
        if (fq == 0) { lp0 = __hip_atomic_fetch_add(lcnt + e0, 1, __ATOMIC_RELAXED, __HIP_MEMORY_SCOPE_WORKGROUP); lp1 = __hip_atomic_fetch_add(lcnt + e1, 1, __ATOMIC_RELAXED, __HIP_MEMORY_SCOPE_WORKGROUP); }
        __syncthreads();
        if (F.tid < 32) lbase[F.tid] = (int)__hip_atomic_fetch_add(gcnt + F.tid, (unsigned)lcnt[F.tid], RLX_AGENT);
        __syncthreads();
        if (fq == 0) {
            const int s0 = e0 * ECAP + lbase[e0] + lp0, s1 = e1 * ECAP + lbase[e1] + lp1;
            ent_tok[s0] = 2 * row; ent_tok[s1] = 2 * row + 1; ent_w[s0] = w0; ent_w[s1] = w1; ent_rs[s0] = rstd; ent_rs[s1] = rstd;
        }
        __syncthreads();
    }
}
__device__ __forceinline__ void build_ust(Frame& F, int l) {
    LAS int* ust = (LAS int*)(F.lds + MOE_OFF); LAS int* cnt = ust + 64;
    if (F.tid < 32) cnt[F.tid] = (int)__hip_atomic_load((unsigned*)(F.ctl + CW_CNT + 64 * l) + F.tid, RLX_AGENT);
    __syncthreads();
    if (F.tid == 0) { int acc = 0;
        for (int e = 0; e < 32; ++e) { ust[e] = acc; acc += (cnt[e] + 255) >> 8; }
        ust[32] = acc; }
    __syncthreads();
}
__device__ __forceinline__ int crow(int r, int hi) { return (r & 3) + 8 * (r >> 2) + 4 * hi; }
__device__ __forceinline__ s16x4 vtr(const LAS unsigned char* p) { return __builtin_bit_cast(s16x4, __builtin_amdgcn_ds_read_tr16_b64_v4i16((LAS v4i16_t*)p)); }
__device__ __forceinline__ void glds(const void* g, LAS unsigned char* l) { __builtin_amdgcn_global_load_lds((const unsigned*)g, (LAS unsigned*)l, 16, 0, 0); }
#define PKV(lo, hi4) (bf16x8){lo[0], lo[1], lo[2], lo[3], hi4[0], hi4[1], hi4[2], hi4[3]}

__device__ __forceinline__ void pack_p(const f32x16& p0, const f32x16& p1, bf16x8 (&pa)[4]) {
    u32x4 w0, w1, w2, w3;
    w0.x = cvt_pk_bf16(p0[0], p0[1]); w0.y = cvt_pk_bf16(p0[2], p0[3]); w0.z = cvt_pk_bf16(p0[4], p0[5]); w0.w = cvt_pk_bf16(p0[6], p0[7]);
    w1.x = cvt_pk_bf16(p0[8], p0[9]); w1.y = cvt_pk_bf16(p0[10], p0[11]); w1.z = cvt_pk_bf16(p0[12], p0[13]); w1.w = cvt_pk_bf16(p0[14], p0[15]);
    w2.x = cvt_pk_bf16(p1[0], p1[1]); w2.y = cvt_pk_bf16(p1[2], p1[3]); w2.z = cvt_pk_bf16(p1[4], p1[5]); w2.w = cvt_pk_bf16(p1[6], p1[7]);
    w3.x = cvt_pk_bf16(p1[8], p1[9]); w3.y = cvt_pk_bf16(p1[10], p1[11]); w3.z = cvt_pk_bf16(p1[12], p1[13]); w3.w = cvt_pk_bf16(p1[14], p1[15]);
    pa[0] = __builtin_bit_cast(bf16x8, w0); pa[1] = __builtin_bit_cast(bf16x8, w1); pa[2] = __builtin_bit_cast(bf16x8, w2); pa[3] = __builtin_bit_cast(bf16x8, w3);
}
template <int NDB>
__device__ __forceinline__ void pv_mma(f32x16 (&o)[NDB], const LAS unsigned char* vp, const bf16x8 (&pa)[4]) {
    s16x4 lo[2][4], hi4[2][4];
#pragma unroll
    for (int ks = 0; ks < 4; ++ks) { lo[0][ks] = vtr(vp + ks * 1024); hi4[0][ks] = vtr(vp + ks * 1024 + 512); }
#pragma unroll
    for (int db = 0; db < NDB; ++db) {
        if (db + 1 < NDB) {
#pragma unroll
            for (int ks = 0; ks < 4; ++ks) { lo[(db + 1) & 1][ks] = vtr(vp + (db + 1) * 4096 + ks * 1024); hi4[(db + 1) & 1][ks] = vtr(vp + (db + 1) * 4096 + ks * 1024 + 512); }
        }
        __builtin_amdgcn_sched_barrier(0);
#pragma unroll
        for (int ks = 0; ks < 4; ++ks) o[db] = __builtin_amdgcn_mfma_f32_32x32x16_bf16(pa[ks], PKV(lo[db & 1][ks], hi4[db & 1][ks]), o[db], 0, 0, 0);
        __builtin_amdgcn_sched_barrier(0);
    }
}
__device__ __forceinline__ void qk_mma(f32x16& p0, f32x16& p1, const LAS unsigned char* Kb, const LAS unsigned char* Qs, int lane, int r32, int hi) {
    const LAS unsigned char* kb = Kb + hi * 1024 + r32 * 16;
#pragma unroll
    for (int d0 = 0; d0 < 4; ++d0) {
        const bf16x8 b0 = *(const LAS bf16x8*)(kb + d0 * 2048), b1 = *(const LAS bf16x8*)(kb + d0 * 2048 + 512), q = *(const LAS bf16x8*)(Qs + d0 * 1024 + lane * 16);
        p0 = __builtin_amdgcn_mfma_f32_32x32x16_bf16(b0, q, p0, 0, 0, 0); p1 = __builtin_amdgcn_mfma_f32_32x32x16_bf16(b1, q, p1, 0, 0, 0);
    }
}

__device__ __forceinline__ void diff_epilogue(Frame& F, f32x16 (&o)[4], LAS float* xch, const float* subg, float lam_init, bf16* Ow);
template <int VAR>
__device__ __forceinline__ void diff_stream(f32x16 (&o)[4], float& l, const LAS unsigned char* Kb, const LAS unsigned char* Vb, const bf16x8 (&qr)[4], const LAS float* lut,
                                            bool near, float cfar, int qrow, int kmin, int lane, int r32, int hi) {
    f32x16 p0, p1; const float init = near ? 0.f : cfar;
#pragma unroll
    for (int r = 0; r < 16; ++r) { p0[r] = init; p1[r] = init; }
    const LAS unsigned char* kb = Kb + r32 * 128; const int sw = (r32 >> 1) & 7;
    bf16x8 kf[8];
#pragma unroll
    for (int d0 = 0; d0 < 4; ++d0) { const int so = (((2 * d0 + hi) ^ sw) << 4); kf[2 * d0] = *(const LAS bf16x8*)(kb + so); kf[2 * d0 + 1] = *(const LAS bf16x8*)(kb + 4096 + so); }
    __builtin_amdgcn_sched_barrier(0);
#pragma unroll
    for (int d0 = 0; d0 < 4; ++d0) { if (!(VAR & 4)) { p0 = __builtin_amdgcn_mfma_f32_32x32x16_bf16(kf[2 * d0], qr[d0], p0, 0, 0, 0); p1 = __builtin_amdgcn_mfma_f32_32x32x16_bf16(kf[2 * d0 + 1], qr[d0], p1, 0, 0, 0); }
        else { p0[d0] += __builtin_bit_cast(f32x4, kf[2 * d0])[0]; p1[d0] += __builtin_bit_cast(f32x4, kf[2 * d0 + 1])[0]; } }
    if (VAR & 1) { } else if (near) {
#pragma unroll
        for (int r = 0; r < 16; ++r) { const int d0 = qrow - (kmin + crow(r, hi)), d1 = d0 - 32;
            const float b0 = lut[min(max(d0, 0), 127)], b1 = lut[min(max(d1, 0), 127)];
            p0[r] = d0 < 0 ? 0.f : fexp2(p0[r] + b0); p1[r] = d1 < 0 ? 0.f : fexp2(p1[r] + b1); }
    } else {
#pragma unroll
        for (int r = 0; r < 16; ++r) { p0[r] = fexp2(p0[r]); p1[r] = fexp2(p1[r]); }
    }
    float s = 0.f;
#pragma unroll
    for (int r = 0; r < 16; ++r) s += p0[r] + p1[r];
    l += s;
    bf16x8 pa[4]; pack_p(p0, p1, pa);
    const LAS unsigned char* vp = Vb + ((lane >> 4) & 1) * 32 + (lane & 3) * 8 + (4 * hi + ((lane & 15) >> 2)) * 64;
    if (!(VAR & 2)) pv_mma<4>(o, vp, pa); else { o[0][0] += __builtin_bit_cast(f32x4, pa[0])[0] + __builtin_bit_cast(f32x4, pa[3])[1]; }
}

template <int VAR>
__device__ __forceinline__ void diff_unit(Frame& F, int b, int h, int qb, const float* subg, float lam, float lam_init, bf16* Odst) {
    const int lane = F.lane, r32 = lane & 31, hi = lane >> 5, wid = F.wave, js = wid >> 2, wq = wid & 3;
    bf16* DQ = (bf16*)(F.ws + WS_DQ); const bf16* DK = (const bf16*)(F.ws + WS_DK); const bf16* VA = (const bf16*)(F.ws + WS_VA);
    const long rowbase = (long)b * SEQ; const int q0 = qb * 128, qw = q0 + 32 * wq;
    LAS unsigned char* kv = F.lds;
    LAS float* wsf = (LAS float*)(F.lds + WSF_OFF) + wid * 64; const LAS float* lut = (const LAS float*)(F.lds + LUT_OFF) + h * 128;
    const int NT = (q0 + 128) / 64;
    const int krow_ = 8 * wid + (lane >> 3);
    const bf16* k1src = DK + (rowbase + krow_) * 512 + h * 128 + (((lane & 7) ^ ((krow_ >> 1) & 7)) * 8);
    const bf16* vsrc0 = VA + (rowbase + 16 * (wid & 3) + (lane >> 2)) * 512 + h * 128 + (wid >> 2) * 32 + (lane & 3) * 8;
#define DIFF_ISSUE(t, bufi) do { LAS unsigned char* bb_ = kv + (bufi) * 32768; const long ro_ = (long)(t) * 64 * 512; \
        glds(k1src + ro_, bb_ + wid * 1024); glds(k1src + ro_ + 64, bb_ + 8192 + wid * 1024); \
        glds(vsrc0 + ro_, bb_ + 16384 + wid * 1024); glds(vsrc0 + ro_ + 64, bb_ + 16384 + (wid + 8) * 1024); } while (0)
    bf16x8 qr[4];
#pragma unroll
    for (int d0 = 0; d0 < 4; ++d0) qr[d0] = *(const bf16x8*)(DQ + (rowbase + qw + r32) * 512 + h * 128 + js * 64 + d0 * 16 + hi * 8);
    asm volatile("" ::: "memory");
    if (!(VAR & 8)) { DIFF_ISSUE(0, 0);
    if (NT > 1) DIFF_ISSUE(1, 1); }
    f32x16 o[4];
#pragma unroll
    for (int i = 0; i < 4; ++i)
#pragma unroll
        for (int r = 0; r < 16; ++r) o[i][r] = 0.f;
    float l = 0.f;
    const float cfar = lut[127];
    if (NT > 1) asm volatile("s_waitcnt vmcnt(4)" ::: "memory"); else asm volatile("s_waitcnt vmcnt(0)" ::: "memory");
    __builtin_amdgcn_s_barrier(); asm volatile("" ::: "memory");
    int sc_ = 0, sn2 = 2;
    for (int t = 0; t < NT; ++t) {
        if (!(VAR & 8)) { if (t + 2 < NT) DIFF_ISSUE(t + 2, sn2); }
        const int kmin = 64 * t;
        if (kmin <= qw + 31) {
            const bool near = (qw - (kmin + 63)) < 113;
            const LAS unsigned char* bb = kv + sc_ * 32768;
            diff_stream<VAR>(o, l, bb + js * 8192, bb + 16384, qr, lut, near, cfar, qw + r32, kmin, lane, r32, hi);
        }
        if (t + 2 < NT) asm volatile("s_waitcnt vmcnt(4) lgkmcnt(0)" ::: "memory"); else asm volatile("s_waitcnt vmcnt(0) lgkmcnt(0)" ::: "memory");
        if (!(VAR & 16)) __builtin_amdgcn_s_barrier(); asm volatile("" ::: "memory");
        sn2 = sc_; sc_ = (sc_ == 2) ? 0 : sc_ + 1;
    }
#undef DIFF_ISSUE
    l += __shfl_xor(l, 32);
    if (hi == 0) wsf[r32] = l;
    LDS_WAIT();
    const float sc = js ? lam : 1.0f;
#pragma unroll
    for (int r = 0; r < 16; ++r) { const float rl = sc * __builtin_amdgcn_rcpf(wsf[crow(r, hi)]);
#pragma unroll
        for (int db = 0; db < 4; ++db) o[db][r] *= rl; }
    LAS float* xch = (LAS float*)(F.lds + wq * 16384);
    if (js) {
#pragma unroll
        for (int db = 0; db < 4; ++db)
#pragma unroll
            for (int r = 0; r < 16; ++r) xch[(db * 16 + r) * 64 + lane] = o[db][r];
    }
    asm volatile("s_waitcnt lgkmcnt(0)" ::: "memory"); __syncthreads();
    if (!js && !(VAR & 32)) diff_epilogue(F, o, xch, subg, lam_init, Odst + (rowbase + qw) * 512 + h * 128);
    asm volatile("s_waitcnt lgkmcnt(0)" ::: "memory"); __syncthreads();
}
__device__ __forceinline__ void diff_epilogue(Frame& F, f32x16 (&o)[4], LAS float* xch, const float* subg, float lam_init, bf16* Ow) {
    int lane = F.lane; asm volatile("" : "+v"(lane));
    const int r32 = lane & 31, hi = lane >> 5;
    float ssq[16];
#pragma unroll
    for (int r = 0; r < 16; ++r) { float s = 0.f;
#pragma unroll
        for (int db = 0; db < 4; ++db) { const float v = o[db][r] - xch[(db * 16 + r) * 64 + lane]; o[db][r] = v; s += v * v; }
        ssq[r] = s; }
#pragma unroll
    for (int r = 0; r < 16; ++r) { float s = ssq[r]; s += __shfl_xor(s, 1); s += __shfl_xor(s, 2); s += __shfl_xor(s, 4); s += __shfl_xor(s, 8); s += __shfl_xor(s, 16);
        ssq[r] = (1.0f - lam_init) * __builtin_amdgcn_rsqf(s * (1.0f / 128.0f) + EPS); }
    float sg[4];
#pragma unroll
    for (int db = 0; db < 4; ++db) sg[db] = subg[32 * db + r32];
    LDS_WAIT();
    LAS bf16* stl = (LAS bf16*)xch;
#pragma unroll
    for (int r = 0; r < 16; ++r) { const int orow = crow(r, hi);
#pragma unroll
        for (int db = 0; db < 4; ++db) stl[orow * 128 + db * 32 + r32] = (bf16)(cvt_pk_bf16(o[db][r] * ssq[r] * sg[db], 0.f) & 0xffffu); }
    LDS_WAIT();
#pragma unroll
    for (int i = 0; i < 8; ++i) { const int row = i * 4 + (lane >> 4), ch = lane & 15; const u32x4 v = *(const LAS u32x4*)(stl + row * 128 + ch * 8); *(u32x4*)(Ow + (long)row * 512 + ch * 8) = v; }
}

template <bool M>
__device__ __forceinline__ bool sb_tile(f32x16 (&o)[2], float& carry, const bf16x8 (&qr)[4], const LAS unsigned char* kp, int ksw, const LAS unsigned char* vp, int hi, int lane, int qrow, int t,
                                        const bf16* ksrc, const bf16* vsrc, LAS unsigned char* kb_, LAS unsigned char* vb_) {
#define SB_ISSUE_K(t_) do { _Pragma("unroll") for (int c = 0; c < 8; ++c) { const int kr_ = 8 * c + (lane >> 3); glds(ksrc + (long)(64 * (t_) + 8 * c) * 512 + (((lane & 7) ^ ((kr_ >> 1) & 7)) * 8), kb_ + c * 1024); } } while (0)
#define SB_ISSUE_V(t_) do { _Pragma("unroll") for (int p = 0; p < 8; ++p) glds(vsrc + (long)(64 * (t_) + 16 * (p & 3)) * 512 + (p >> 2) * 32, vb_ + p * 1024); } while (0)
    {
        const int kmin = 64 * t;
        asm volatile("s_waitcnt vmcnt(8)" ::: "memory");
        bf16x8 kf[8];
#pragma unroll
        for (int d0 = 0; d0 < 4; ++d0) { const int so = (((2 * d0 + hi) ^ ksw) << 4); kf[2 * d0] = *(const LAS bf16x8*)(kp + so); kf[2 * d0 + 1] = *(const LAS bf16x8*)(kp + 4096 + so); }
        asm volatile("s_waitcnt lgkmcnt(0)" ::: "memory");
        if (t > 0) SB_ISSUE_K(t - 1);
        f32x16 p0, p1;
#pragma unroll
        for (int r = 0; r < 16; ++r) { p0[r] = 0.f; p1[r] = 0.f; }
#pragma unroll
        for (int d0 = 0; d0 < 4; ++d0) { p0 = __builtin_amdgcn_mfma_f32_32x32x16_bf16(kf[2 * d0], qr[d0], p0, 0, 0, 0); p1 = __builtin_amdgcn_mfma_f32_32x32x16_bf16(kf[2 * d0 + 1], qr[d0], p1, 0, 0, 0); }
        float Lb[8][4], T_own[8], T_oth[8];
#pragma unroll
        for (int i = 0; i < 8; ++i) {
#pragma unroll
            for (int e = 0; e < 4; ++e) { const float y = (i < 4) ? p0[4 * i + e] : p1[4 * (i - 4) + e]; const int key = kmin + 8 * i + 4 * hi + e;
                const float sp = fmaxf(y, 0.f) + flog2(1.f + fexp2(-fabsf(y)));
                Lb[i][e] = (!M || key < qrow) ? sp : 0.f; }
            T_own[i] = (Lb[i][0] + Lb[i][1]) + (Lb[i][2] + Lb[i][3]);
        }
#pragma unroll
        for (int i = 0; i < 8; ++i) T_oth[i] = __shfl_xor(T_own[i], 32);
        float after = carry;
#pragma unroll
        for (int i = 7; i >= 0; --i) {
            const float off = after + (hi == 0 ? T_oth[i] : 0.f);
            after += T_own[i] + T_oth[i];
            float suf = off;
#pragma unroll
            for (int e = 3; e >= 0; --e) { const float y = (i < 4) ? p0[4 * i + e] : p1[4 * (i - 4) + e]; const int key = kmin + 8 * i + 4 * hi + e;
                const float a = (!M || key < qrow) ? fexp2(y - Lb[i][e] - suf) : 0.f; suf += Lb[i][e];
                if (i < 4) p0[4 * i + e] = a; else p1[4 * (i - 4) + e] = a; }
        }
        carry = after;
        bf16x8 pa[4]; pack_p(p0, p1, pa);
        if (t > 0) asm volatile("s_waitcnt vmcnt(8)" ::: "memory"); else asm volatile("s_waitcnt vmcnt(0)" ::: "memory");
        pv_mma<2>(o, vp, pa);
        asm volatile("s_waitcnt lgkmcnt(0)" ::: "memory");
#if SB_EARLY_EXIT
        if (__all(carry > SB_EXIT_LOG2)) return true;
#endif
        if (t > 0) SB_ISSUE_V(t - 1);
        return false;
    }
#undef SB_ISSUE_K
#undef SB_ISSUE_V
}

__device__ __forceinline__ void sb_unit(Frame& F, int b, int h, int blk) {
    const int lane = F.lane, r32 = lane & 31, hi = lane >> 5, wid = F.wave;
    bf16* SBQ = (bf16*)(F.ws + WS_SBQ); const bf16* SBK = (const bf16*)(F.ws + WS_SBK); const bf16* SBV = (const bf16*)(F.ws + WS_SBV);
    const long rowbase = (long)b * SEQ; const int qw = 32 * blk; const int qrow = qw + r32;
    LAS unsigned char* kb_ = F.lds + wid * 16384; LAS unsigned char* vb_ = kb_ + 8192;
    bf16x8 qr[4];
#pragma unroll
    for (int d0 = 0; d0 < 4; ++d0) qr[d0] = *(const bf16x8*)(SBQ + (rowbase + qrow) * 512 + h * 64 + d0 * 16 + hi * 8);
    f32x16 o[2];
#pragma unroll
    for (int i = 0; i < 2; ++i)
#pragma unroll
        for (int r = 0; r < 16; ++r) o[i][r] = 0.f;
    float carry = 0.f;
    const bf16* ksrc = SBK + (rowbase + (lane >> 3)) * 512 + h * 64;
    const bf16* vsrc = SBV + (rowbase + (lane >> 2)) * 512 + h * 64 + (lane & 3) * 8;
    const LAS unsigned char* kp = kb_ + r32 * 128; const int ksw = (r32 >> 1) & 7;
    const LAS unsigned char* vp = vb_ + ((lane >> 4) & 1) * 32 + (lane & 3) * 8 + (4 * hi + ((lane & 15) >> 2)) * 64;
#define SB_ISSUE_K(t_) do { _Pragma("unroll") for (int c = 0; c < 8; ++c) { const int kr_ = 8 * c + (lane >> 3); glds(ksrc + (long)(64 * (t_) + 8 * c) * 512 + (((lane & 7) ^ ((kr_ >> 1) & 7)) * 8), kb_ + c * 1024); } } while (0)
#define SB_ISSUE_V(t_) do { _Pragma("unroll") for (int p = 0; p < 8; ++p) glds(vsrc + (long)(64 * (t_) + 16 * (p & 3)) * 512 + (p >> 2) * 32, vb_ + p * 1024); } while (0)
    const int t0 = qw >> 6;
    asm volatile("s_waitcnt lgkmcnt(0)" ::: "memory");
    SB_ISSUE_K(t0); SB_ISSUE_V(t0);
    if (!sb_tile<true>(o, carry, qr, kp, ksw, vp, hi, lane, qrow, t0, ksrc, vsrc, kb_, vb_))
        for (int t = t0 - 1; t >= 0; --t) if (sb_tile<false>(o, carry, qr, kp, ksw, vp, hi, lane, qrow, t, ksrc, vsrc, kb_, vb_)) break;
#undef SB_ISSUE_K
#undef SB_ISSUE_V
    asm volatile("s_waitcnt vmcnt(0) lgkmcnt(0)" ::: "memory");
    LAS bf16* stl = (LAS bf16*)kb_;
#pragma unroll
    for (int r = 0; r < 16; ++r) { const int orow = crow(r, hi);
#pragma unroll
        for (int db = 0; db < 2; ++db) stl[orow * 64 + db * 32 + r32] = (bf16)(cvt_pk_bf16(o[db][r], 0.f) & 0xffffu); }
    LDS_WAIT();
    bf16* Ow = SBQ + (rowbase + qw) * 512 + h * 64;
#pragma unroll
    for (int i = 0; i < 4; ++i) { const int row = i * 8 + (lane >> 3), ch = lane & 7; const u32x4 v = *(const LAS u32x4*)(stl + row * 64 + ch * 8); *(u32x4*)(Ow + (long)row * 512 + ch * 8) = v; }
    asm volatile("s_waitcnt lgkmcnt(0)" ::: "memory");
}

__device__ __forceinline__ int t5_bucket(int n) {
    if (n < 16) return n;
    int b = 16;
    const int thr[15] = {19, 21, 24, 27, 31, 35, 40, 46, 52, 59, 67, 77, 87, 99, 113};
#pragma unroll
    for (int j = 0; j < 15; ++j) b += (n >= thr[j]) ? 1 : 0;
    return b;
}

__device__ __forceinline__ void attention_phase(Frame& F, int l) {
    const float* relb = KIN(1); const float* gq = KIN(4) + l * 64; const float* gk = KIN(5) + l * 64;
    LAS float* scal = (LAS float*)(F.lds + WSF_OFF);
    if (F.wave == 0) { const int d = F.lane;
        float a1 = KIN(6)[l * 64 + d] * KIN(7)[l * 64 + d], a2 = KIN(8)[l * 64 + d] * KIN(9)[l * 64 + d], mq = fabsf(gq[d]), mk = fabsf(gk[d]);
        a1 = wave_sum(a1); a2 = wave_sum(a2);
#pragma unroll
        for (int o = 1; o < 64; o <<= 1) { mq = fmaxf(mq, __shfl_xor(mq, o)); mk = fmaxf(mk, __shfl_xor(mk, o)); }
        if (d == 0) { scal[0] = a1; scal[1] = a2; scal[2] = mq; scal[3] = mk; } }
    if (F.tid >= 64 && F.tid < 192) scal[16 + F.tid - 64] = relb[F.tid - 64];
    __syncthreads();
    const float s1 = scal[0], s2 = scal[1], gqm = scal[2], gkm = scal[3];
    const float lam_init = 0.8f - 0.6f * expf(-0.3f * (float)l);
    const float lam = expf(s1) - expf(s2) + lam_init;
    float lutv;
    {
        const int h = F.tid >> 7, d = F.tid & 127; float mb = -3.0e38f;
        for (int bkt = 0; bkt < 32; ++bkt) mb = fmaxf(mb, scal[16 + bkt * 4 + h]);
        const float M = 8.f * gqm * gkm + mb;
        lutv = (scal[16 + t5_bucket(d) * 4 + h] - M) * LOG2E;
    }
    __syncthreads();
    ((LAS float*)(F.lds + LUT_OFF))[F.tid] = lutv;
    __syncthreads();
    const float* subg = KIN(10) + l * 128;
#ifndef ATT_MASK
#define ATT_MASK 3
#endif
#ifndef DIFF_VARIANT
#define DIFF_VARIANT -1
#endif
    if (DIFF_VARIANT >= 0) { for (int i = 0;; ++i) { const long L = (long)i * F.G + F.vcu; if (L >= 1024) break;
        const int Lm = (int)(L & 255), bh = Lm >> 3, s = Lm & 7, k = (int)(L >> 8), qb = (k == 0) ? 31 - s : (k == 1) ? 16 + s : (k == 2) ? 15 - s : s;
        diff_unit<(DIFF_VARIANT >= 0 ? DIFF_VARIANT : 0)>(F, bh >> 2, bh & 3, qb, subg, lam, lam_init, (bf16*)(F.ws + WS_XB)); }
        __syncthreads(); }
    PB_START(10);
    const int vcu = F.vcu;
    if (ATT_MASK & 1) for (int i = 0;; ++i) { const long L = (long)i * F.G + vcu; if (L >= 1024) break;
        const int Lm = (int)(L & 255), bh = Lm >> 3, s = Lm & 7, k = (int)(L >> 8), qb = (k == 0) ? 31 - s : (k == 1) ? 16 + s : (k == 2) ? 15 - s : s;
        diff_unit<0>(F, bh >> 2, bh & 3, qb, subg, lam, lam_init, (bf16*)(F.ws + WS_DQ)); }
    __syncthreads();
    PB_END(10);
    PB_START(11);
    const int gw = F.vcu * NWAVES + F.wave, NGW = F.G * NWAVES;
    if (ATT_MASK & 2) for (int i = 0;; ++i) { int bh, x;
        if (F.G == 256) { const int xg = F.vcu >> 5, lw = (F.vcu & 31) * NWAVES + F.wave, pp = (i >> 1) * 256 + lw; if (pp >= 512) break; bh = 8 * xg + (pp >> 6); x = pp & 63; }
        else { const long p = (long)(i >> 1) * NGW + gw; if (p >= 4096) break; bh = (int)(p >> 6); x = (int)(p & 63); }
        const int blk = (i & 1) ? 127 - x : x;
        sb_unit(F, bh >> 3, bh & 7, blk); }
    __syncthreads();
    PB_END(11);
}

constexpr int NPHASE = 1 + 8 * DEPTH;
__global__ void __launch_bounds__(NWAVES * 64, 2) mk_fwd(Args args) {
    extern __shared__ __attribute__((aligned(16))) unsigned char lds_raw[];
    Frame F;
    F.lds = (LAS unsigned char*)lds_raw;
    F.MISC = (volatile LAS unsigned*)(F.lds + MISC_OFF);
    F.tid = threadIdx.x; F.lane = F.tid & 63; F.wave = __builtin_amdgcn_readfirstlane(F.tid >> 6); F.G = gridDim.x;
    F.ws = args.ws; F.ctl = (gu32*)(args.ws + WS_CTL); F.out = args.out;
    for (int u = F.tid; u < (LDS_BYTES - LDSCTL_OFF) / 4; u += NWAVES * 64) ((LAS unsigned*)(F.lds + LDSCTL_OFF))[u] = 0u;
    __syncthreads();
    const unsigned my_xcc = xb_xcc_id(); unsigned my_rank = 0;
    if (F.tid == 0) my_rank = __hip_atomic_fetch_add((unsigned*)(F.ctl + CW_XRANK) + my_xcc, 1u, RLX_AGENT);
    my_rank = (unsigned)__builtin_amdgcn_readfirstlane((int)my_rank);
    if (F.tid == 0) ((volatile LAS unsigned*)(F.lds + MISC_OFF))[12] = my_rank;
    __syncthreads();
    my_rank = ((volatile LAS unsigned*)(F.lds + MISC_OFF))[12];
    F.vcu = (int)blockIdx.x; F.cx = (int)blockIdx.x; F.local_ok = 0;
    XcdBarrier bar; bar.bar = (unsigned*)(F.ctl + CW_BAR); bar.x = 0; bar.st = nullptr;
    if (!MK_SPLIT) bar = xcd_barrier_post((unsigned*)(F.ctl + CW_BAR), F.MISC + 8);
    F.pb_t0 = 0; F.pb_acc = 0;
    const int lo = args.ph_lo, hi = args.ph_hi;
#define IN(k) (lo <= (k) && (k) < hi)
#define SEAM(k) do { if (IN(k) && IN((k) + 1)) xcd_barrier(bar); } while (0)
#define SEAM_L(k) do { if (IN(k) && IN((k) + 1)) { if (F.local_ok) xcc_barrier((unsigned*)(F.ctl + CW_LBAR), my_xcc, (unsigned)F.G / 8u, (unsigned*)(F.ctl + CW_BAR) + XB_TMO); else xcd_barrier(bar); } } while (0)
#define REFRESH() int gw, NGW, c; do { int t_ = threadIdx.x; asm volatile("" : "+v"(t_)); F.tid = t_; F.lane = t_ & 63; F.wave = __builtin_amdgcn_readfirstlane(t_ >> 6); \
        gw = F.vcu * NWAVES + F.wave; NGW = F.G * NWAVES; c = F.cx; (void)gw; (void)NGW; (void)c; } while (0)

    PB_START(0);
    if (PH_ON(0) && IN(0)) { REFRESH();
        convert_small_weights(F, gw, NGW);
        convert_moe_weights(F, 0, gw, NGW);
        rows_phase<false, false, false, true>(F, KIN(0), nullptr, 2 * gw, 2 * NGW, T);
    }
    SEAM(0);
    PB_END(0);
    if (!MK_SPLIT) {
        LAS unsigned* xc = (LAS unsigned*)(F.lds + WSF_OFF);
        if (F.tid < 16) xc[F.tid] = __hip_atomic_load((unsigned*)(F.ctl + CW_XRANK) + F.tid, RLX_AGENT);
        __syncthreads();
        unsigned pre = 0, tot = 0, uni = 1u;
#pragma unroll
        for (unsigned j = 0; j < 16; ++j) { const unsigned cj = xc[j]; pre += (j < my_xcc) ? cj : 0u; tot += cj; uni &= (cj == 0u || cj * 8u == (unsigned)F.G) ? 1u : 0u; }
        F.local_ok = (uni && tot == (unsigned)F.G && F.G == 256) ? 1 : 0;
        if (tot == (unsigned)F.G) { F.vcu = (int)(pre + my_rank); const int per = F.G / 8; F.cx = (F.G % 8 == 0) ? (F.vcu % per) * 8 + F.vcu / per : F.vcu; }
        __syncthreads(); }
#pragma nounroll
    for (int l = 0; l < DEPTH; ++l) {
        const int pb = 1 + 8 * l;
        PB_START(1);
        if (PH_ON(1) && IN(pb + 0)) {   REFRESH();
            SchedPlain S{(const char*)(F.ws + WS_XB), (const char*)(F.ws + WS_WIN_T) + (size_t)l * NIN * D * 2, 128, 20, D, F.G, c, (const int*)(F.ws + WS_RSTD1), nullptr};
            LAS float* gl = (LAS float*)(F.lds + LUT_OFF);
            if (F.tid < 128) gl[F.tid] = (F.tid < 64) ? KIN(4)[l * 64 + F.tid] * C2 : KIN(5)[l * 64 + F.tid - 64];
            __syncthreads();
            EpiInProj E{F.ws, gl, (const LAS float*)(F.lds + AUX_OFF)};
            pg8::gemm_phase<EpiInProj, SchedPlain>(F.lds, D, S, E);
        }
        SEAM_L(pb + 0);
        PB_END(1);
        PB_START(2);
        if (PH_ON(2) && IN(pb + 1)) { REFRESH(); attention_phase(F, l); }
        SEAM_L(pb + 1);
        PB_END(2);
        PB_START(3);
        if (PH_ON(3) && IN(pb + 2)) {   REFRESH();
            SchedBranch S{(const char*)(F.ws + WS_DQ), (const char*)(F.ws + WS_SBQ), (const char*)(F.ws + WS_WBD_T) + (size_t)l * D * 512 * 2, (const char*)(F.ws + WS_WBS_T) + (size_t)l * D * 512 * 2, F.G, c};
            EpiBranch E{(const unsigned char*)(F.ws + WS_G1), (bf16*)(F.ws + WS_MIXED)};
            pg8::gemm_phase<EpiBranch, SchedBranch>(F.lds, 512, S, E);
        }
        SEAM_L(pb + 2);
        PB_END(3);
        PB_START(4);
        if (PH_ON(4) && IN(pb + 3)) {   REFRESH();
            SchedPlain S{(const char*)(F.ws + WS_MIXED), (const char*)(F.ws + WS_WOUT_T) + (size_t)l * D * D * 2, 128, 4, D, F.G, c};
            EpiOutProj E{(bf16*)(F.ws + WS_XB), (unsigned char*)(F.ws + WS_XB8)};
            pg8::gemm_phase<EpiOutProj, SchedPlain>(F.lds, D, S, E);
        }
        SEAM_L(pb + 3);
        PB_END(4);
        PB_START(5);
        if (PH_ON(5) && IN(pb + 4)) { REFRESH(); router_phase(F, l); }
        SEAM(pb + 4);
        PB_END(5);
        PB_START(7);
        if (PH_ON(7) && IN(pb + 5)) {   REFRESH();
            build_ust(F, l);
            SchedMoe<true> S{(const char*)(F.ws + WS_XB8), (const char*)(F.ws + WS_WGU_T), (const LAS int*)(F.lds + MOE_OFF), (const int*)(F.ws + WS_ENT_TOK), (const int*)(F.ws + WS_ENT_RS), nullptr, D / 2, (size_t)1024 * 1024, F.G, c};
            EpiMoe1 E{(const LAS float*)(F.lds + AUX_OFF), (unsigned char*)(F.ws + WS_ACT)};
            pg8::gemm_phase<EpiMoe1, SchedMoe<true>>(F.lds, D / 2, S, E);
        }
        SEAM_L(pb + 5);
        PB_END(7);
        PB_START(8);
        if (PH_ON(8) && IN(pb + 6)) {   REFRESH();
            build_ust(F, l);
            SchedMoe<false> S{(const char*)(F.ws + WS_ACT), (const char*)(F.ws + WS_WDN_T), (const LAS int*)(F.lds + MOE_OFF), (const int*)(F.ws + WS_IDENT), (const int*)(F.ws + WS_ENT_TOK), (const int*)(F.ws + WS_ENT_W), DFF / 2, (size_t)1024 * 512, F.G, c};
            EpiMoe2 E{(const LAS int*)(F.lds + AUX_OFF), (unsigned char*)(F.ws + WS_CONTRIB)};
            pg8::gemm_phase<EpiMoe2, SchedMoe<false>>(F.lds, DFF / 2, S, E);
        }
        SEAM(pb + 6);
        PB_END(8);
        PB_START(9);
        if (PH_ON(9) && IN(pb + 7)) {   REFRESH();
            const int per = F.G / 8, xg = F.vcu / per, lw = (F.vcu % per) * NWAVES + F.wave; const bool al = (F.G == 256);
            const int mf = al ? 4096 * xg + 2 * lw : 2 * gw, ms = al ? 512 : 2 * NGW, me = al ? 4096 * xg + 4096 : T;
            if (l + 1 < DEPTH) { rows_phase<true, true, false, true>(F, nullptr, nullptr, mf, ms, me); convert_moe_weights(F, l + 1, gw, NGW); }
            else rows_phase<true, true, true, false>(F, nullptr, F.out, mf, ms, me);
        }
        if (l + 1 < DEPTH) SEAM_L(pb + 7);
        PB_END(9);
    }
    if (PROBE_TYPE >= 0 && blockIdx.x == 0 && threadIdx.x == 0) { const unsigned long long te = __builtin_amdgcn_s_memrealtime();
        while (__builtin_amdgcn_s_memrealtime() - te < PROBE_AMP * F.pb_acc) __builtin_amdgcn_s_sleep(8); }
#undef IN
#undef SEAM
}

extern "C" void kernel_launch(void* const* d_in, const int* in_sizes, int n_in, void* d_out, int out_size, void* d_ws, size_t ws_size, hipStream_t stream) {
    static int grid = 0;
    if (grid == 0) {
        if (n_in != 20 || in_sizes[0] != T * D || out_size != T * D || ws_size < WS_END) { fprintf(stderr, "kernel_launch: unexpected shapes / workspace (n_in %d, ws %zu, need %zu)\n", n_in, ws_size, (size_t)WS_END); grid = -1; return; }
        int dev = 0, cus = 0, per_cu = 0;
        if (hipGetDevice(&dev) != hipSuccess || hipDeviceGetAttribute(&cus, hipDeviceAttributeMultiprocessorCount, dev) != hipSuccess) { grid = -1; return; }
        if (hipFuncSetAttribute((const void*)mk_fwd, hipFuncAttributeMaxDynamicSharedMemorySize, LDS_BYTES) != hipSuccess) { fprintf(stderr, "kernel_launch: hipFuncSetAttribute failed\n"); grid = -1; return; }
        if (hipOccupancyMaxActiveBlocksPerMultiprocessor(&per_cu, (const void*)mk_fwd, NWAVES * 64, LDS_BYTES) != hipSuccess || per_cu < 1) fprintf(stderr, "kernel_launch: occupancy query reports %d\n", per_cu);
        (void)hipGetLastError();
        grid = cus;
    }
    if (grid < 0) return;
    if (hipMemsetAsync((char*)d_ws + WS_CTL, 0, CTL_ZERO_BYTES, stream) != hipSuccess) return;
    Args a{};
    for (int i = 0; i < 20; ++i) a.in[i] = (const float*)d_in[i];
    a.out = (float*)d_out; a.ws = (unsigned char*)d_ws;
#if MK_SPLIT
    for (int p = 0; p < NPHASE; ++p) { a.ph_lo = p; a.ph_hi = p + 1; hipLaunchKernelGGL(mk_fwd, dim3(grid), dim3(NWAVES * 64), LDS_BYTES, stream, a); }
#else
    a.ph_lo = 0; a.ph_hi = NPHASE;
    hipLaunchKernelGGL(mk_fwd, dim3(grid), dim3(NWAVES * 64), LDS_BYTES, stream, a);
#endif
}
```

```cpp
#include <hip/hip_runtime.h>
#include <cstdio>
#include <cstdint>

#define GAS __attribute__((address_space(1)))
#define LAS __attribute__((address_space(3)))
typedef unsigned short bf16;
typedef short bf16x8 __attribute__((ext_vector_type(8)));
typedef short s16x4 __attribute__((ext_vector_type(4)));
typedef short v4i16_t __attribute__((ext_vector_type(4)));
typedef float f32x2 __attribute__((ext_vector_type(2)));
typedef float f32x4 __attribute__((ext_vector_type(4)));
typedef float f32x16 __attribute__((ext_vector_type(16)));
typedef unsigned u32x2 __attribute__((ext_vector_type(2)));
typedef unsigned u32x4 __attribute__((ext_vector_type(4)));
typedef int v4i_t __attribute__((ext_vector_type(4)));
typedef GAS unsigned gu32;

constexpr int T = 32768, SEQ = 4096, NB = 8, D = 1024, NIN = 5120, DEPTH = 2;
constexpr int NE = 32, DFF = 512;
constexpr float EPS = 1e-6f;
constexpr float LOG2E = 1.4426950408889634f;
constexpr float C2 = 0.125f * LOG2E;
constexpr int NWAVES = 8;
#ifndef SB_EARLY_EXIT
#define SB_EARLY_EXIT 1
#endif
#define SB_EXIT_LOG2 64.f
#ifndef MK_SPLIT
#define MK_SPLIT 0
#endif
#ifndef PH_MASK
#define PH_MASK 0x3ff
#endif
#define PH_ON(k) (((PH_MASK) >> (k)) & 1)
#ifndef PROBE_TYPE
#define PROBE_TYPE -1
#endif
#define PROBE_AMP 8
#define PB_START(k) do { if (PROBE_TYPE == (k)) F.pb_t0 = __builtin_amdgcn_s_memrealtime(); } while (0)
#define PB_END(k) do { if (PROBE_TYPE == (k)) F.pb_acc += __builtin_amdgcn_s_memrealtime() - F.pb_t0; } while (0)

constexpr size_t MiB = 1u << 20;
constexpr size_t WS_CTL = 0, CTL_ZERO_BYTES = 1 * MiB;
constexpr size_t WS_RSTD1 = 1 * MiB;
constexpr size_t WS_IDENT = 2 * MiB;
constexpr size_t WS_WR_T = 5 * MiB;
constexpr size_t WS_WIN_T = 8 * MiB;
constexpr size_t WS_WBD_T = 28 * MiB;
constexpr size_t WS_WBS_T = 30 * MiB;
constexpr size_t WS_WOUT_T = 32 * MiB;
constexpr size_t WS_WGU_T = 36 * MiB;
constexpr size_t WS_WDN_T = 100 * MiB;
constexpr size_t WS_XB = 132 * MiB;
constexpr size_t WS_R0 = 196 * MiB;
constexpr size_t WS_DQ = WS_R0;
constexpr size_t WS_DK = WS_R0 + 32 * MiB;
constexpr size_t WS_VA = WS_R0 + 64 * MiB;
constexpr size_t WS_SBQ = WS_R0 + 96 * MiB;
constexpr size_t WS_SBK = WS_R0 + 128 * MiB;
constexpr size_t WS_SBV = WS_R0 + 160 * MiB;
constexpr size_t WS_G1 = WS_R0 + 192 * MiB;
constexpr size_t WS_MIXED = WS_G1;
constexpr int PMAX = 65536 + 32 * 256;
constexpr size_t WS_ACT = WS_SBK;
constexpr size_t WS_XB8 = WS_DK;
constexpr float W8_SCALE = 64.f, A8_SCALE = 2.f, C8_SCALE = 32.f;
constexpr size_t WS_CONTRIB = WS_G1;
constexpr int ECAP = 32768;
constexpr size_t WS_ENT_TOK = 68 * MiB;
constexpr size_t WS_ENT_W = 72 * MiB;
constexpr size_t WS_ENT_RS = 76 * MiB;
constexpr size_t WS_END = WS_R0 + 256 * MiB;

constexpr int CW_BAR = 4096;
constexpr int CW_LBAR = 20480;
constexpr int CW_XRANK = 12288;
constexpr int CW_CNT = 16384;

constexpr int RING_BYTES = 131072;
constexpr int LDSCTL_OFF = RING_BYTES, MISC_OFF = LDSCTL_OFF + 320;
constexpr int LUT_OFF = LDSCTL_OFF + 512;
constexpr int WSF_OFF = LDSCTL_OFF + 2560;
constexpr int MOE_OFF = LDSCTL_OFF + 4608;
constexpr int AUX_OFF = LDSCTL_OFF + 7680;
constexpr int IDT_OFF = LDSCTL_OFF + 5632;
constexpr int LDS_BYTES = 147456;

#define RLX_AGENT __ATOMIC_RELAXED, __HIP_MEMORY_SCOPE_AGENT
#define LDS_WAIT() asm volatile("s_waitcnt lgkmcnt(0)" ::: "memory")
#define VM_WAIT() asm volatile("s_waitcnt vmcnt(0)" ::: "memory")
__device__ __forceinline__ unsigned cvt_pk_bf16(float lo, float hi) { unsigned r; asm volatile("v_cvt_pk_bf16_f32 %0, %1, %2" : "=v"(r) : "v"(lo), "v"(hi)); return r; }
__device__ __forceinline__ float bf_lo(unsigned w) { return __uint_as_float(w << 16); }
__device__ __forceinline__ float bf_hi(unsigned w) { return __uint_as_float(w & 0xffff0000u); }
__device__ __forceinline__ float wave_sum(float v) {
#pragma unroll
    for (int o = 1; o < 64; o <<= 1) v += __shfl_xor(v, o);
    return v;
}
__device__ __forceinline__ u32x2 pack8_fp8(const float (&a)[8]) {
    int w0 = 0, w1 = 0;
    w0 = __builtin_amdgcn_cvt_pk_fp8_f32(a[0], a[1], w0, false); w0 = __builtin_amdgcn_cvt_pk_fp8_f32(a[2], a[3], w0, true);
    w1 = __builtin_amdgcn_cvt_pk_fp8_f32(a[4], a[5], w1, false); w1 = __builtin_amdgcn_cvt_pk_fp8_f32(a[6], a[7], w1, true);
    u32x2 r; r.x = (unsigned)w0; r.y = (unsigned)w1; return r;
}
__device__ __forceinline__ float fexp2(float x) { return __builtin_amdgcn_exp2f(x); }
__device__ __forceinline__ float flog2(float x) { return __builtin_amdgcn_logf(x); }

#define XB_TMO      128
#define XB_XCNT(j)  (256  + 64 * (j))
#define XB_XSUB(j)  (1280 + 64 * (j))
#define XB_XGEN(j)  (2304 + 64 * (j))
#define XB_TOP      3328
#define XB_TOPGEN   3392
#define XCD_BAR_WORDS 3456
#define XB_SPIN_CAP (1u << 23)
__device__ __forceinline__ unsigned xb_ld(unsigned* p)              { return __hip_atomic_load(p, __ATOMIC_RELAXED, __HIP_MEMORY_SCOPE_AGENT); }
__device__ __forceinline__ unsigned xb_add(unsigned* p, unsigned v) { return __hip_atomic_fetch_add(p, v, __ATOMIC_RELAXED, __HIP_MEMORY_SCOPE_AGENT); }
__device__ __forceinline__ unsigned xb_xcc_id() { return (unsigned)__builtin_amdgcn_s_getreg((3 << 11) | 20) & 0xFu; }
#define XB_SPIN(cond, bar) do { unsigned _sp = 0; while (cond) { __builtin_amdgcn_s_sleep(1); \
    if ((++_sp & 255u) == 0u) { if (xb_ld(&(bar)[XB_TMO])) break; if (_sp > XB_SPIN_CAP) { atomicAdd(&(bar)[XB_TMO], 1u); break; } } } } while (0)
struct XcdBarrier { unsigned* bar; unsigned x; volatile LAS unsigned* st; };
__device__ __forceinline__ XcdBarrier xcd_barrier_post(unsigned* bar, volatile LAS unsigned* st) {
    XcdBarrier b; b.bar = bar; b.x = xb_xcc_id(); b.st = st;
    if (threadIdx.x == 0) (void)xb_add(&bar[XB_XCNT(b.x)], 1u);
    return b;
}
__device__ __forceinline__ void xcd_barrier_complete(unsigned* bar, unsigned x, unsigned& nloc, unsigned& nx) {
    const unsigned G = gridDim.x * gridDim.y * gridDim.z;
    unsigned sum, cnt, mine, sp = 0u;
    for (;;) {
        sum = 0u; cnt = 0u; mine = 0u;
#pragma unroll
        for (unsigned j = 0; j < 16; ++j) { const unsigned c = xb_ld(&bar[XB_XCNT(j)]); sum += c; cnt += (c > 0u) ? 1u : 0u; mine = (j == x) ? c : mine; }
        if (sum == G) break;
        __builtin_amdgcn_s_sleep(1);
        if ((++sp & 255u) == 0u) { if (xb_ld(&bar[XB_TMO])) break; if (sp > XB_SPIN_CAP) { atomicAdd(&bar[XB_TMO], 1u); break; } }
    }
    nloc = mine > 0u ? mine : 1u; nx = cnt > 0u ? cnt : 1u;
}
__device__ __forceinline__ void xcd_barrier(const XcdBarrier& b) {
    asm volatile("s_waitcnt vmcnt(0)" ::: "memory");
    __syncthreads();
    if (threadIdx.x == 0) {
        unsigned* bar = b.bar;
        __builtin_amdgcn_s_waitcnt(0);
        unsigned nloc = b.st[0], nx = b.st[1];
        if (nloc == 0u) { xcd_barrier_complete(bar, b.x, nloc, nx); b.st[0] = nloc; b.st[1] = nx; }
        const unsigned old = xb_add(&bar[XB_XSUB(b.x)], 1u);
        const unsigned gen = old / nloc;
        if (old + 1u == (gen + 1u) * nloc) {
            __builtin_amdgcn_fence(__ATOMIC_RELEASE, "agent");
            asm volatile("s_waitcnt vmcnt(0)" ::: "memory");
            const unsigned og = xb_add(&bar[XB_TOP], 1u);
            const unsigned tg = og / nx;
            if (og + 1u == (tg + 1u) * nx) xb_add(&bar[XB_TOPGEN], 1u);
            else XB_SPIN(xb_ld(&bar[XB_TOPGEN]) == tg, bar);
            __builtin_amdgcn_fence(__ATOMIC_ACQUIRE, "agent");
            xb_add(&bar[XB_XGEN(b.x)], 1u);
            asm volatile("s_waitcnt vmcnt(0)" ::: "memory");
        } else {
            XB_SPIN(xb_ld(&bar[XB_XGEN(b.x)]) == gen, bar);
            __builtin_amdgcn_fence(__ATOMIC_ACQUIRE, "agent");
            asm volatile("s_waitcnt vmcnt(0)" ::: "memory");
        }
    }
    __syncthreads();
}

__device__ __forceinline__ void xcc_barrier(unsigned* lb, unsigned x, unsigned nloc, unsigned* tmo) {
    asm volatile("s_waitcnt vmcnt(0)" ::: "memory");
    __syncthreads();
    if (threadIdx.x == 0) {
        const unsigned old = xb_add(&lb[64 * x], 1u), gen = old / nloc;
        if (old + 1u == (gen + 1u) * nloc) xb_add(&lb[1024 + 64 * x], 1u);
        else { unsigned sp = 0; while (xb_ld(&lb[1024 + 64 * x]) == gen) { __builtin_amdgcn_s_sleep(1);
                   if ((++sp & 255u) == 0u) { if (xb_ld(tmo)) break; if (sp > XB_SPIN_CAP) { atomicAdd(tmo, 1u); break; } } } }
        __builtin_amdgcn_fence(__ATOMIC_ACQUIRE, "agent");
        asm volatile("s_waitcnt vmcnt(0)" ::: "memory");
    }
    __syncthreads();
}

namespace pg8 {
constexpr int BM = 256, BK = 64, HALF = 128, HTB = HALF * BK * 2, STAGE_BYTES = 8 * HTB, NXCD = 8, WGM = 8;
__host__ __device__ __forceinline__ int lds_byte(int r, int c) { const int st = (r >> 4) * 2 + (c >> 5), rr = r & 15, cc = c & 31, ob = rr * 64 + cc * 2; return st * 1024 + (ob ^ (((ob >> 9) & 1) << 5)); }
__host__ __device__ __forceinline__ void stage_rc(int b, int& R, int& C) { const int st = b / 1024, sb = b % 1024, swz = sb ^ (((sb >> 9) & 1) << 5); R = (st >> 1) * 16 + swz / 64; C = (st & 1) * 32 + (swz % 64) / 2; }
__host__ __device__ __forceinline__ int perm32(int rho) { const int n = rho >> 4, i = rho & 15; return 8 * (i >> 2) + 4 * n + (i & 3); }

struct Unit { const char* A; const char* B; int pm, pn, kind, eoff, nvalid, goff, gnv, slot; };
constexpr int KEEP = 0x100;

__device__ __forceinline__ void tile_order(int L, int nM, int nN, int& pm, int& pn) {
    const int nwg = nM * nN; int wgid = L;
    { const int q = nwg / NXCD, r = nwg % NXCD, xcd = wgid % NXCD, off = wgid / NXCD; wgid = (xcd < r ? xcd * (q + 1) : r * (q + 1) + (xcd - r) * q) + off; }
    const int nig = WGM * nN, gid = wgid / nig, fm = gid * WGM, gsz = (nM - fm) < WGM ? (nM - fm) : WGM;
    pm = fm + ((wgid % nig) % gsz); pn = (wgid % nig) / gsz;
}

template <class Epi, class Sched, bool ALIGN_EPI = true, bool SP2 = true>
__device__ __forceinline__ void gemm_phase(LAS unsigned char* lds, const int K_, const Sched& S, const Epi& E, unsigned long long* pb = nullptr) {
    int tid_ = threadIdx.x; asm volatile("" : "+v"(tid_));
    const int tid = tid_, wid = __builtin_amdgcn_readfirstlane(tid >> 6), lane = tid & 63, wr = wid >> 2, wc = wid & 3, fr = lane & 15, fq = lane >> 4;
    int K = K_; asm volatile("" : "+s"(K));
    const int nt = K / BK;
    unsigned voffA[2], voffB[2]; int gR[2]; unsigned gC[2];
#pragma unroll
    for (int i = 0; i < 2; ++i) { int R, C; stage_rc(tid * 16 + i * 8192, R, C); const int Rb = Epi::PERM ? ((R & ~31) + perm32(R & 31)) : R;
        voffA[i] = (unsigned)(R * K + C) * 2u; voffB[i] = (unsigned)(Rb * K + C) * 2u; gR[i] = R; gC[i] = (unsigned)C * 2u; }
    unsigned voffG[2][2]; (void)gR; (void)gC;
    LAS int* idtab = (LAS int*)(lds + STAGE_BYTES + (IDT_OFF - RING_BYTES));
#define PG8_IDS_DMA(u_, slot) do { if (wid < 4) { int t_ = tid; asm volatile("" : "+v"(t_));   \
        __builtin_amdgcn_global_load_lds((const unsigned*)(S.ids + (u_).goff + t_), (LAS unsigned*)(idtab + (slot) * 256 + wid * 64), 4, 0, 0); } } while (0)
    LAS int* auxt = (LAS int*)(lds + STAGE_BYTES + (AUX_OFF - RING_BYTES));
#define PG8_AUX_DMA(u_) do { if (wid < 4) { int t_ = tid; asm volatile("" : "+v"(t_)); \
        if (S.aux0) __builtin_amdgcn_global_load_lds((const unsigned*)(S.aux0 + (u_).eoff + t_), (LAS unsigned*)(auxt + (u_).slot * 256 + wid * 64), 4, 0, 0); \
        if (S.aux1) __builtin_amdgcn_global_load_lds((const unsigned*)(S.aux1 + (u_).eoff + t_), (LAS unsigned*)(auxt + 768 + (u_).slot * 256 + wid * 64), 4, 0, 0); } } while (0)
#define PG8_IDS_READ(u_, slot) do { _Pragma("unroll") for (int i_ = 0; i_ < 2; ++i_) { int g_ = gR[i_]; asm volatile("" : "+v"(g_)); _Pragma("unroll") for (int h_ = 0; h_ < 2; ++h_) { const int r_ = h_ * 128 + g_; int id_ = idtab[(slot) * 256 + r_]; \
        id_ = (r_ < (u_).gnv) ? (id_ >> 1) : 0; voffG[h_][i_] = (unsigned)id_ * (unsigned)(K * 2) + gC[i_]; } } } while (0)
#define PG8_STAGE_A(buf, h, gbase) do { if constexpr (Sched::GATHER) { PG8_STAGE(PG8_SA(buf, h), gbase, voffG[h]); } else { PG8_STAGE(PG8_SA(buf, h), (gbase) + (h) * hstep, voffA); } } while (0)
    const size_t kstep = (size_t)(BK * 2);
    const size_t hstep = (size_t)HALF * K * 2;
    const unsigned ldsw = (unsigned)wid * 1024u;
    constexpr bool F8 = Sched::FP8;
    const int aoff = lds_byte(wr * 64 + fr, fq * 8), boff = lds_byte(wc * 32 + fr, fq * 8);
    constexpr int KSTEP = 1024;
#define PG8_SA(b, h) (((b) * 2 + (h)) * HTB)
#define PG8_SB(b, h) ((4 + (b) * 2 + (h)) * HTB)
#define PG8_STAGE(bufoff, gbase, voff) do { _Pragma("unroll") for (int _i = 0; _i < 2; ++_i) \
        __builtin_amdgcn_global_load_lds((const unsigned*)((const char*)(gbase) + (voff)[_i]), (LAS unsigned*)(lds + (bufoff) + ldsw + _i * 8192), 16, 0, 0); } while (0)
#define PG8_LDA(dst, b, h) do { _Pragma("unroll") for (int m = 0; m < 4; ++m) _Pragma("unroll") for (int k = 0; k < 2; ++k) dst[m][k] = *(const LAS bf16x8*)(lds + PG8_SA(b, h) + aoff + m * 2048 + k * KSTEP); } while (0)
#define PG8_LDB(dst, b, h) do { _Pragma("unroll") for (int n = 0; n < 2; ++n) _Pragma("unroll") for (int k = 0; k < 2; ++k) dst[n][k] = *(const LAS bf16x8*)(lds + PG8_SB(b, h) + boff + n * 2048 + k * KSTEP); } while (0)
#define PG8_CAT(x) __builtin_shufflevector(__builtin_bit_cast(v4i_t, (x)[0]), __builtin_bit_cast(v4i_t, (x)[1]), 0, 1, 2, 3, 4, 5, 6, 7)
#define PG8_MMA(ai, bj, At, Bt) do { __builtin_amdgcn_s_setprio(1); if constexpr (F8) { _Pragma("unroll") for (int m = 0; m < 4; ++m) _Pragma("unroll") for (int n = 0; n < 2; ++n) \
        acc[ai][bj][m][n] = __builtin_amdgcn_mfma_scale_f32_16x16x128_f8f6f4(PG8_CAT(Bt[n]), PG8_CAT(At[m]), acc[ai][bj][m][n], 0, 0, 0, 0x7f7f7f7f, 0, 0x7f7f7f7f); } else { \
        _Pragma("unroll") for (int m = 0; m < 4; ++m) _Pragma("unroll") for (int n = 0; n < 2; ++n) _Pragma("unroll") for (int k = 0; k < 2; ++k) \
        acc[ai][bj][m][n] = __builtin_amdgcn_mfma_f32_16x16x32_bf16(Bt[n][k], At[m][k], acc[ai][bj][m][n], 0, 0, 0); } __builtin_amdgcn_s_setprio(0); } while (0)
#define PG8_WAIT_V(n) asm volatile("s_waitcnt vmcnt(" #n ")" ::: "memory")
#define PG8_WAIT_L(n) asm volatile("s_waitcnt lgkmcnt(" #n ")" ::: "memory")
#define PG8_BAR __builtin_amdgcn_s_barrier()
#define PG8_SCHED __builtin_amdgcn_sched_barrier(0)
    Unit cur, nxt; int ui = 0;
    if (!S.next(0, cur)) return;
    f32x4 acc[2][2][4][2];
#pragma unroll
    for (int a = 0; a < 2; ++a)
#pragma unroll
        for (int b = 0; b < 2; ++b)
#pragma unroll
            for (int m = 0; m < 4; ++m)
#pragma unroll
                for (int n = 0; n < 2; ++n) acc[a][b][m][n] = (f32x4){0.f, 0.f, 0.f, 0.f};
    bf16x8 At[4][2], B0[2][2], B1[2][2];
    const char* cA = cur.A; const char* cB = cur.B;
    static_assert(SP2, "only the SP2 loop is kept here");
    cur.slot = 0;
    if constexpr (Sched::GATHER) { PG8_IDS_DMA(cur, 0); PG8_AUX_DMA(cur); PG8_WAIT_V(0); __syncthreads(); PG8_IDS_READ(cur, 0); }
    else if (S.aux0) { PG8_AUX_DMA(cur); PG8_WAIT_V(0); __syncthreads(); }
    PG8_STAGE(PG8_SB(0, 0), cB, voffB); PG8_STAGE(PG8_SB(0, 1), cB + hstep, voffB); PG8_STAGE_A(0, 0, cA); PG8_STAGE_A(0, 1, cA);
    if (wr == 1) PG8_BAR;
    PG8_WAIT_V(2); PG8_BAR;
    PG8_STAGE(PG8_SB(1, 0), cB + kstep, voffB); PG8_STAGE_A(1, 0, cA + kstep); PG8_STAGE(PG8_SB(1, 1), cB + hstep + kstep, voffB);
    PG8_WAIT_V(6); PG8_BAR;
    for (;;) {
        const bool has_next = S.next(ui + 1, nxt);
        const char* nA = has_next ? nxt.A : cA; const char* nB = has_next ? nxt.B : cB;
        nxt.slot = (cur.slot == 2) ? 0 : cur.slot + 1;
        if constexpr (Sched::GATHER) { if (has_next) { PG8_IDS_DMA(nxt, (ui + 1) & 1); PG8_AUX_DMA(nxt); } }
        else { if (has_next && S.aux0) PG8_AUX_DMA(nxt); }
#pragma nounroll
        for (int t = 0; t < nt; t += 2) {
            unsigned long long pbt = 0; if (pb && (PROBE_TYPE == 21 || PROBE_TYPE == 22)) pbt = __builtin_amdgcn_s_memrealtime();
            const bool last = (t == nt - 2);
            const char* a1 = cA + (size_t)(t + 1) * kstep;
            const char* a2 = last ? nA : cA + (size_t)(t + 2) * kstep; const char* b2 = last ? nB : cB + (size_t)(t + 2) * kstep;
            const char* a3 = a2 + kstep; const char* b3 = b2 + kstep;
            PG8_LDB(B0, 0, 0); PG8_LDB(B1, 0, 1); PG8_SCHED; PG8_LDA(At, 0, 0); PG8_STAGE_A(1, 1, a1);
            if constexpr (Sched::GATHER) { if (last && has_next) PG8_IDS_READ(nxt, (ui + 1) & 1); }
            PG8_WAIT_V(8); PG8_WAIT_L(0); PG8_BAR; PG8_MMA(0, 0, At, B0); PG8_MMA(0, 1, At, B1); PG8_BAR; PG8_SCHED;
            PG8_LDA(At, 0, 1); PG8_STAGE(PG8_SB(0, 0), b2, voffB); PG8_STAGE(PG8_SB(0, 1), b2 + hstep, voffB); PG8_STAGE_A(0, 0, a2);
            PG8_WAIT_V(8); PG8_WAIT_L(0); PG8_BAR; PG8_MMA(1, 0, At, B0); PG8_MMA(1, 1, At, B1); PG8_BAR; PG8_SCHED;
            PG8_LDB(B0, 1, 0); PG8_LDB(B1, 1, 1); PG8_SCHED; PG8_LDA(At, 1, 0); PG8_STAGE_A(0, 1, a2);
            PG8_WAIT_V(8); PG8_WAIT_L(0); PG8_BAR; PG8_MMA(0, 0, At, B0); PG8_MMA(0, 1, At, B1); PG8_BAR; PG8_SCHED;
            PG8_LDA(At, 1, 1); PG8_STAGE(PG8_SB(1, 0), b3, voffB); PG8_STAGE(PG8_SB(1, 1), b3 + hstep, voffB); PG8_STAGE_A(1, 0, a3);
            PG8_WAIT_V(8); PG8_WAIT_L(0); PG8_BAR; PG8_MMA(1, 0, At, B0); PG8_MMA(1, 1, At, B1); PG8_BAR; PG8_SCHED;
            if (pb && ((PROBE_TYPE == 21 && t == 0) || (PROBE_TYPE == 22 && t != 0))) *pb += __builtin_amdgcn_s_memrealtime() - pbt;
        }
        unsigned long long pbe = 0; if (pb && PROBE_TYPE == 20) pbe = __builtin_amdgcn_s_memrealtime();
        if constexpr (ALIGN_EPI) { if (wr == 0) PG8_BAR; }
        { unsigned z_ = 0u; asm volatile("" : "+v"(z_));
          const int l_ = (int)__builtin_amdgcn_mbcnt_hi(~0u, __builtin_amdgcn_mbcnt_lo(~0u, z_));
          E(acc, cur, wr, wc, l_ & 15, l_ >> 4); }
        if (pb && PROBE_TYPE == 20) *pb += __builtin_amdgcn_s_memrealtime() - pbe;
        if (!has_next) break;
        if (!(cur.kind & KEEP)) {
#pragma unroll
            for (int a = 0; a < 2; ++a)
#pragma unroll
                for (int b = 0; b < 2; ++b)
#pragma unroll
                    for (int m = 0; m < 4; ++m)
#pragma unroll
                        for (int n = 0; n < 2; ++n) acc[a][b][m][n] = (f32x4){0.f, 0.f, 0.f, 0.f};
        }
        cur = nxt; cA = nA; cB = nB; ++ui;
        if constexpr (ALIGN_EPI) { if (wr == 1) PG8_BAR; }
    }
    PG8_WAIT_V(0);
    if constexpr (!ALIGN_EPI) { if (wr == 0) PG8_BAR; }
    PG8_BAR;
#undef PG8_SA
#undef PG8_SB
#undef PG8_STAGE
#undef PG8_STAGE_A
#undef PG8_IDS_DMA
#undef PG8_AUX_DMA
#undef PG8_IDS_READ
#undef PG8_LDA
#undef PG8_LDB
#undef PG8_MMA
#undef PG8_CAT
#undef PG8_WAIT_V
#undef PG8_WAIT_L
#undef PG8_BAR
#undef PG8_SCHED
}
}

struct Args { const float* in[20]; float* out; unsigned char* ws; int ph_lo, ph_hi; };
#define KIN(i) (((const __attribute__((address_space(4))) Args*)__builtin_amdgcn_kernarg_segment_ptr())->in[i])
struct Frame {
    LAS unsigned char* lds;
    volatile LAS unsigned* MISC;
    gu32* ctl;
    int tid, lane, wave, G;
    int vcu, cx, local_ok;
    unsigned char* ws;
    float* out;
    unsigned long long pb_t0, pb_acc;
};

using pg8::Unit;
typedef f32x4 Acc[2][2][4][2];

struct EpiInProj {
    static constexpr bool PERM = true;
    unsigned char* ws; const LAS float* gl; const LAS float* rs_tab;
    __device__ __forceinline__ void operator()(Acc& acc, const Unit& u, int wr, int wc, int fr, int fq) const {
        const int row0 = u.pm * 256 + wr * 64 + fr; const int pn = u.pn;
        float rs[2][4];
#pragma unroll
        for (int ai = 0; ai < 2; ++ai)
#pragma unroll
            for (int m = 0; m < 4; ++m) rs[ai][m] = rs_tab[u.slot * 256 + wr * 64 + fr + ai * 128 + m * 16];
        if (pn < 4) {
            const LAS float* g = gl + (pn >> 1) * 64 + 8 * fq;
            bf16* dst = (bf16*)(ws + WS_DQ + (size_t)(pn >> 1) * (32 * MiB)) + wc * 128 + (pn & 1) * 64 + 8 * fq;
#pragma unroll
            for (int ai = 0; ai < 2; ++ai)
#pragma unroll
                for (int m = 0; m < 4; ++m) {
                    const int row = row0 + ai * 128 + m * 16; const float r_ = rs[ai][m]; float ss = 0.f; f32x4 v[2][2];
#pragma unroll
                    for (int bj = 0; bj < 2; ++bj)
#pragma unroll
                        for (int n = 0; n < 2; ++n) { v[bj][n] = acc[ai][bj][m][n] * r_; ss += (v[bj][n][0] * v[bj][n][0] + v[bj][n][1] * v[bj][n][1]) + (v[bj][n][2] * v[bj][n][2] + v[bj][n][3] * v[bj][n][3]); }
                    ss += __shfl_xor(ss, 16); ss += __shfl_xor(ss, 32);
                    const float inv = __builtin_amdgcn_rsqf(ss * (1.0f / 64.0f) + EPS);
                    bf16* rowp = dst + (size_t)row * 512;
#pragma unroll
                    for (int bj = 0; bj < 2; ++bj) { const f32x4 g0 = *(const LAS f32x4*)(g + 32 * bj) * inv, g1 = *(const LAS f32x4*)(g + 32 * bj + 4) * inv; u32x4 w;
                        w.x = cvt_pk_bf16(v[bj][0][0] * g0[0], v[bj][0][1] * g0[1]); w.y = cvt_pk_bf16(v[bj][0][2] * g0[2], v[bj][0][3] * g0[3]);
                        w.z = cvt_pk_bf16(v[bj][1][0] * g1[0], v[bj][1][1] * g1[1]); w.w = cvt_pk_bf16(v[bj][1][2] * g1[2], v[bj][1][3] * g1[3]);
                        *(u32x4*)(rowp + bj * 32) = w; }
                }
        } else if (pn < 12) {
            const int sec = (pn - 4) >> 1; bf16* dst = (bf16*)(ws + WS_VA + (size_t)sec * (32 * MiB)) + ((pn - 4) & 1) * 256 + wc * 32 + 8 * fq; const float sc = (sec == 1) ? C2 : 1.f;
#pragma unroll
            for (int ai = 0; ai < 2; ++ai)
#pragma unroll
                for (int m = 0; m < 4; ++m) { const int row = row0 + ai * 128 + m * 16; const float r_ = rs[ai][m] * sc; bf16* rowp = dst + (size_t)row * 512;
#pragma unroll
                    for (int bj = 0; bj < 2; ++bj) { const f32x4 v0 = acc[ai][bj][m][0] * r_, v1 = acc[ai][bj][m][1] * r_; u32x4 w;
                        w.x = cvt_pk_bf16(v0[0], v0[1]); w.y = cvt_pk_bf16(v0[2], v0[3]); w.z = cvt_pk_bf16(v1[0], v1[1]); w.w = cvt_pk_bf16(v1[2], v1[3]);
                        *(u32x4*)(rowp + bj * 128) = w; } }
        } else {
            const int col0 = (pn - 12) * 128 + wc * 32 + 8 * fq; unsigned char* G = ws + WS_G1;
#pragma unroll
            for (int ai = 0; ai < 2; ++ai)
#pragma unroll
                for (int m = 0; m < 4; ++m) { const int row = row0 + ai * 128 + m * 16; const float r_ = rs[ai][m];
                    unsigned qa[8], qb[8];
#pragma unroll
                    for (int n = 0; n < 2; ++n)
#pragma unroll
                        for (int j = 0; j < 4; ++j) { const float ga = acc[ai][0][m][n][j] * r_, gb = acc[ai][1][m][n][j] * r_;
                            const float sa = __builtin_amdgcn_rcpf(1.f + fexp2(-ga * LOG2E)), sb = __builtin_amdgcn_rcpf(1.f + fexp2(-gb * LOG2E));
                            qa[n * 4 + j] = (unsigned)(sa * 255.f + 0.5f); qb[n * 4 + j] = max(1u, (unsigned)(sb * 255.f + 0.5f)); }
                    u32x4 w;
                    w.x = qa[0] | (qa[1] << 8) | (qa[2] << 16) | (qa[3] << 24); w.y = qa[4] | (qa[5] << 8) | (qa[6] << 16) | (qa[7] << 24);
                    w.z = qb[0] | (qb[1] << 8) | (qb[2] << 16) | (qb[3] << 24); w.w = qb[4] | (qb[5] << 8) | (qb[6] << 16) | (qb[7] << 24);
                    *(u32x4*)(G + (size_t)row * 2048 + (size_t)col0 * 2) = w; }
        }
    }
};

struct EpiBranch {
    static constexpr bool PERM = true;
    const unsigned char* G; bf16* MIXED;
    __device__ __forceinline__ void operator()(Acc& acc, const Unit& u, int wr, int wc, int fr, int fq) const {
        const int row0 = u.pm * 256 + wr * 64 + fr; const int col0 = u.pn * 256 + wc * 32 + 8 * fq; const bool first = (u.kind & 0xff) == 0;
        const unsigned char* Gp = G + (size_t)row0 * 2048 + (size_t)col0 * 2;
        u32x4 g[2][4][2];
#pragma unroll
        for (int ai = 0; ai < 2; ++ai)
#pragma unroll
            for (int m = 0; m < 4; ++m)
#pragma unroll
                for (int bj = 0; bj < 2; ++bj) g[ai][m][bj] = *(const u32x4*)(Gp + (size_t)(ai * 128 + m * 16) * 2048 + bj * 256);
#define UB(w, k) ((float)(((w) >> (8 * (k))) & 0xffu))
        if (first) {
#pragma unroll
            for (int ai = 0; ai < 2; ++ai)
#pragma unroll
                for (int m = 0; m < 4; ++m)
#pragma unroll
                    for (int bj = 0; bj < 2; ++bj) { u32x4 gg = g[ai][m][bj]; asm volatile("" : "+v"(gg));
                        f32x4 v0 = acc[ai][bj][m][0], v1 = acc[ai][bj][m][1];
                        v0[0] *= UB(gg.x, 0) * __builtin_amdgcn_rcpf(UB(gg.z, 0)); v0[1] *= UB(gg.x, 1) * __builtin_amdgcn_rcpf(UB(gg.z, 1)); v0[2] *= UB(gg.x, 2) * __builtin_amdgcn_rcpf(UB(gg.z, 2)); v0[3] *= UB(gg.x, 3) * __builtin_amdgcn_rcpf(UB(gg.z, 3));
                        v1[0] *= UB(gg.y, 0) * __builtin_amdgcn_rcpf(UB(gg.w, 0)); v1[1] *= UB(gg.y, 1) * __builtin_amdgcn_rcpf(UB(gg.w, 1)); v1[2] *= UB(gg.y, 2) * __builtin_amdgcn_rcpf(UB(gg.w, 2)); v1[3] *= UB(gg.y, 3) * __builtin_amdgcn_rcpf(UB(gg.w, 3));
                        acc[ai][bj][m][0] = v0; acc[ai][bj][m][1] = v1; }
        } else {
            bf16* Mp = MIXED + (size_t)row0 * 1024 + col0; asm volatile("" : "+v"(Mp)); const float q = 1.0f / 255.0f;
#pragma unroll
            for (int ai = 0; ai < 2; ++ai)
#pragma unroll
                for (int m = 0; m < 4; ++m)
#pragma unroll
                    for (int bj = 0; bj < 2; ++bj) { u32x4 gg = g[ai][m][bj]; asm volatile("" : "+v"(gg)); const f32x4 v0 = acc[ai][bj][m][0] * q, v1 = acc[ai][bj][m][1] * q; u32x4 w;
                        w.x = cvt_pk_bf16(v0[0] * UB(gg.z, 0), v0[1] * UB(gg.z, 1)); w.y = cvt_pk_bf16(v0[2] * UB(gg.z, 2), v0[3] * UB(gg.z, 3));
                        w.z = cvt_pk_bf16(v1[0] * UB(gg.w, 0), v1[1] * UB(gg.w, 1)); w.w = cvt_pk_bf16(v1[2] * UB(gg.w, 2), v1[3] * UB(gg.w, 3));
                        *(u32x4*)(Mp + (size_t)(ai * 128 + m * 16) * 1024 + bj * 128) = w; }
        }
#undef UB
    }
};

struct EpiOutProj {
    static constexpr bool PERM = true;
    bf16* XB; unsigned char* XB8;
    __device__ __forceinline__ void operator()(Acc& acc, const Unit& u, int wr, int wc, int fr, int fq) const {
        const int row0 = u.pm * 256 + wr * 64 + fr; const int col0 = u.pn * 256 + wc * 32 + 8 * fq;
        bf16* base = XB + (size_t)row0 * 1024 + col0; unsigned char* base8 = XB8 + (size_t)row0 * 1024 + col0;
        u32x4 g[2][4][2];
#pragma unroll
        for (int ai = 0; ai < 2; ++ai)
#pragma unroll
            for (int m = 0; m < 4; ++m)
#pragma unroll
                for (int bj = 0; bj < 2; ++bj) g[ai][m][bj] = *(const u32x4*)(base + (size_t)(ai * 128 + m * 16) * 1024 + bj * 128);
#pragma unroll
        for (int ai = 0; ai < 2; ++ai)
#pragma unroll
            for (int m = 0; m < 4; ++m)
#pragma unroll
                for (int bj = 0; bj < 2; ++bj) { const u32x4 gg = g[ai][m][bj]; const f32x4 a0 = acc[ai][bj][m][0], a1 = acc[ai][bj][m][1]; u32x4 w;
                    w.x = cvt_pk_bf16(a0[0] + bf_lo(gg.x), a0[1] + bf_hi(gg.x)); w.y = cvt_pk_bf16(a0[2] + bf_lo(gg.y), a0[3] + bf_hi(gg.y));
                    w.z = cvt_pk_bf16(a1[0] + bf_lo(gg.z), a1[1] + bf_hi(gg.z)); w.w = cvt_pk_bf16(a1[2] + bf_lo(gg.w), a1[3] + bf_hi(gg.w));
                    *(u32x4*)(base + (size_t)(ai * 128 + m * 16) * 1024 + bj * 128) = w;
                    const float v8[8] = {bf_lo(w.x), bf_hi(w.x), bf_lo(w.y), bf_hi(w.y), bf_lo(w.z), bf_hi(w.z), bf_lo(w.w), bf_hi(w.w)};
                    *(u32x2*)(base8 + (size_t)(ai * 128 + m * 16) * 1024 + bj * 128) = pack8_fp8(v8); }
    }
};

struct EpiMoe1 {
    static constexpr bool PERM = true;
    const LAS float* rs_tab; unsigned char* ACT;
    __device__ __forceinline__ void operator()(Acc& acc, const Unit& u, int wr, int wc, int fr, int fq) const {
        const int row0 = u.pm * 256 + wr * 64 + fr; const int col0 = u.pn * 128 + wc * 32 + 8 * fq; const int r0 = wr * 64 + fr;
        float rs[2][4];
#pragma unroll
        for (int ai = 0; ai < 2; ++ai)
#pragma unroll
            for (int m = 0; m < 4; ++m) { const int r = r0 + ai * 128 + m * 16; rs[ai][m] = (r < u.nvalid) ? rs_tab[u.slot * 256 + r] * (1.0f / W8_SCALE) : 0.f; }
#pragma unroll
        for (int ai = 0; ai < 2; ++ai)
#pragma unroll
            for (int m = 0; m < 4; ++m) { const int prow = row0 + ai * 128 + m * 16; const float r_ = rs[ai][m]; float a[8];
#pragma unroll
                for (int n = 0; n < 2; ++n)
#pragma unroll
                    for (int j = 0; j < 4; ++j) { const float g = acc[ai][0][m][n][j] * r_, up = acc[ai][1][m][n][j] * r_;
                        a[n * 4 + j] = A8_SCALE * g * up * __builtin_amdgcn_rcpf(1.f + fexp2(-g * LOG2E)); }
                *(u32x2*)(ACT + (size_t)prow * 512 + col0) = pack8_fp8(a); }
    }
};

struct EpiMoe2 {
    static constexpr bool PERM = true;
    const LAS int* tok_tab; unsigned char* CONTRIB;
    __device__ __forceinline__ void operator()(Acc& acc, const Unit& u, int wr, int wc, int fr, int fq) const {
        const int col0 = u.pn * 256 + wc * 32 + 8 * fq; const int r0 = wr * 64 + fr;
        int tk[2][4]; float ww[2][4];
#pragma unroll
        for (int ai = 0; ai < 2; ++ai)
#pragma unroll
            for (int m = 0; m < 4; ++m) { const int r = r0 + ai * 128 + m * 16; const bool ok = r < u.nvalid; tk[ai][m] = ok ? tok_tab[u.slot * 256 + r] : -1; ww[ai][m] = ok ? __int_as_float(tok_tab[768 + u.slot * 256 + r]) * (C8_SCALE / (W8_SCALE * A8_SCALE)) : 0.f; }
#pragma unroll
        for (int ai = 0; ai < 2; ++ai)
#pragma unroll
            for (int m = 0; m < 4; ++m) { const int tok2 = tk[ai][m]; const float w_ = ww[ai][m];
                if (tok2 >= 0) {
#pragma unroll
                    for (int bj = 0; bj < 2; ++bj) { const f32x4 v0 = acc[ai][bj][m][0] * w_, v1 = acc[ai][bj][m][1] * w_;
                        const float v8[8] = {v0[0], v0[1], v0[2], v0[3], v1[0], v1[1], v1[2], v1[3]};
                        *(u32x2*)(CONTRIB + (size_t)tok2 * 1024 + col0 + bj * 128) = pack8_fp8(v8); } } }
    }
};

struct SchedPlain {
    static constexpr bool GATHER = false; static constexpr bool FP8 = false;
    const char* A; const char* Bt; int nM, nN, K, G, c; const int* aux0 = nullptr; const int* aux1 = nullptr;
    __device__ __forceinline__ bool next(int i, Unit& u) const {
        const long L = (long)i * G + c; if (L >= (long)nM * nN) return false;
        pg8::tile_order((int)L, nM, nN, u.pm, u.pn); u.kind = 0; u.eoff = 256 * u.pm; u.nvalid = 256; u.goff = 0; u.gnv = 0;
        u.A = A + (size_t)u.pm * 256 * K * 2; u.B = Bt + (size_t)u.pn * 256 * K * 2; return true;
    }
};
struct SchedBranch {
    static constexpr bool GATHER = false; static constexpr bool FP8 = false;
    const char *OA, *OB, *WBD, *WBS; int G, c; const int* aux0 = nullptr; const int* aux1 = nullptr;
    __device__ __forceinline__ bool next(int i, Unit& u) const {
        const long L = (long)(i >> 1) * G + c; if (L >= 128 * 4) return false;
        pg8::tile_order((int)L, 128, 4, u.pm, u.pn); const int br = i & 1; u.kind = br ? 1 : (0 | pg8::KEEP); u.eoff = 0; u.nvalid = 256; u.goff = 0; u.gnv = 0;
        u.A = (br ? OB : OA) + (size_t)u.pm * 256 * 512 * 2; u.B = (br ? WBS : WBD) + (size_t)u.pn * 256 * 512 * 2; return true;
    }
};
template <bool G>
struct SchedMoe {
    static constexpr bool GATHER = true; static constexpr bool FP8 = true;
    const char* A; const char* W; const LAS int* ust; const int* ids; const int* aux0; const int* aux1; int K; size_t wstride; int Gn, c;
    __device__ __forceinline__ bool next(int i, Unit& u) const {
        const int v = (Gn % 8 == 0) ? (c % 8) * (Gn / 8) + c / 8 : c;
        const long L = (long)i * Gn + v; const int nrb = ust[32]; if (L >= (long)nrb * 4) return false;
        const int rb = (int)(L >> 2), pn = (int)(L & 3); int e = 0;
        for (int j = 1; j < 32; ++j) e += (ust[j] <= rb) ? 1 : 0;
        const int rbl = rb - ust[e]; const int left = ust[64 + e] - 256 * rbl;
        u.pm = rb; u.pn = pn; u.kind = 0; u.eoff = e * ECAP + 256 * rbl; u.nvalid = left < 256 ? left : 256;
        if (G) { u.goff = u.eoff; u.gnv = u.nvalid; } else { u.goff = 256 * rb; u.gnv = 256; }
        u.A = A; u.B = W + (size_t)e * wstride + (size_t)pn * 256 * K * 2; return true;
    }
};

template <class RowMap>
__device__ __forceinline__ void transpose_item(const float* W, int N, bf16* WT, int Kd, const float* gk, LAS unsigned* scr, int kb, int nb, int lane, const RowMap& map) {
    const int k0 = 64 * kb, n0 = 64 * nb, n4 = lane & 15, kq = lane >> 4;
    f32x4 va[8], vb[8];
    const float* wp = W + (size_t)(k0 + 2 * kq) * N + n0 + 4 * n4;
#pragma unroll
    for (int i = 0; i < 8; ++i) { va[i] = __builtin_nontemporal_load((const f32x4*)(wp + (size_t)(8 * i) * N)); vb[i] = __builtin_nontemporal_load((const f32x4*)(wp + (size_t)(8 * i + 1) * N)); }
#pragma unroll
    for (int i = 0; i < 8; ++i) {
        float ga = 1.f, gb = 1.f; if (gk) { ga = gk[k0 + 8 * i + 2 * kq]; gb = gk[k0 + 8 * i + 2 * kq + 1]; }
#pragma unroll
        for (int j = 0; j < 4; ++j) scr[(4 * n4 + j) * 33 + 4 * i + kq] = cvt_pk_bf16(va[i][j] * ga, vb[i][j] * gb);
    }
    LDS_WAIT(); asm volatile("" ::: "memory");
    const int nl = lane >> 3, c = lane & 7;
#pragma unroll
    for (int p = 0; p < 8; ++p) { const int n = 8 * p + nl; const LAS unsigned* sp = scr + n * 33 + 4 * c;
        u32x4 o; o.x = sp[0]; o.y = sp[1]; o.z = sp[2]; o.w = sp[3];
        *(u32x4*)(WT + (size_t)map(n0 + n) * Kd + k0 + 8 * c) = o; }
    LDS_WAIT(); asm volatile("" ::: "memory");
}
template <class RowMap>
__device__ __forceinline__ void transpose_item8(const float* W, int N, unsigned char* WT, int Kd, const float* gk, float scale, LAS unsigned char* scr, int kb, int nb, int lane, const RowMap& map) {
    const int k0 = 64 * kb, n0 = 64 * nb, n4 = lane & 15, kq = lane >> 4;
    f32x4 va[8], vb[8];
    const float* wp = W + (size_t)(k0 + 2 * kq) * N + n0 + 4 * n4;
#pragma unroll
    for (int i = 0; i < 8; ++i) { va[i] = __builtin_nontemporal_load((const f32x4*)(wp + (size_t)(8 * i) * N)); vb[i] = __builtin_nontemporal_load((const f32x4*)(wp + (size_t)(8 * i + 1) * N)); }
#pragma unroll
    for (int i = 0; i < 8; ++i) {
        float ga = scale, gb = scale; if (gk) { ga *= gk[k0 + 8 * i + 2 * kq]; gb *= gk[k0 + 8 * i + 2 * kq + 1]; }
#pragma unroll
        for (int j = 0; j < 4; ++j) *(LAS unsigned short*)(scr + (4 * n4 + j) * 72 + 8 * i + 2 * kq) = (unsigned short)(__builtin_amdgcn_cvt_pk_fp8_f32(va[i][j] * ga, vb[i][j] * gb, 0, false) & 0xffff);
    }
    LDS_WAIT(); asm volatile("" ::: "memory");
    const int nl = lane >> 3, c = lane & 7;
#pragma unroll
    for (int p = 0; p < 8; ++p) { const int n = 8 * p + nl; const u32x2 o = *(const LAS u32x2*)(scr + n * 72 + 8 * c);
        *(u32x2*)(WT + (size_t)map(n0 + n) * Kd + k0 + 8 * c) = o; }
    LDS_WAIT(); asm volatile("" ::: "memory");
}
struct MapPlain { __device__ __forceinline__ int operator()(int c) const { return c; } };
struct MapIn {
    __device__ __forceinline__ int operator()(int c) const {
        if (c < 1024) { const int pn = c >> 8, hh = (c >> 6) & 3, d = c & 63; return 256 * pn + 128 * (d >> 5) + 32 * hh + (d & 31); }
        if (c < 3072) return c;
        if (c < 4096) { const int cc = c - 3072; return 3072 + 256 * (cc >> 7) + (cc & 127); }
        const int cc = c - 4096; return 3072 + 256 * (cc >> 7) + 128 + (cc & 127);
    }
};
struct MapGU { int up; __device__ __forceinline__ int operator()(int c) const { return 256 * (c >> 7) + 128 * up + (c & 127); } };

__device__ __forceinline__ void convert_moe_weights(Frame& F, int l, int gw, int NGW) {
    LAS unsigned char* scr = (LAS unsigned char*)(F.lds + F.wave * 16384);
    const float* g2 = KIN(14) + l * D;
    for (int it = gw; it < NE * 384; it += NGW) {
        const int e = it / 384, r = it % 384;
        if (r < 256) { const int up = r >> 7, q = r & 127, kb = q >> 3, nb = q & 7;
            const float* W = (up ? KIN(18) : KIN(17)) + ((size_t)l * NE + e) * (size_t)D * DFF;
            transpose_item8(W, DFF, (unsigned char*)(F.ws + WS_WGU_T) + (size_t)e * 1024 * 1024, 1024, g2, W8_SCALE, scr, kb, nb, F.lane, MapGU{up});
        } else { const int q = r - 256, kb = q >> 4, nb = q & 15;
            const float* W = KIN(19) + ((size_t)l * NE + e) * (size_t)DFF * D;
            transpose_item8(W, D, (unsigned char*)(F.ws + WS_WDN_T) + (size_t)e * 1024 * 512, 512, nullptr, W8_SCALE, scr, kb, nb, F.lane, MapPlain{});
        }
    }
}
__device__ __forceinline__ void convert_small_weights(Frame& F, int gw, int NGW) {
    LAS unsigned* scr = (LAS unsigned*)(F.lds + F.wave * 16384);
    for (int it = gw; it < 2 * 1792; it += NGW) {
        const int l = it / 1792; int r = it % 1792;
        if (r < 1280) { const int kb = r / 80, nb = r % 80;
            transpose_item(KIN(3) + (size_t)l * D * NIN, NIN, (bf16*)(F.ws + WS_WIN_T) + (size_t)l * NIN * D, D, KIN(2) + l * D, scr, kb, nb, F.lane, MapIn{}); continue; }
        r -= 1280;
        if (r < 128) { transpose_item(KIN(11) + (size_t)l * 512 * D, D, (bf16*)(F.ws + WS_WBD_T) + (size_t)l * D * 512, 512, nullptr, scr, r >> 4, r & 15, F.lane, MapPlain{}); continue; }
        r -= 128;
        if (r < 128) { transpose_item(KIN(12) + (size_t)l * 512 * D, D, (bf16*)(F.ws + WS_WBS_T) + (size_t)l * D * 512, 512, nullptr, scr, r >> 4, r & 15, F.lane, MapPlain{}); continue; }
        r -= 128;
        transpose_item(KIN(13) + (size_t)l * D * D, D, (bf16*)(F.ws + WS_WOUT_T) + (size_t)l * D * D, D, nullptr, scr, r >> 4, r & 15, F.lane, MapPlain{});
    }
    const int gt = (gw * 64 + F.lane), NT_ = NGW * 64;
    for (int i = gt; i < PMAX; i += NT_) ((int*)(F.ws + WS_IDENT))[i] = 2 * i;
    for (int idx = gt; idx < 2 * 48 * 1024; idx += NT_) {
        const int l = idx / (48 * 1024), r = idx % (48 * 1024), n = r >> 10, k = r & 1023; float v = 0.f;
        if (n < 32) v = KIN(16)[((size_t)l * D + k) * 32 + n]; else if (n < 36) v = KIN(15)[((size_t)l * D + k) * 4 + (n - 32)];
        v *= KIN(14)[l * D + k];
        ((bf16*)(F.ws + WS_WR_T))[idx] = (bf16)(cvt_pk_bf16(v, 0.f) & 0xffffu);
    }
}
template <bool INB, bool ADD, bool WX, bool WB>
__device__ __forceinline__ void rows_phase(Frame& F, const float* xin, float* xout, int m_first, int m_step, int m_end) {
    const unsigned char* C = (const unsigned char*)(F.ws + WS_CONTRIB); bf16* XB = (bf16*)(F.ws + WS_XB); float* rstd = (float*)(F.ws + WS_RSTD1);
    for (int m0 = m_first; m0 < m_end; m0 += m_step) {
        f32x4 v[2][4]; u32x2 xa[2][4]; unsigned ca[2][4], cb[2][4];
#pragma unroll
        for (int q = 0; q < 2; ++q) {
            if (INB) { const u32x2* xr = (const u32x2*)(XB + (size_t)(m0 + q) * D) + F.lane;
#pragma unroll
                for (int j = 0; j < 4; ++j) xa[q][j] = xr[64 * j]; }
            else { const f32x4* xr = (const f32x4*)(xin + (size_t)(m0 + q) * D) + F.lane;
#pragma unroll
                for (int j = 0; j < 4; ++j) v[q][j] = __builtin_nontemporal_load(xr + 64 * j); }
            if (ADD) { const unsigned* c0 = (const unsigned*)(C + (size_t)(2 * (m0 + q)) * D) + F.lane; const unsigned* c1 = (const unsigned*)(C + (size_t)(2 * (m0 + q) + 1) * D) + F.lane;
#pragma unroll
                for (int j = 0; j < 4; ++j) { ca[q][j] = c0[64 * j]; cb[q][j] = c1[64 * j]; } } }
#pragma unroll
        for (int q = 0; q < 2; ++q) { const int m = m0 + q;
            if (INB) {
#pragma unroll
                for (int j = 0; j < 4; ++j) { const u32x2 a = xa[q][j]; v[q][j] = (f32x4){bf_lo(a.x), bf_hi(a.x), bf_lo(a.y), bf_hi(a.y)}; } }
            if (ADD) {
#pragma unroll
                for (int j = 0; j < 4; ++j) { const int a = (int)ca[q][j], b = (int)cb[q][j];
                    const f32x2 a0 = __builtin_amdgcn_cvt_pk_f32_fp8(a, false), a1 = __builtin_amdgcn_cvt_pk_f32_fp8(a, true), b0 = __builtin_amdgcn_cvt_pk_f32_fp8(b, false), b1 = __builtin_amdgcn_cvt_pk_f32_fp8(b, true);
                    v[q][j][0] += (a0[0] + b0[0]) * (1.0f / C8_SCALE); v[q][j][1] += (a0[1] + b0[1]) * (1.0f / C8_SCALE); v[q][j][2] += (a1[0] + b1[0]) * (1.0f / C8_SCALE); v[q][j][3] += (a1[1] + b1[1]) * (1.0f / C8_SCALE); } }
            if (WX) { f32x4* xo = (f32x4*)(xout + (size_t)m * D) + F.lane;
#pragma unroll
                for (int j = 0; j < 4; ++j) __builtin_nontemporal_store(v[q][j], xo + 64 * j); }
            if (WB) {
                u32x2 w[4]; float s_ = 0.f;
#pragma unroll
                for (int j = 0; j < 4; ++j) { w[j].x = cvt_pk_bf16(v[q][j][0], v[q][j][1]); w[j].y = cvt_pk_bf16(v[q][j][2], v[q][j][3]);
                    const float r0 = bf_lo(w[j].x), r1 = bf_hi(w[j].x), r2 = bf_lo(w[j].y), r3 = bf_hi(w[j].y); s_ += (r0 * r0 + r1 * r1) + (r2 * r2 + r3 * r3); }
                s_ = wave_sum(s_);
                if (F.lane == 0) rstd[m] = 1.0f / sqrtf(s_ * (1.0f / D) + EPS);
                u32x2* o = (u32x2*)(XB + (size_t)m * D) + F.lane;
#pragma unroll
                for (int j = 0; j < 4; ++j) o[64 * j] = w[j];
            } }
    }
}

__device__ __forceinline__ void router_phase(Frame& F, int l) {
    const bf16* XB = (const bf16*)(F.ws + WS_XB); const bf16* WR = (const bf16*)(F.ws + WS_WR_T) + (size_t)l * 48 * 1024;
    int* ent_tok = (int*)(F.ws + WS_ENT_TOK); float* ent_w = (float*)(F.ws + WS_ENT_W); float* ent_rs = (float*)(F.ws + WS_ENT_RS);
    unsigned* gcnt = (unsigned*)(F.ctl + CW_CNT + 64 * l);
    LAS int* lcnt = (LAS int*)(F.lds + MOE_OFF) + 64; LAS int* lbase = lcnt + 32;
    const int fr = F.lane & 15, fq = F.lane >> 4;
    { LAS u32x4* wl = (LAS u32x4*)F.lds; u32x4 tmp[12];
#pragma unroll
        for (int j = 0; j < 12; ++j) { const int f = F.tid + 512 * j, ln = f & 63, kk = (f >> 6) & 31, nb = f >> 11; tmp[j] = *(const u32x4*)(WR + (size_t)(16 * nb + (ln & 15)) * D + 32 * kk + 8 * (ln >> 4)); }
#pragma unroll
        for (int j = 0; j < 12; ++j) wl[F.tid + 512 * j] = tmp[j];
    }
    __syncthreads();
    for (int chunk = F.vcu; chunk < T / 128; chunk += F.G) {
        if (F.tid < 32) lcnt[F.tid] = 0;
        __syncthreads();
        const int row = chunk * 128 + F.wave * 16 + fr;
        f32x4 a0 = {0.f, 0.f, 0.f, 0.f}, a1 = a0, a2 = a0; float ss = 0.f;
        const bf16* xp = XB + (size_t)row * D + 8 * fq; const LAS bf16x8* wl = (const LAS bf16x8*)F.lds + F.lane;
#pragma unroll
        for (int kb_ = 0; kb_ < 2; ++kb_) {
        u32x4 xa[16];
#pragma unroll
        for (int kk = 0; kk < 16; ++kk) xa[kk] = *(const u32x4*)(xp + 32 * (16 * kb_ + kk));
#pragma unroll
        for (int k_ = 0; k_ < 16; ++k_) { const int kk = 16 * kb_ + k_;
            { const u32x4 x_ = xa[k_]; float t0 = bf_lo(x_.x), t1 = bf_hi(x_.x), t2 = bf_lo(x_.y), t3 = bf_hi(x_.y), t4 = bf_lo(x_.z), t5 = bf_hi(x_.z), t6 = bf_lo(x_.w), t7 = bf_hi(x_.w);
              ss += (t0 * t0 + t1 * t1) + (t2 * t2 + t3 * t3) + (t4 * t4 + t5 * t5) + (t6 * t6 + t7 * t7); }
            const bf16x8 xf = __builtin_bit_cast(bf16x8, xa[k_]);
            a0 = __builtin_amdgcn_mfma_f32_16x16x32_bf16(wl[(0 * 32 + kk) * 64], xf, a0, 0, 0, 0);
            a1 = __builtin_amdgcn_mfma_f32_16x16x32_bf16(wl[(1 * 32 + kk) * 64], xf, a1, 0, 0, 0);
            a2 = __builtin_amdgcn_mfma_f32_16x16x32_bf16(wl[(2 * 32 + kk) * 64], xf, a2, 0, 0, 0);
            if ((k_ & 3) == 3) __builtin_amdgcn_sched_barrier(0);
        }
        asm volatile("" ::: "memory");
        }
        ss += __shfl_xor(ss, 16); ss += __shfl_xor(ss, 32);
        const float rstd = 1.0f / sqrtf(ss * (1.0f / D) + EPS);
        float gl[4];
#pragma unroll
        for (int j = 0; j < 4; ++j) gl[j] = __shfl(a2[j], fr) * rstd;
        int g = 0; float gm = gl[0];
#pragma unroll
        for (int j = 1; j < 4; ++j) if (gl[j] > gm) { gm = gl[j]; g = j; }
        float gs = 0.f;
#pragma unroll
        for (int j = 0; j < 4; ++j) gs += __expf(gl[j] - gm);
        const float pg = 1.0f / gs;
        f32x4 sel = (g >> 1) ? a1 : a0;
        float el[8];
#pragma unroll
        for (int i = 0; i < 8; ++i) { const int src = fr + 16 * (2 * (g & 1) + (i >> 2)); el[i] = __shfl(sel[i & 3], src) * rstd; }
        int i1 = 0; float m1 = el[0];
#pragma unroll
        for (int i = 1; i < 8; ++i) if (el[i] > m1) { m1 = el[i]; i1 = i; }
        int i2 = -1; float m2 = -3.0e38f;
#pragma unroll
        for (int i = 0; i < 8; ++i) if (i != i1 && el[i] > m2) { m2 = el[i]; i2 = i; }
        const float p2 = __expf(m2 - m1); const float w0 = pg / (1.f + p2), w1 = pg * p2 / (1.f + p2);
        const int e0 = 8 * g + i1, e1 = 8 * g + i2;
        int lp0 = 0, lp1 = 0;
        if (fq == 0) { lp0 = __hip_atomic_fetch_add(lcnt + e0, 1, __ATOMIC_RELAXED, __HIP_MEMORY_SCOPE_WORKGROUP); lp1 = __hip_atomic_fetch_add(lcnt + e1, 1, __ATOMIC_RELAXED, __HIP_MEMORY_SCOPE_WORKGROUP); }
        __syncthreads();
        if (F.tid < 32) lbase[F.tid] = (int)__hip_atomic_fetch_add(gcnt + F.tid, (unsigned)lcnt[F.tid], RLX_AGENT);
        __syncthreads();
        if (fq == 0) {
            const int s0 = e0 * ECAP + lbase[e0] + lp0, s1 = e1 * ECAP + lbase[e1] + lp1;
            ent_tok[s0] = 2 * row; ent_tok[s1] = 2 * row + 1; ent_w[s0] = w0; ent_w[s1] = w1; ent_rs[s0] = rstd; ent_rs[s1] = rstd;
        }
        __syncthreads();
    }
}
__device__ __forceinline__ void build_ust(Frame& F, int l) {
    LAS int* ust = (LAS int*)(F.lds + MOE_OFF); LAS int* cnt = ust + 64;
    if (F.tid < 32) cnt[F.tid] = (int)__hip_atomic_load((unsigned*)(F.ctl + CW_CNT + 64 * l) + F.tid, RLX_AGENT);
    __syncthreads();
    if (F.tid == 0) { int acc = 0;
        for (int e = 0; e < 32; ++e) { ust[e] = acc; acc += (cnt[e] + 255) >> 8; }
        ust[32] = acc; }
    __syncthreads();
}
__device__ __forceinline__ int crow(int r, int hi) { return (r & 3) + 8 * (r >> 2) + 4 * hi; }
__device__ __forceinline__ s16x4 vtr(const LAS unsigned char* p) { return __builtin_bit_cast(s16x4, __builtin_amdgcn_ds_read_tr16_b64_v4i16((LAS v4i16_t*)p)); }
__device__ __forceinline__ void glds(const void* g, LAS unsigned char* l) { __builtin_amdgcn_global_load_lds((const unsigned*)g, (LAS unsigned*)l, 16, 0, 0); }
#define PKV(lo, hi4) (bf16x8){lo[0], lo[1], lo[2], lo[3], hi4[0], hi4[1], hi4[2], hi4[3]}

__device__ __forceinline__ void pack_p(const f32x16& p0, const f32x16& p1, bf16x8 (&pa)[4]) {
    u32x4 w0, w1, w2, w3;
    w0.x = cvt_pk_bf16(p0[0], p0[1]); w0.y = cvt_pk_bf16(p0[2], p0[3]); w0.z = cvt_pk_bf16(p0[4], p0[5]); w0.w = cvt_pk_bf16(p0[6], p0[7]);
    w1.x = cvt_pk_bf16(p0[8], p0[9]); w1.y = cvt_pk_bf16(p0[10], p0[11]); w1.z = cvt_pk_bf16(p0[12], p0[13]); w1.w = cvt_pk_bf16(p0[14], p0[15]);
    w2.x = cvt_pk_bf16(p1[0], p1[1]); w2.y = cvt_pk_bf16(p1[2], p1[3]); w2.z = cvt_pk_bf16(p1[4], p1[5]); w2.w = cvt_pk_bf16(p1[6], p1[7]);
    w3.x = cvt_pk_bf16(p1[8], p1[9]); w3.y = cvt_pk_bf16(p1[10], p1[11]); w3.z = cvt_pk_bf16(p1[12], p1[13]); w3.w = cvt_pk_bf16(p1[14], p1[15]);
    pa[0] = __builtin_bit_cast(bf16x8, w0); pa[1] = __builtin_bit_cast(bf16x8, w1); pa[2] = __builtin_bit_cast(bf16x8, w2); pa[3] = __builtin_bit_cast(bf16x8, w3);
}
#define VTR_ASM(dst, addr, off) asm volatile("ds_read_b64_tr_b16 %0, %1 offset:%2" : "=v"(dst) : "v"(addr), "n"(off) : "memory")
#define VTR_WAIT(n, b) asm volatile("s_waitcnt lgkmcnt(" #n ")" : "+v"(lo[b][0]), "+v"(lo[b][1]), "+v"(lo[b][2]), "+v"(lo[b][3]), "+v"(hi4[b][0]), "+v"(hi4[b][1]), "+v"(hi4[b][2]), "+v"(hi4[b][3]) :: "memory")
template <int NDB>
__device__ __forceinline__ void pv_mma(f32x16 (&o)[NDB], const LAS unsigned char* vp, const bf16x8 (&pa)[4]) {
    s16x4 lo[2][4], hi4[2][4];
    const unsigned va = (unsigned)(size_t)vp;
#pragma unroll
    for (int ks = 0; ks < 4; ++ks) { VTR_ASM(lo[0][ks], va, ks * 1024); VTR_ASM(hi4[0][ks], va, ks * 1024 + 512); }
#pragma unroll
    for (int db = 0; db < NDB; ++db) {
        if (db + 1 < NDB) {
#pragma unroll
            for (int ks = 0; ks < 4; ++ks) { VTR_ASM(lo[(db + 1) & 1][ks], va, (db + 1) * 4096 + ks * 1024); VTR_ASM(hi4[(db + 1) & 1][ks], va, (db + 1) * 4096 + ks * 1024 + 512); }
            if (db & 1) VTR_WAIT(8, 1); else VTR_WAIT(8, 0);
        } else { if (db & 1) VTR_WAIT(0, 1); else VTR_WAIT(0, 0); }
        __builtin_amdgcn_sched_barrier(0);
#pragma unroll
        for (int ks = 0; ks < 4; ++ks) o[db] = __builtin_amdgcn_mfma_f32_32x32x16_bf16(pa[ks], PKV(lo[db & 1][ks], hi4[db & 1][ks]), o[db], 0, 0, 0);
        __builtin_amdgcn_sched_barrier(0);
    }
}
__device__ __forceinline__ void qk_mma(f32x16& p0, f32x16& p1, const LAS unsigned char* Kb, const LAS unsigned char* Qs, int lane, int r32, int hi) {
    const LAS unsigned char* kb = Kb + hi * 1024 + r32 * 16;
#pragma unroll
    for (int d0 = 0; d0 < 4; ++d0) {
        const bf16x8 b0 = *(const LAS bf16x8*)(kb + d0 * 2048), b1 = *(const LAS bf16x8*)(kb + d0 * 2048 + 512), q = *(const LAS bf16x8*)(Qs + d0 * 1024 + lane * 16);
        p0 = __builtin_amdgcn_mfma_f32_32x32x16_bf16(b0, q, p0, 0, 0, 0); p1 = __builtin_amdgcn_mfma_f32_32x32x16_bf16(b1, q, p1, 0, 0, 0);
    }
}

__device__ __forceinline__ void diff_epilogue(Frame& F, f32x16 (&o)[4], LAS float* xch, const float* subg, float lam_init, bf16* Ow);
template <int VAR>
__device__ __forceinline__ void diff_stream(f32x16 (&o)[4], float& l, const LAS unsigned char* Kb, const LAS unsigned char* Vb, const bf16x8 (&qr)[4], const LAS float* lut,
                                            bool near, float cfar, int qrow, int kmin, int lane, int r32, int hi) {
    f32x16 p0, p1; const float init = near ? 0.f : cfar;
#pragma unroll
    for (int r = 0; r < 16; ++r) { p0[r] = init; p1[r] = init; }
    const LAS unsigned char* kb = Kb + r32 * 128; const int sw = (r32 >> 1) & 7;
    bf16x8 kf[8];
#pragma unroll
    for (int d0 = 0; d0 < 4; ++d0) { const int so = (((2 * d0 + hi) ^ sw) << 4); kf[2 * d0] = *(const LAS bf16x8*)(kb + so); kf[2 * d0 + 1] = *(const LAS bf16x8*)(kb + 4096 + so); }
    __builtin_amdgcn_sched_barrier(0);
#pragma unroll
    for (int d0 = 0; d0 < 4; ++d0) { if (!(VAR & 4)) { p0 = __builtin_amdgcn_mfma_f32_32x32x16_bf16(kf[2 * d0], qr[d0], p0, 0, 0, 0); p1 = __builtin_amdgcn_mfma_f32_32x32x16_bf16(kf[2 * d0 + 1], qr[d0], p1, 0, 0, 0); }
        else { p0[d0] += __builtin_bit_cast(f32x4, kf[2 * d0])[0]; p1[d0] += __builtin_bit_cast(f32x4, kf[2 * d0 + 1])[0]; } }
    if (VAR & 1) { } else if (near) {
#pragma unroll
        for (int r = 0; r < 16; ++r) { const int d0 = qrow - (kmin + crow(r, hi)), d1 = d0 - 32;
            const float b0 = lut[min(max(d0, 0), 127)], b1 = lut[min(max(d1, 0), 127)];
            p0[r] = d0 < 0 ? 0.f : fexp2(p0[r] + b0); p1[r] = d1 < 0 ? 0.f : fexp2(p1[r] + b1); }
    } else {
#pragma unroll
        for (int r = 0; r < 16; ++r) { p0[r] = fexp2(p0[r]); p1[r] = fexp2(p1[r]); }
    }
    float s = 0.f;
#pragma unroll
    for (int r = 0; r < 16; ++r) s += p0[r] + p1[r];
    l += s;
    bf16x8 pa[4]; pack_p(p0, p1, pa);
    const LAS unsigned char* vp = Vb + ((lane >> 4) & 1) * 32 + (lane & 3) * 8 + (4 * hi + ((lane & 15) >> 2)) * 64;
    if (!(VAR & 2)) pv_mma<4>(o, vp, pa); else { o[0][0] += __builtin_bit_cast(f32x4, pa[0])[0] + __builtin_bit_cast(f32x4, pa[3])[1]; }
}

template <int VAR>
__device__ __forceinline__ void diff_unit(Frame& F, int b, int h, int qb, const float* subg, float lam, float lam_init, bf16* Odst) {
    const int lane = F.lane, r32 = lane & 31, hi = lane >> 5, wid = F.wave, js = wid >> 2, wq = wid & 3;
    bf16* DQ = (bf16*)(F.ws + WS_DQ); const bf16* DK = (const bf16*)(F.ws + WS_DK); const bf16* VA = (const bf16*)(F.ws + WS_VA);
    const long rowbase = (long)b * SEQ; const int q0 = qb * 128, qw = q0 + 32 * wq;
    LAS unsigned char* kv = F.lds;
    LAS float* wsf = (LAS float*)(F.lds + WSF_OFF) + wid * 64; const LAS float* lut = (const LAS float*)(F.lds + LUT_OFF) + h * 128;
    const int NT = (q0 + 128) / 64;
    const int krow_ = 8 * wid + (lane >> 3);
    const bf16* k1src = DK + (rowbase + krow_) * 512 + h * 128 + (((lane & 7) ^ ((krow_ >> 1) & 7)) * 8);
    const bf16* vsrc0 = VA + (rowbase + 16 * (wid & 3) + (lane >> 2)) * 512 + h * 128 + (wid >> 2) * 32 + (lane & 3) * 8;
#define DIFF_ISSUE(t, bufi) do { LAS unsigned char* bb_ = kv + (bufi) * 32768; const long ro_ = (long)(t) * 64 * 512; \
        glds(k1src + ro_, bb_ + wid * 1024); glds(k1src + ro_ + 64, bb_ + 8192 + wid * 1024); \
        glds(vsrc0 + ro_, bb_ + 16384 + wid * 1024); glds(vsrc0 + ro_ + 64, bb_ + 16384 + (wid + 8) * 1024); } while (0)
    bf16x8 qr[4];
#pragma unroll
    for (int d0 = 0; d0 < 4; ++d0) qr[d0] = *(const bf16x8*)(DQ + (rowbase + qw + r32) * 512 + h * 128 + js * 64 + d0 * 16 + hi * 8);
    asm volatile("" ::: "memory");
    if (!(VAR & 8)) { DIFF_ISSUE(0, 0);
    if (NT > 1) DIFF_ISSUE(1, 1); }
    f32x16 o[4];
#pragma unroll
    for (int i = 0; i < 4; ++i)
#pragma unroll
        for (int r = 0; r < 16; ++r) o[i][r] = 0.f;
    float l = 0.f;
    const float cfar = lut[127];
    if (NT > 1) asm volatile("s_waitcnt vmcnt(4)" ::: "memory"); else asm volatile("s_waitcnt vmcnt(0)" ::: "memory");
    __builtin_amdgcn_s_barrier(); asm volatile("" ::: "memory");
    int sc_ = 0, sn2 = 2;
    for (int t = 0; t < NT; ++t) {
        if (!(VAR & 8)) { if (t + 2 < NT) DIFF_ISSUE(t + 2, sn2); }
        const int kmin = 64 * t;
        if (kmin <= qw + 31) {
            const bool near = (qw - (kmin + 63)) < 113;
            const LAS unsigned char* bb = kv + sc_ * 32768;
            diff_stream<VAR>(o, l, bb + js * 8192, bb + 16384, qr, lut, near, cfar, qw + r32, kmin, lane, r32, hi);
        }
        if (t + 2 < NT) asm volatile("s_waitcnt vmcnt(4) lgkmcnt(0)" ::: "memory"); else asm volatile("s_waitcnt vmcnt(0) lgkmcnt(0)" ::: "memory");
        if (!(VAR & 16)) __builtin_amdgcn_s_barrier(); asm volatile("" ::: "memory");
        sn2 = sc_; sc_ = (sc_ == 2) ? 0 : sc_ + 1;
    }
#undef DIFF_ISSUE
    l += __shfl_xor(l, 32);
    if (hi == 0) wsf[r32] = l;
    LDS_WAIT();
    const float sc = js ? lam : 1.0f;
#pragma unroll
    for (int r = 0; r < 16; ++r) { const float rl = sc * __builtin_amdgcn_rcpf(wsf[crow(r, hi)]);
#pragma unroll
        for (int db = 0; db < 4; ++db) o[db][r] *= rl; }
    LAS float* xch = (LAS float*)(F.lds + wq * 16384);
    if (js) {
#pragma unroll
        for (int db = 0; db < 4; ++db)
#pragma unroll
            for (int r = 0; r < 16; ++r) xch[(db * 16 + r) * 64 + lane] = o[db][r];
    }
    asm volatile("s_waitcnt lgkmcnt(0)" ::: "memory"); __syncthreads();
    if (!js && !(VAR & 32)) diff_epilogue(F, o, xch, subg, lam_init, Odst + (rowbase + qw) * 512 + h * 128);
    asm volatile("s_waitcnt lgkmcnt(0)" ::: "memory"); __syncthreads();
}
__device__ __forceinline__ void diff_epilogue(Frame& F, f32x16 (&o)[4], LAS float* xch, const float* subg, float lam_init, bf16* Ow) {
    int lane = F.lane; asm volatile("" : "+v"(lane));
    const int r32 = lane & 31, hi = lane >> 5;
    float ssq[16];
#pragma unroll
    for (int r = 0; r < 16; ++r) { float s = 0.f;
#pragma unroll
        for (int db = 0; db < 4; ++db) { const float v = o[db][r] - xch[(db * 16 + r) * 64 + lane]; o[db][r] = v; s += v * v; }
        ssq[r] = s; }
#pragma unroll
    for (int r = 0; r < 16; ++r) { float s = ssq[r]; s += __shfl_xor(s, 1); s += __shfl_xor(s, 2); s += __shfl_xor(s, 4); s += __shfl_xor(s, 8); s += __shfl_xor(s, 16);
        ssq[r] = (1.0f - lam_init) * __builtin_amdgcn_rsqf(s * (1.0f / 128.0f) + EPS); }
    float sg[4];
#pragma unroll
    for (int db = 0; db < 4; ++db) sg[db] = subg[32 * db + r32];
    LDS_WAIT();
    LAS bf16* stl = (LAS bf16*)xch;
#pragma unroll
    for (int r = 0; r < 16; ++r) { const int orow = crow(r, hi);
#pragma unroll
        for (int db = 0; db < 4; ++db) stl[orow * 128 + db * 32 + r32] = (bf16)(cvt_pk_bf16(o[db][r] * ssq[r] * sg[db], 0.f) & 0xffffu); }
    LDS_WAIT();
#pragma unroll
    for (int i = 0; i < 8; ++i) { const int row = i * 4 + (lane >> 4), ch = lane & 15; const u32x4 v = *(const LAS u32x4*)(stl + row * 128 + ch * 8); *(u32x4*)(Ow + (long)row * 512 + ch * 8) = v; }
}

template <bool M>
__device__ __forceinline__ bool sb_tile(f32x16 (&o)[2], float& carry, const bf16x8 (&qr)[4], const LAS unsigned char* kp, int ksw, const LAS unsigned char* vp, int hi, int lane, int qrow, int t,
                                        const bf16* ksrc, const bf16* vsrc, LAS unsigned char* kb_, LAS unsigned char* vb_) {
#define SB_ISSUE_K(t_) do { _Pragma("unroll") for (int c = 0; c < 8; ++c) { const int kr_ = 8 * c + (lane >> 3); glds(ksrc + (long)(64 * (t_) + 8 * c) * 512 + (((lane & 7) ^ ((kr_ >> 1) & 7)) * 8), kb_ + c * 1024); } } while (0)
#define SB_ISSUE_V(t_) do { _Pragma("unroll") for (int p = 0; p < 8; ++p) glds(vsrc + (long)(64 * (t_) + 16 * (p & 3)) * 512 + (p >> 2) * 32, vb_ + p * 1024); } while (0)
    {
        const int kmin = 64 * t;
        asm volatile("s_waitcnt vmcnt(8)" ::: "memory");
        bf16x8 kf[8];
#pragma unroll
        for (int d0 = 0; d0 < 4; ++d0) { const int so = (((2 * d0 + hi) ^ ksw) << 4); kf[2 * d0] = *(const LAS bf16x8*)(kp + so); kf[2 * d0 + 1] = *(const LAS bf16x8*)(kp + 4096 + so); }
        asm volatile("s_waitcnt lgkmcnt(0)" ::: "memory");
        if (t > 0) SB_ISSUE_K(t - 1);
        f32x16 p0, p1;
#pragma unroll
        for (int r = 0; r < 16; ++r) { p0[r] = 0.f; p1[r] = 0.f; }
#pragma unroll
        for (int d0 = 0; d0 < 4; ++d0) { p0 = __builtin_amdgcn_mfma_f32_32x32x16_bf16(kf[2 * d0], qr[d0], p0, 0, 0, 0); p1 = __builtin_amdgcn_mfma_f32_32x32x16_bf16(kf[2 * d0 + 1], qr[d0], p1, 0, 0, 0); }
        float Lb[8][4], T_own[8], T_oth[8];
#pragma unroll
        for (int i = 0; i < 8; ++i) {
#pragma unroll
            for (int e = 0; e < 4; ++e) { const float y = (i < 4) ? p0[4 * i + e] : p1[4 * (i - 4) + e]; const int key = kmin + 8 * i + 4 * hi + e;
                const float sp = fmaxf(y, 0.f) + flog2(1.f + fexp2(-fabsf(y)));
                Lb[i][e] = (!M || key < qrow) ? sp : 0.f; }
            T_own[i] = (Lb[i][0] + Lb[i][1]) + (Lb[i][2] + Lb[i][3]);
        }
#pragma unroll
        for (int i = 0; i < 8; ++i) T_oth[i] = __shfl_xor(T_own[i], 32);
        float after = carry;
#pragma unroll
        for (int i = 7; i >= 0; --i) {
            const float off = after + (hi == 0 ? T_oth[i] : 0.f);
            after += T_own[i] + T_oth[i];
            float suf = off;
#pragma unroll
            for (int e = 3; e >= 0; --e) { const float y = (i < 4) ? p0[4 * i + e] : p1[4 * (i - 4) + e]; const int key = kmin + 8 * i + 4 * hi + e;
                const float a = (!M || key < qrow) ? fexp2(y - Lb[i][e] - suf) : 0.f; suf += Lb[i][e];
                if (i < 4) p0[4 * i + e] = a; else p1[4 * (i - 4) + e] = a; }
        }
        carry = after;
        bf16x8 pa[4]; pack_p(p0, p1, pa);
        if (t > 0) asm volatile("s_waitcnt vmcnt(8)" ::: "memory"); else asm volatile("s_waitcnt vmcnt(0)" ::: "memory");
        pv_mma<2>(o, vp, pa);
        asm volatile("s_waitcnt lgkmcnt(0)" ::: "memory");
#if SB_EARLY_EXIT
        if (__all(carry > SB_EXIT_LOG2)) return true;
#endif
        if (t > 0) SB_ISSUE_V(t - 1);
        return false;
    }
#undef SB_ISSUE_K
#undef SB_ISSUE_V
}

__device__ __forceinline__ void sb_unit(Frame& F, int b, int h, int blk) {
    const int lane = F.lane, r32 = lane & 31, hi = lane >> 5, wid = F.wave;
    bf16* SBQ = (bf16*)(F.ws + WS_SBQ); const bf16* SBK = (const bf16*)(F.ws + WS_SBK); const bf16* SBV = (const bf16*)(F.ws + WS_SBV);
    const long rowbase = (long)b * SEQ; const int qw = 32 * blk; const int qrow = qw + r32;
    LAS unsigned char* kb_ = F.lds + wid * 16384; LAS unsigned char* vb_ = kb_ + 8192;
    bf16x8 qr[4];
#pragma unroll
    for (int d0 = 0; d0 < 4; ++d0) qr[d0] = *(const bf16x8*)(SBQ + (rowbase + qrow) * 512 + h * 64 + d0 * 16 + hi * 8);
    f32x16 o[2];
#pragma unroll
    for (int i = 0; i < 2; ++i)
#pragma unroll
        for (int r = 0; r < 16; ++r) o[i][r] = 0.f;
    float carry = 0.f;
    const bf16* ksrc = SBK + (rowbase + (lane >> 3)) * 512 + h * 64;
    const bf16* vsrc = SBV + (rowbase + (lane >> 2)) * 512 + h * 64 + (lane & 3) * 8;
    const LAS unsigned char* kp = kb_ + r32 * 128; const int ksw = (r32 >> 1) & 7;
    const LAS unsigned char* vp = vb_ + ((lane >> 4) & 1) * 32 + (lane & 3) * 8 + (4 * hi + ((lane & 15) >> 2)) * 64;
#define SB_ISSUE_K(t_) do { _Pragma("unroll") for (int c = 0; c < 8; ++c) { const int kr_ = 8 * c + (lane >> 3); glds(ksrc + (long)(64 * (t_) + 8 * c) * 512 + (((lane & 7) ^ ((kr_ >> 1) & 7)) * 8), kb_ + c * 1024); } } while (0)
#define SB_ISSUE_V(t_) do { _Pragma("unroll") for (int p = 0; p < 8; ++p) glds(vsrc + (long)(64 * (t_) + 16 * (p & 3)) * 512 + (p >> 2) * 32, vb_ + p * 1024); } while (0)
    const int t0 = qw >> 6;
    asm volatile("s_waitcnt lgkmcnt(0)" ::: "memory");
    SB_ISSUE_K(t0); SB_ISSUE_V(t0);
    if (!sb_tile<true>(o, carry, qr, kp, ksw, vp, hi, lane, qrow, t0, ksrc, vsrc, kb_, vb_))
        for (int t = t0 - 1; t >= 0; --t) if (sb_tile<false>(o, carry, qr, kp, ksw, vp, hi, lane, qrow, t, ksrc, vsrc, kb_, vb_)) break;
#undef SB_ISSUE_K
#undef SB_ISSUE_V
    asm volatile("s_waitcnt vmcnt(0) lgkmcnt(0)" ::: "memory");
    LAS bf16* stl = (LAS bf16*)kb_;
#pragma unroll
    for (int r = 0; r < 16; ++r) { const int orow = crow(r, hi);
#pragma unroll
        for (int db = 0; db < 2; ++db) stl[orow * 64 + db * 32 + r32] = (bf16)(cvt_pk_bf16(o[db][r], 0.f) & 0xffffu); }
    LDS_WAIT();
    bf16* Ow = SBQ + (rowbase + qw) * 512 + h * 64;
#pragma unroll
    for (int i = 0; i < 4; ++i) { const int row = i * 8 + (lane >> 3), ch = lane & 7; const u32x4 v = *(const LAS u32x4*)(stl + row * 64 + ch * 8); *(u32x4*)(Ow + (long)row * 512 + ch * 8) = v; }
    asm volatile("s_waitcnt lgkmcnt(0)" ::: "memory");
}

__device__ __forceinline__ int t5_bucket(int n) {
    if (n < 16) return n;
    int b = 16;
    const int thr[15] = {19, 21, 24, 27, 31, 35, 40, 46, 52, 59, 67, 77, 87, 99, 113};
#pragma unroll
    for (int j = 0; j < 15; ++j) b += (n >= thr[j]) ? 1 : 0;
    return b;
}

__device__ __forceinline__ void attention_phase(Frame& F, int l) {
    const float* relb = KIN(1); const float* gq = KIN(4) + l * 64; const float* gk = KIN(5) + l * 64;
    LAS float* scal = (LAS float*)(F.lds + WSF_OFF);
    if (F.wave == 0) { const int d = F.lane;
        float a1 = KIN(6)[l * 64 + d] * KIN(7)[l * 64 + d], a2 = KIN(8)[l * 64 + d] * KIN(9)[l * 64 + d], mq = fabsf(gq[d]), mk = fabsf(gk[d]);
        a1 = wave_sum(a1); a2 = wave_sum(a2);
#pragma unroll
        for (int o = 1; o < 64; o <<= 1) { mq = fmaxf(mq, __shfl_xor(mq, o)); mk = fmaxf(mk, __shfl_xor(mk, o)); }
        if (d == 0) { scal[0] = a1; scal[1] = a2; scal[2] = mq; scal[3] = mk; } }
    if (F.tid >= 64 && F.tid < 192) scal[16 + F.tid - 64] = relb[F.tid - 64];
    __syncthreads();
    const float s1 = scal[0], s2 = scal[1], gqm = scal[2], gkm = scal[3];
    const float lam_init = 0.8f - 0.6f * expf(-0.3f * (float)l);
    const float lam = expf(s1) - expf(s2) + lam_init;
    float lutv;
    {
        const int h = F.tid >> 7, d = F.tid & 127; float mb = -3.0e38f;
        for (int bkt = 0; bkt < 32; ++bkt) mb = fmaxf(mb, scal[16 + bkt * 4 + h]);
        const float M = 8.f * gqm * gkm + mb;
        lutv = (scal[16 + t5_bucket(d) * 4 + h] - M) * LOG2E;
    }
    __syncthreads();
    ((LAS float*)(F.lds + LUT_OFF))[F.tid] = lutv;
    __syncthreads();
    const float* subg = KIN(10) + l * 128;
#ifndef ATT_MASK
#define ATT_MASK 3
#endif
#ifndef DIFF_VARIANT
#define DIFF_VARIANT -1
#endif
    if (DIFF_VARIANT >= 0) { for (int i = 0;; ++i) { const long L = (long)i * F.G + F.vcu; if (L >= 1024) break;
        const int Lm = (int)(L & 255), bh = Lm >> 3, s = Lm & 7, k = (int)(L >> 8), qb = (k == 0) ? 31 - s : (k == 1) ? 16 + s : (k == 2) ? 15 - s : s;
        diff_unit<(DIFF_VARIANT >= 0 ? DIFF_VARIANT : 0)>(F, bh >> 2, bh & 3, qb, subg, lam, lam_init, (bf16*)(F.ws + WS_XB)); }
        __syncthreads(); }
    PB_START(10);
    const int vcu = F.vcu;
    if (ATT_MASK & 1) for (int i = 0;; ++i) { const long L = (long)i * F.G + vcu; if (L >= 1024) break;
        const int Lm = (int)(L & 255), bh = Lm >> 3, s = Lm & 7, k = (int)(L >> 8), qb = (k == 0) ? 31 - s : (k == 1) ? 16 + s : (k == 2) ? 15 - s : s;
        diff_unit<0>(F, bh >> 2, bh & 3, qb, subg, lam, lam_init, (bf16*)(F.ws + WS_DQ)); }
    __syncthreads();
    PB_END(10);
    PB_START(11);
    const int gw = F.vcu * NWAVES + F.wave, NGW = F.G * NWAVES;
    if (ATT_MASK & 2) for (int i = 0;; ++i) { int bh, x;
        if (F.G == 256) { const int xg = F.vcu >> 5, lw = (F.vcu & 31) * NWAVES + F.wave, pp = (i >> 1) * 256 + lw; if (pp >= 512) break; bh = 8 * xg + (pp >> 6); x = pp & 63; }
        else { const long p = (long)(i >> 1) * NGW + gw; if (p >= 4096) break; bh = (int)(p >> 6); x = (int)(p & 63); }
        const int blk = (i & 1) ? 127 - x : x;
        sb_unit(F, bh >> 3, bh & 7, blk); }
    __syncthreads();
    PB_END(11);
}

constexpr int NPHASE = 1 + 8 * DEPTH;
__global__ void __launch_bounds__(NWAVES * 64, 2) mk_fwd(Args args) {
    extern __shared__ __attribute__((aligned(16))) unsigned char lds_raw[];
    Frame F;
    F.lds = (LAS unsigned char*)lds_raw;
    F.MISC = (volatile LAS unsigned*)(F.lds + MISC_OFF);
    F.tid = threadIdx.x; F.lane = F.tid & 63; F.wave = __builtin_amdgcn_readfirstlane(F.tid >> 6); F.G = gridDim.x;
    F.ws = args.ws; F.ctl = (gu32*)(args.ws + WS_CTL); F.out = args.out;
    for (int u = F.tid; u < (LDS_BYTES - LDSCTL_OFF) / 4; u += NWAVES * 64) ((LAS unsigned*)(F.lds + LDSCTL_OFF))[u] = 0u;
    __syncthreads();
    const unsigned my_xcc = xb_xcc_id(); unsigned my_rank = 0;
    if (F.tid == 0) my_rank = __hip_atomic_fetch_add((unsigned*)(F.ctl + CW_XRANK) + my_xcc, 1u, RLX_AGENT);
    my_rank = (unsigned)__builtin_amdgcn_readfirstlane((int)my_rank);
    if (F.tid == 0) ((volatile LAS unsigned*)(F.lds + MISC_OFF))[12] = my_rank;
    __syncthreads();
    my_rank = ((volatile LAS unsigned*)(F.lds + MISC_OFF))[12];
    F.vcu = (int)blockIdx.x; F.cx = (int)blockIdx.x; F.local_ok = 0;
    XcdBarrier bar; bar.bar = (unsigned*)(F.ctl + CW_BAR); bar.x = 0; bar.st = nullptr;
    if (!MK_SPLIT) bar = xcd_barrier_post((unsigned*)(F.ctl + CW_BAR), F.MISC + 8);
    F.pb_t0 = 0; F.pb_acc = 0;
    const int lo = args.ph_lo, hi = args.ph_hi;
#define IN(k) (lo <= (k) && (k) < hi)
#define SEAM(k) do { if (IN(k) && IN((k) + 1)) xcd_barrier(bar); } while (0)
#define SEAM_L(k) do { if (IN(k) && IN((k) + 1)) { if (F.local_ok) xcc_barrier((unsigned*)(F.ctl + CW_LBAR), my_xcc, (unsigned)F.G / 8u, (unsigned*)(F.ctl + CW_BAR) + XB_TMO); else xcd_barrier(bar); } } while (0)
#define REFRESH() int gw, NGW, c; do { int t_ = threadIdx.x; asm volatile("" : "+v"(t_)); F.tid = t_; F.lane = t_ & 63; F.wave = __builtin_amdgcn_readfirstlane(t_ >> 6); \
        gw = F.vcu * NWAVES + F.wave; NGW = F.G * NWAVES; c = F.cx; (void)gw; (void)NGW; (void)c; } while (0)

    PB_START(0);
    if (PH_ON(0) && IN(0)) { REFRESH();
        convert_small_weights(F, gw, NGW);
        convert_moe_weights(F, 0, gw, NGW);
        rows_phase<false, false, false, true>(F, KIN(0), nullptr, 2 * gw, 2 * NGW, T);
    }
    SEAM(0);
    PB_END(0);
    if (!MK_SPLIT) {
        LAS unsigned* xc = (LAS unsigned*)(F.lds + WSF_OFF);
        if (F.tid < 16) xc[F.tid] = __hip_atomic_load((unsigned*)(F.ctl + CW_XRANK) + F.tid, RLX_AGENT);
        __syncthreads();
        unsigned pre = 0, tot = 0, uni = 1u;
#pragma unroll
        for (unsigned j = 0; j < 16; ++j) { const unsigned cj = xc[j]; pre += (j < my_xcc) ? cj : 0u; tot += cj; uni &= (cj == 0u || cj * 8u == (unsigned)F.G) ? 1u : 0u; }
        F.local_ok = (uni && tot == (unsigned)F.G && F.G == 256) ? 1 : 0;
        if (tot == (unsigned)F.G) { F.vcu = (int)(pre + my_rank); const int per = F.G / 8; F.cx = (F.G % 8 == 0) ? (F.vcu % per) * 8 + F.vcu / per : F.vcu; }
        __syncthreads(); }
#pragma nounroll
    for (int l = 0; l < DEPTH; ++l) {
        const int pb = 1 + 8 * l;
        PB_START(1);
        if (PH_ON(1) && IN(pb + 0)) {   REFRESH();
            SchedPlain S{(const char*)(F.ws + WS_XB), (const char*)(F.ws + WS_WIN_T) + (size_t)l * NIN * D * 2, 128, 20, D, F.G, c, (const int*)(F.ws + WS_RSTD1), nullptr};
            LAS float* gl = (LAS float*)(F.lds + LUT_OFF);
            if (F.tid < 128) gl[F.tid] = (F.tid < 64) ? KIN(4)[l * 64 + F.tid] * C2 : KIN(5)[l * 64 + F.tid - 64];
            __syncthreads();
            EpiInProj E{F.ws, gl, (const LAS float*)(F.lds + AUX_OFF)};
            pg8::gemm_phase<EpiInProj, SchedPlain>(F.lds, D, S, E);
        }
        SEAM_L(pb + 0);
        PB_END(1);
        PB_START(2);
        if (PH_ON(2) && IN(pb + 1)) { REFRESH(); attention_phase(F, l); }
        SEAM_L(pb + 1);
        PB_END(2);
        PB_START(3);
        if (PH_ON(3) && IN(pb + 2)) {   REFRESH();
            SchedBranch S{(const char*)(F.ws + WS_DQ), (const char*)(F.ws + WS_SBQ), (const char*)(F.ws + WS_WBD_T) + (size_t)l * D * 512 * 2, (const char*)(F.ws + WS_WBS_T) + (size_t)l * D * 512 * 2, F.G, c};
            EpiBranch E{(const unsigned char*)(F.ws + WS_G1), (bf16*)(F.ws + WS_MIXED)};
            pg8::gemm_phase<EpiBranch, SchedBranch>(F.lds, 512, S, E);
        }
        SEAM_L(pb + 2);
        PB_END(3);
        PB_START(4);
        if (PH_ON(4) && IN(pb + 3)) {   REFRESH();
            SchedPlain S{(const char*)(F.ws + WS_MIXED), (const char*)(F.ws + WS_WOUT_T) + (size_t)l * D * D * 2, 128, 4, D, F.G, c};
            EpiOutProj E{(bf16*)(F.ws + WS_XB), (unsigned char*)(F.ws + WS_XB8)};
            pg8::gemm_phase<EpiOutProj, SchedPlain>(F.lds, D, S, E);
        }
        SEAM_L(pb + 3);
        PB_END(4);
        PB_START(5);
        if (PH_ON(5) && IN(pb + 4)) { REFRESH(); router_phase(F, l); }
        SEAM(pb + 4);
        PB_END(5);
        PB_START(7);
        if (PH_ON(7) && IN(pb + 5)) {   REFRESH();
            build_ust(F, l);
            SchedMoe<true> S{(const char*)(F.ws + WS_XB8), (const char*)(F.ws + WS_WGU_T), (const LAS int*)(F.lds + MOE_OFF), (const int*)(F.ws + WS_ENT_TOK), (const int*)(F.ws + WS_ENT_RS), nullptr, D / 2, (size_t)1024 * 1024, F.G, c};
            EpiMoe1 E{(const LAS float*)(F.lds + AUX_OFF), (unsigned char*)(F.ws + WS_ACT)};
            pg8::gemm_phase<EpiMoe1, SchedMoe<true>>(F.lds, D / 2, S, E);
        }
        SEAM_L(pb + 5);
        PB_END(7);
        PB_START(8);
        if (PH_ON(8) && IN(pb + 6)) {   REFRESH();
            build_ust(F, l);
            SchedMoe<false> S{(const char*)(F.ws + WS_ACT), (const char*)(F.ws + WS_WDN_T), (const LAS int*)(F.lds + MOE_OFF), (const int*)(F.ws + WS_IDENT), (const int*)(F.ws + WS_ENT_TOK), (const int*)(F.ws + WS_ENT_W), DFF / 2, (size_t)1024 * 512, F.G, c};
            EpiMoe2 E{(const LAS int*)(F.lds + AUX_OFF), (unsigned char*)(F.ws + WS_CONTRIB)};
            pg8::gemm_phase<EpiMoe2, SchedMoe<false>>(F.lds, DFF / 2, S, E);
        }
        SEAM(pb + 6);
        PB_END(8);
        PB_START(9);
        if (PH_ON(9) && IN(pb + 7)) {   REFRESH();
            const int per = F.G / 8, xg = F.vcu / per, lw = (F.vcu % per) * NWAVES + F.wave; const bool al = (F.G == 256);
            const int mf = al ? 4096 * xg + 2 * lw : 2 * gw, ms = al ? 512 : 2 * NGW, me = al ? 4096 * xg + 4096 : T;
            if (l + 1 < DEPTH) { rows_phase<true, true, false, true>(F, nullptr, nullptr, mf, ms, me); convert_moe_weights(F, l + 1, gw, NGW); }
            else rows_phase<true, true, true, false>(F, nullptr, F.out, mf, ms, me);
        }
        if (l + 1 < DEPTH) SEAM_L(pb + 7);
        PB_END(9);
    }
    if (PROBE_TYPE >= 0 && blockIdx.x == 0 && threadIdx.x == 0) { const unsigned long long te = __builtin_amdgcn_s_memrealtime();
        while (__builtin_amdgcn_s_memrealtime() - te < PROBE_AMP * F.pb_acc) __builtin_amdgcn_s_sleep(8); }
#undef IN
#undef SEAM
}

extern "C" void kernel_launch(void* const* d_in, const int* in_sizes, int n_in, void* d_out, int out_size, void* d_ws, size_t ws_size, hipStream_t stream) {
    static int grid = 0;
    if (grid == 0) {
        if (n_in != 20 || in_sizes[0] != T * D || out_size != T * D || ws_size < WS_END) { fprintf(stderr, "kernel_launch: unexpected shapes / workspace (n_in %d, ws %zu, need %zu)\n", n_in, ws_size, (size_t)WS_END); grid = -1; return; }
        int dev = 0, cus = 0, per_cu = 0;
        if (hipGetDevice(&dev) != hipSuccess || hipDeviceGetAttribute(&cus, hipDeviceAttributeMultiprocessorCount, dev) != hipSuccess) { grid = -1; return; }
        if (hipFuncSetAttribute((const void*)mk_fwd, hipFuncAttributeMaxDynamicSharedMemorySize, LDS_BYTES) != hipSuccess) { fprintf(stderr, "kernel_launch: hipFuncSetAttribute failed\n"); grid = -1; return; }
        if (hipOccupancyMaxActiveBlocksPerMultiprocessor(&per_cu, (const void*)mk_fwd, NWAVES * 64, LDS_BYTES) != hipSuccess || per_cu < 1) fprintf(stderr, "kernel_launch: occupancy query reports %d\n", per_cu);
        (void)hipGetLastError();
        grid = cus;
    }
    if (grid < 0) return;
    if (hipMemsetAsync((char*)d_ws + WS_CTL, 0, CTL_ZERO_BYTES, stream) != hipSuccess) return;
    Args a{};
    for (int i = 0; i < 20; ++i) a.in[i] = (const float*)d_in[i];
    a.out = (float*)d_out; a.ws = (unsigned char*)d_ws;
#if MK_SPLIT
    for (int p = 0; p < NPHASE; ++p) { a.ph_lo = p; a.ph_hi = p + 1; hipLaunchKernelGGL(mk_fwd, dim3(grid), dim3(NWAVES * 64), LDS_BYTES, stream, a); }
#else
    a.ph_lo = 0; a.ph_hi = NPHASE;
    hipLaunchKernelGGL(mk_fwd, dim3(grid), dim3(NWAVES * 64), LDS_BYTES, stream, a);
#endif
}
```

```cpp
#include <hip/hip_runtime.h>
#include <cstdio>
#include <cstdint>

#define GAS __attribute__((address_space(1)))
#define LAS __attribute__((address_space(3)))
typedef unsigned short bf16;
typedef short bf16x8 __attribute__((ext_vector_type(8)));
typedef short s16x4 __attribute__((ext_vector_type(4)));
typedef short v4i16_t __attribute__((ext_vector_type(4)));
typedef float f32x2 __attribute__((ext_vector_type(2)));
typedef float f32x4 __attribute__((ext_vector_type(4)));
typedef float f32x16 __attribute__((ext_vector_type(16)));
typedef unsigned u32x2 __attribute__((ext_vector_type(2)));
typedef unsigned u32x4 __attribute__((ext_vector_type(4)));
typedef int v4i_t __attribute__((ext_vector_type(4)));
typedef GAS unsigned gu32;

constexpr int T = 32768, SEQ = 4096, NB = 8, D = 1024, NIN = 5120, DEPTH = 2;
constexpr int NE = 32, DFF = 512;
constexpr float EPS = 1e-6f;
constexpr float LOG2E = 1.4426950408889634f;
constexpr float C2 = 0.125f * LOG2E;
constexpr int NWAVES = 8;
#ifndef SB_EARLY_EXIT
#define SB_EARLY_EXIT 1
#endif
#define SB_EXIT_LOG2 64.f
#ifndef MK_SPLIT
#define MK_SPLIT 0
#endif
#ifndef PH_MASK
#define PH_MASK 0x3ff
#endif
#define PH_ON(k) (((PH_MASK) >> (k)) & 1)
#ifndef PROBE_TYPE
#define PROBE_TYPE -1
#endif
#define PROBE_AMP 8
#define PB_START(k) do { if (PROBE_TYPE == (k)) F.pb_t0 = __builtin_amdgcn_s_memrealtime(); } while (0)
#define PB_END(k) do { if (PROBE_TYPE == (k)) F.pb_acc += __builtin_amdgcn_s_memrealtime() - F.pb_t0; } while (0)

constexpr size_t MiB = 1u << 20;
constexpr size_t WS_CTL = 0, CTL_ZERO_BYTES = 1 * MiB;
constexpr size_t WS_RSTD1 = 1 * MiB;
constexpr size_t WS_IDENT = 2 * MiB;
constexpr size_t WS_WR_T = 5 * MiB;
constexpr size_t WS_WIN_T = 8 * MiB;
constexpr size_t WS_WBD_T = 28 * MiB;
constexpr size_t WS_WBS_T = 30 * MiB;
constexpr size_t WS_WOUT_T = 32 * MiB;
constexpr size_t WS_WGU_T = 36 * MiB;
constexpr size_t WS_WDN_T = 100 * MiB;
constexpr size_t WS_XB = 132 * MiB;
constexpr size_t WS_R0 = 196 * MiB;
constexpr size_t WS_DQ = WS_R0;
constexpr size_t WS_DK = WS_R0 + 32 * MiB;
constexpr size_t WS_VA = WS_R0 + 64 * MiB;
constexpr size_t WS_SBQ = WS_R0 + 96 * MiB;
constexpr size_t WS_SBK = WS_R0 + 128 * MiB;
constexpr size_t WS_SBV = WS_R0 + 160 * MiB;
constexpr size_t WS_G1 = WS_R0 + 192 * MiB;
constexpr size_t WS_MIXED = WS_G1;
constexpr int PMAX = 65536 + 32 * 256;
constexpr size_t WS_ACT = WS_SBK;
constexpr size_t WS_XB8 = WS_DK;
constexpr float W8_SCALE = 64.f, A8_SCALE = 2.f, C8_SCALE = 32.f;
constexpr size_t WS_CONTRIB = WS_G1;
constexpr int ECAP = 32768;
constexpr size_t WS_ENT_TOK = 68 * MiB;
constexpr size_t WS_ENT_W = 72 * MiB;
constexpr size_t WS_ENT_RS = 76 * MiB;
constexpr size_t WS_END = WS_R0 + 256 * MiB;

constexpr int CW_BAR = 4096;
constexpr int CW_LBAR = 20480;
constexpr int CW_XRANK = 12288;
constexpr int CW_CNT = 16384;

constexpr int RING_BYTES = 131072;
constexpr int LDSCTL_OFF = RING_BYTES, MISC_OFF = LDSCTL_OFF + 320;
constexpr int LUT_OFF = LDSCTL_OFF + 512;
constexpr int WSF_OFF = LDSCTL_OFF + 2560;
constexpr int MOE_OFF = LDSCTL_OFF + 4608;
constexpr int AUX_OFF = LDSCTL_OFF + 7680;
constexpr int IDT_OFF = LDSCTL_OFF + 5632;
constexpr int LDS_BYTES = 147456;

#define RLX_AGENT __ATOMIC_RELAXED, __HIP_MEMORY_SCOPE_AGENT
#define LDS_WAIT() asm volatile("s_waitcnt lgkmcnt(0)" ::: "memory")
#define VM_WAIT() asm volatile("s_waitcnt vmcnt(0)" ::: "memory")
__device__ __forceinline__ unsigned cvt_pk_bf16(float lo, float hi) { unsigned r; asm volatile("v_cvt_pk_bf16_f32 %0, %1, %2" : "=v"(r) : "v"(lo), "v"(hi)); return r; }
__device__ __forceinline__ float bf_lo(unsigned w) { return __uint_as_float(w << 16); }
__device__ __forceinline__ float bf_hi(unsigned w) { return __uint_as_float(w & 0xffff0000u); }
__device__ __forceinline__ float wave_sum(float v) {
#pragma unroll
    for (int o = 1; o < 64; o <<= 1) v += __shfl_xor(v, o);
    return v;
}
__device__ __forceinline__ u32x2 pack8_fp8(const float (&a)[8]) {
    int w0 = 0, w1 = 0;
    w0 = __builtin_amdgcn_cvt_pk_fp8_f32(a[0], a[1], w0, false); w0 = __builtin_amdgcn_cvt_pk_fp8_f32(a[2], a[3], w0, true);
    w1 = __builtin_amdgcn_cvt_pk_fp8_f32(a[4], a[5], w1, false); w1 = __builtin_amdgcn_cvt_pk_fp8_f32(a[6], a[7], w1, true);
    u32x2 r; r.x = (unsigned)w0; r.y = (unsigned)w1; return r;
}
__device__ __forceinline__ float fexp2(float x) { return __builtin_amdgcn_exp2f(x); }
__device__ __forceinline__ float flog2(float x) { return __builtin_amdgcn_logf(x); }

#define XB_TMO      128
#define XB_XCNT(j)  (256  + 64 * (j))
#define XB_XSUB(j)  (1280 + 64 * (j))
#define XB_XGEN(j)  (2304 + 64 * (j))
#define XB_TOP      3328
#define XB_TOPGEN   3392
#define XCD_BAR_WORDS 3456
#define XB_SPIN_CAP (1u << 23)
__device__ __forceinline__ unsigned xb_ld(unsigned* p)              { return __hip_atomic_load(p, __ATOMIC_RELAXED, __HIP_MEMORY_SCOPE_AGENT); }
__device__ __forceinline__ unsigned xb_add(unsigned* p, unsigned v) { return __hip_atomic_fetch_add(p, v, __ATOMIC_RELAXED, __HIP_MEMORY_SCOPE_AGENT); }
__device__ __forceinline__ unsigned xb_xcc_id() { return (unsigned)__builtin_amdgcn_s_getreg((3 << 11) | 20) & 0xFu; }
#define XB_SPIN(cond, bar) do { unsigned _sp = 0; while (cond) { __builtin_amdgcn_s_sleep(1); \
    if ((++_sp & 255u) == 0u) { if (xb_ld(&(bar)[XB_TMO])) break; if (_sp > XB_SPIN_CAP) { atomicAdd(&(bar)[XB_TMO], 1u); break; } } } } while (0)
struct XcdBarrier { unsigned* bar; unsigned x; volatile LAS unsigned* st; };
__device__ __forceinline__ XcdBarrier xcd_barrier_post(unsigned* bar, volatile LAS unsigned* st) {
    XcdBarrier b; b.bar = bar; b.x = xb_xcc_id(); b.st = st;
    if (threadIdx.x == 0) (void)xb_add(&bar[XB_XCNT(b.x)], 1u);
    return b;
}
__device__ __forceinline__ void xcd_barrier_complete(unsigned* bar, unsigned x, unsigned& nloc, unsigned& nx) {
    const unsigned G = gridDim.x * gridDim.y * gridDim.z;
    unsigned sum, cnt, mine, sp = 0u;
    for (;;) {
        sum = 0u; cnt = 0u; mine = 0u;
#pragma unroll
        for (unsigned j = 0; j < 16; ++j) { const unsigned c = xb_ld(&bar[XB_XCNT(j)]); sum += c; cnt += (c > 0u) ? 1u : 0u; mine = (j == x) ? c : mine; }
        if (sum == G) break;
        __builtin_amdgcn_s_sleep(1);
        if ((++sp & 255u) == 0u) { if (xb_ld(&bar[XB_TMO])) break; if (sp > XB_SPIN_CAP) { atomicAdd(&bar[XB_TMO], 1u); break; } }
    }
    nloc = mine > 0u ? mine : 1u; nx = cnt > 0u ? cnt : 1u;
}
__device__ __forceinline__ void xcd_barrier(const XcdBarrier& b) {
    asm volatile("s_waitcnt vmcnt(0)" ::: "memory");
    __syncthreads();
    if (threadIdx.x == 0) {
        unsigned* bar = b.bar;
        __builtin_amdgcn_s_waitcnt(0);
        unsigned nloc = b.st[0], nx = b.st[1];
        if (nloc == 0u) { xcd_barrier_complete(bar, b.x, nloc, nx); b.st[0] = nloc; b.st[1] = nx; }
        const unsigned old = xb_add(&bar[XB_XSUB(b.x)], 1u);
        const unsigned gen = old / nloc;
        if (old + 1u == (gen + 1u) * nloc) {
            __builtin_amdgcn_fence(__ATOMIC_RELEASE, "agent");
            asm volatile("s_waitcnt vmcnt(0)" ::: "memory");
            const unsigned og = xb_add(&bar[XB_TOP], 1u);
            const unsigned tg = og / nx;
            if (og + 1u == (tg + 1u) * nx) xb_add(&bar[XB_TOPGEN], 1u);
            else XB_SPIN(xb_ld(&bar[XB_TOPGEN]) == tg, bar);
            __builtin_amdgcn_fence(__ATOMIC_ACQUIRE, "agent");
            xb_add(&bar[XB_XGEN(b.x)], 1u);
            asm volatile("s_waitcnt vmcnt(0)" ::: "memory");
        } else {
            XB_SPIN(xb_ld(&bar[XB_XGEN(b.x)]) == gen, bar);
            __builtin_amdgcn_fence(__ATOMIC_ACQUIRE, "agent");
            asm volatile("s_waitcnt vmcnt(0)" ::: "memory");
        }
    }
    __syncthreads();
}

__device__ __forceinline__ void xcc_barrier(unsigned* lb, unsigned x, unsigned nloc, unsigned* tmo) {
    asm volatile("s_waitcnt vmcnt(0)" ::: "memory");
    __syncthreads();
    if (threadIdx.x == 0) {
        const unsigned old = xb_add(&lb[64 * x], 1u), gen = old / nloc;
        if (old + 1u == (gen + 1u) * nloc) xb_add(&lb[1024 + 64 * x], 1u);
        else { unsigned sp = 0; while (xb_ld(&lb[1024 + 64 * x]) == gen) { __builtin_amdgcn_s_sleep(1);
                   if ((++sp & 255u) == 0u) { if (xb_ld(tmo)) break; if (sp > XB_SPIN_CAP) { atomicAdd(tmo, 1u); break; } } } }
        __builtin_amdgcn_fence(__ATOMIC_ACQUIRE, "agent");
        asm volatile("s_waitcnt vmcnt(0)" ::: "memory");
    }
    __syncthreads();
}

namespace pg8 {
constexpr int BM = 256, BK = 64, HALF = 128, HTB = HALF * BK * 2, STAGE_BYTES = 8 * HTB, NXCD = 8, WGM = 8;
__host__ __device__ __forceinline__ int lds_byte(int r, int c) { const int st = (r >> 4) * 2 + (c >> 5), rr = r & 15, cc = c & 31, ob = rr * 64 + cc * 2; return st * 1024 + (ob ^ (((ob >> 9) & 1) << 5)); }
__host__ __device__ __forceinline__ void stage_rc(int b, int& R, int& C) { const int st = b / 1024, sb = b % 1024, swz = sb ^ (((sb >> 9) & 1) << 5); R = (st >> 1) * 16 + swz / 64; C = (st & 1) * 32 + (swz % 64) / 2; }
__host__ __device__ __forceinline__ int perm32(int rho) { const int n = rho >> 4, i = rho & 15; return 8 * (i >> 2) + 4 * n + (i & 3); }

struct Unit { const char* A; const char* B; int pm, pn, kind, eoff, nvalid, goff, gnv, slot; };
constexpr int KEEP = 0x100;

__device__ __forceinline__ void tile_order(int L, int nM, int nN, int& pm, int& pn) {
    const int nwg = nM * nN; int wgid = L;
    { const int q = nwg / NXCD, r = nwg % NXCD, xcd = wgid % NXCD, off = wgid / NXCD; wgid = (xcd < r ? xcd * (q + 1) : r * (q + 1) + (xcd - r) * q) + off; }
    const int nig = WGM * nN, gid = wgid / nig, fm = gid * WGM, gsz = (nM - fm) < WGM ? (nM - fm) : WGM;
    pm = fm + ((wgid % nig) % gsz); pn = (wgid % nig) / gsz;
}

template <class Epi, class Sched, bool ALIGN_EPI = true, bool SP2 = true>
__device__ __forceinline__ void gemm_phase(LAS unsigned char* lds, const int K_, const Sched& S, const Epi& E, unsigned long long* pb = nullptr) {
    int tid_ = threadIdx.x; asm volatile("" : "+v"(tid_));
    const int tid = tid_, wid = __builtin_amdgcn_readfirstlane(tid >> 6), lane = tid & 63, wr = wid >> 2, wc = wid & 3, fr = lane & 15, fq = lane >> 4;
    int K = K_; asm volatile("" : "+s"(K));
    const int nt = K / BK;
    unsigned voffA[2], voffB[2]; int gR[2]; unsigned gC[2];
#pragma unroll
    for (int i = 0; i < 2; ++i) { int R, C; stage_rc(tid * 16 + i * 8192, R, C); const int Rb = Epi::PERM ? ((R & ~31) + perm32(R & 31)) : R;
        voffA[i] = (unsigned)(R * K + C) * 2u; voffB[i] = (unsigned)(Rb * K + C) * 2u; gR[i] = R; gC[i] = (unsigned)C * 2u; }
    unsigned voffG[2][2]; (void)gR; (void)gC;
    LAS int* idtab = (LAS int*)(lds + STAGE_BYTES + (IDT_OFF - RING_BYTES));
#define PG8_IDS_DMA(u_, slot) do { if (wid < 4) { int t_ = tid; asm volatile("" : "+v"(t_));   \
        __builtin_amdgcn_global_load_lds((const unsigned*)(S.ids + (u_).goff + t_), (LAS unsigned*)(idtab + (slot) * 256 + wid * 64), 4, 0, 0); } } while (0)
    LAS int* auxt = (LAS int*)(lds + STAGE_BYTES + (AUX_OFF - RING_BYTES));
#define PG8_AUX_DMA(u_) do { if (wid < 4) { int t_ = tid; asm volatile("" : "+v"(t_)); \
        if (S.aux0) __builtin_amdgcn_global_load_lds((const unsigned*)(S.aux0 + (u_).eoff + t_), (LAS unsigned*)(auxt + (u_).slot * 256 + wid * 64), 4, 0, 0); \
        if (S.aux1) __builtin_amdgcn_global_load_lds((const unsigned*)(S.aux1 + (u_).eoff + t_), (LAS unsigned*)(auxt + 768 + (u_).slot * 256 + wid * 64), 4, 0, 0); } } while (0)
#define PG8_IDS_READ(u_, slot) do { _Pragma("unroll") for (int i_ = 0; i_ < 2; ++i_) { int g_ = gR[i_]; asm volatile("" : "+v"(g_)); _Pragma("unroll") for (int h_ = 0; h_ < 2; ++h_) { const int r_ = h_ * 128 + g_; int id_ = idtab[(slot) * 256 + r_]; \
        id_ = (r_ < (u_).gnv) ? (id_ >> 1) : 0; voffG[h_][i_] = (unsigned)id_ * (unsigned)(K * 2) + gC[i_]; } } } while (0)
#define PG8_STAGE_A(buf, h, gbase) do { if constexpr (Sched::GATHER) { PG8_STAGE(PG8_SA(buf, h), gbase, voffG[h]); } else { PG8_STAGE(PG8_SA(buf, h), (gbase) + (h) * hstep, voffA); } } while (0)
    const size_t kstep = (size_t)(BK * 2);
    const size_t hstep = (size_t)HALF * K * 2;
    const unsigned ldsw = (unsigned)wid * 1024u;
    constexpr bool F8 = Sched::FP8;
    const int aoff = lds_byte(wr * 64 + fr, fq * 8), boff = lds_byte(wc * 32 + fr, fq * 8);
    constexpr int KSTEP = 1024;
#define PG8_SA(b, h) (((b) * 2 + (h)) * HTB)
#define PG8_SB(b, h) ((4 + (b) * 2 + (h)) * HTB)
#define PG8_STAGE(bufoff, gbase, voff) do { _Pragma("unroll") for (int _i = 0; _i < 2; ++_i) \
        __builtin_amdgcn_global_load_lds((const unsigned*)((const char*)(gbase) + (voff)[_i]), (LAS unsigned*)(lds + (bufoff) + ldsw + _i * 8192), 16, 0, 0); } while (0)
#define PG8_LDA(dst, b, h) do { _Pragma("unroll") for (int m = 0; m < 4; ++m) _Pragma("unroll") for (int k = 0; k < 2; ++k) dst[m][k] = *(const LAS bf16x8*)(lds + PG8_SA(b, h) + aoff + m * 2048 + k * KSTEP); } while (0)
#define PG8_LDB(dst, b, h) do { _Pragma("unroll") for (int n = 0; n < 2; ++n) _Pragma("unroll") for (int k = 0; k < 2; ++k) dst[n][k] = *(const LAS bf16x8*)(lds + PG8_SB(b, h) + boff + n * 2048 + k * KSTEP); } while (0)
#define PG8_CAT(x) __builtin_shufflevector(__builtin_bit_cast(v4i_t, (x)[0]), __builtin_bit_cast(v4i_t, (x)[1]), 0, 1, 2, 3, 4, 5, 6, 7)
#define PG8_MMA(ai, bj, At, Bt) do { __builtin_amdgcn_s_setprio(1); if constexpr (F8) { _Pragma("unroll") for (int m = 0; m < 4; ++m) _Pragma("unroll") for (int n = 0; n < 2; ++n) \
        acc[ai][bj][m][n] = __builtin_amdgcn_mfma_scale_f32_16x16x128_f8f6f4(PG8_CAT(Bt[n]), PG8_CAT(At[m]), acc[ai][bj][m][n], 0, 0, 0, 0x7f7f7f7f, 0, 0x7f7f7f7f); } else { \
        _Pragma("unroll") for (int m = 0; m < 4; ++m) _Pragma("unroll") for (int n = 0; n < 2; ++n) _Pragma("unroll") for (int k = 0; k < 2; ++k) \
        acc[ai][bj][m][n] = __builtin_amdgcn_mfma_f32_16x16x32_bf16(Bt[n][k], At[m][k], acc[ai][bj][m][n], 0, 0, 0); } __builtin_amdgcn_s_setprio(0); } while (0)
#define PG8_WAIT_V(n) asm volatile("s_waitcnt vmcnt(" #n ")" ::: "memory")
#define PG8_WAIT_L(n) asm volatile("s_waitcnt lgkmcnt(" #n ")" ::: "memory")
#define PG8_BAR __builtin_amdgcn_s_barrier()
#define PG8_SCHED __builtin_amdgcn_sched_barrier(0)
    Unit cur, nxt; int ui = 0;
    if (!S.next(0, cur)) return;
    f32x4 acc[2][2][4][2];
#pragma unroll
    for (int a = 0; a < 2; ++a)
#pragma unroll
        for (int b = 0; b < 2; ++b)
#pragma unroll
            for (int m = 0; m < 4; ++m)
#pragma unroll
                for (int n = 0; n < 2; ++n) acc[a][b][m][n] = (f32x4){0.f, 0.f, 0.f, 0.f};
    bf16x8 At[4][2], B0[2][2], B1[2][2];
    const char* cA = cur.A; const char* cB = cur.B;
    static_assert(SP2, "only the SP2 loop is kept here");
    cur.slot = 0;
    if constexpr (Sched::GATHER) { PG8_IDS_DMA(cur, 0); PG8_AUX_DMA(cur); PG8_WAIT_V(0); __syncthreads(); PG8_IDS_READ(cur, 0); }
    else if (S.aux0) { PG8_AUX_DMA(cur); PG8_WAIT_V(0); __syncthreads(); }
    PG8_STAGE(PG8_SB(0, 0), cB, voffB); PG8_STAGE(PG8_SB(0, 1), cB + hstep, voffB); PG8_STAGE_A(0, 0, cA); PG8_STAGE_A(0, 1, cA);
    if (wr == 1) PG8_BAR;
    PG8_WAIT_V(2); PG8_BAR;
    PG8_STAGE(PG8_SB(1, 0), cB + kstep, voffB); PG8_STAGE_A(1, 0, cA + kstep); PG8_STAGE(PG8_SB(1, 1), cB + hstep + kstep, voffB);
    PG8_WAIT_V(6); PG8_BAR;
    for (;;) {
        const bool has_next = S.next(ui + 1, nxt);
        const char* nA = has_next ? nxt.A : cA; const char* nB = has_next ? nxt.B : cB;
        nxt.slot = (cur.slot == 2) ? 0 : cur.slot + 1;
        if constexpr (Sched::GATHER) { if (has_next) { PG8_IDS_DMA(nxt, (ui + 1) & 1); PG8_AUX_DMA(nxt); } }
        else { if (has_next && S.aux0) PG8_AUX_DMA(nxt); }
#pragma nounroll
        for (int t = 0; t < nt; t += 2) {
            unsigned long long pbt = 0; if (pb && (PROBE_TYPE == 21 || PROBE_TYPE == 22)) pbt = __builtin_amdgcn_s_memrealtime();
            const bool last = (t == nt - 2);
            const char* a1 = cA + (size_t)(t + 1) * kstep;
            const char* a2 = last ? nA : cA + (size_t)(t + 2) * kstep; const char* b2 = last ? nB : cB + (size_t)(t + 2) * kstep;
            const char* a3 = a2 + kstep; const char* b3 = b2 + kstep;
            PG8_LDB(B0, 0, 0); PG8_LDB(B1, 0, 1); PG8_SCHED; PG8_LDA(At, 0, 0); PG8_STAGE_A(1, 1, a1);
            if constexpr (Sched::GATHER) { if (last && has_next) PG8_IDS_READ(nxt, (ui + 1) & 1); }
            PG8_WAIT_V(8); PG8_WAIT_L(0); PG8_BAR; PG8_MMA(0, 0, At, B0); PG8_MMA(0, 1, At, B1); PG8_BAR; PG8_SCHED;
            PG8_LDA(At, 0, 1); PG8_STAGE(PG8_SB(0, 0), b2, voffB); PG8_STAGE(PG8_SB(0, 1), b2 + hstep, voffB); PG8_STAGE_A(0, 0, a2);
            PG8_WAIT_V(8); PG8_WAIT_L(0); PG8_BAR; PG8_MMA(1, 0, At, B0); PG8_MMA(1, 1, At, B1); PG8_BAR; PG8_SCHED;
            PG8_LDB(B0, 1, 0); PG8_LDB(B1, 1, 1); PG8_SCHED; PG8_LDA(At, 1, 0); PG8_STAGE_A(0, 1, a2);
            PG8_WAIT_V(8); PG8_WAIT_L(0); PG8_BAR; PG8_MMA(0, 0, At, B0); PG8_MMA(0, 1, At, B1); PG8_BAR; PG8_SCHED;
            PG8_LDA(At, 1, 1); PG8_STAGE(PG8_SB(1, 0), b3, voffB); PG8_STAGE(PG8_SB(1, 1), b3 + hstep, voffB); PG8_STAGE_A(1, 0, a3);
            PG8_WAIT_V(8); PG8_WAIT_L(0); PG8_BAR; PG8_MMA(1, 0, At, B0); PG8_MMA(1, 1, At, B1); PG8_BAR; PG8_SCHED;
            if (pb && ((PROBE_TYPE == 21 && t == 0) || (PROBE_TYPE == 22 && t != 0))) *pb += __builtin_amdgcn_s_memrealtime() - pbt;
        }
        unsigned long long pbe = 0; if (pb && PROBE_TYPE == 20) pbe = __builtin_amdgcn_s_memrealtime();
        if constexpr (ALIGN_EPI) { if (wr == 0) PG8_BAR; }
        { unsigned z_ = 0u; asm volatile("" : "+v"(z_));
          const int l_ = (int)__builtin_amdgcn_mbcnt_hi(~0u, __builtin_amdgcn_mbcnt_lo(~0u, z_));
          E(acc, cur, wr, wc, l_ & 15, l_ >> 4); }
        if (pb && PROBE_TYPE == 20) *pb += __builtin_amdgcn_s_memrealtime() - pbe;
        if (!has_next) break;
        if (!(cur.kind & KEEP)) {
#pragma unroll
            for (int a = 0; a < 2; ++a)
#pragma unroll
                for (int b = 0; b < 2; ++b)
#pragma unroll
                    for (int m = 0; m < 4; ++m)
#pragma unroll
                        for (int n = 0; n < 2; ++n) acc[a][b][m][n] = (f32x4){0.f, 0.f, 0.f, 0.f};
        }
        cur = nxt; cA = nA; cB = nB; ++ui;
        if constexpr (ALIGN_EPI) { if (wr == 1) PG8_BAR; }
    }
    PG8_WAIT_V(0);
    if constexpr (!ALIGN_EPI) { if (wr == 0) PG8_BAR; }
    PG8_BAR;
#undef PG8_SA
#undef PG8_SB
#undef PG8_STAGE
#undef PG8_STAGE_A
#undef PG8_IDS_DMA
#undef PG8_AUX_DMA
#undef PG8_IDS_READ
#undef PG8_LDA
#undef PG8_LDB
#undef PG8_MMA
#undef PG8_CAT
#undef PG8_WAIT_V
#undef PG8_WAIT_L
#undef PG8_BAR
#undef PG8_SCHED
}
}

struct Args { const float* in[20]; float* out; unsigned char* ws; int ph_lo, ph_hi; };
#define KIN(i) (((const __attribute__((address_space(4))) Args*)__builtin_amdgcn_kernarg_segment_ptr())->in[i])
struct Frame {
    LAS unsigned char* lds;
    volatile LAS unsigned* MISC;
    gu32* ctl;
    int tid, lane, wave, G;
    int vcu, cx, local_ok;
    unsigned char* ws;
    float* out;
    unsigned long long pb_t0, pb_acc;
};

using pg8::Unit;
typedef f32x4 Acc[2][2][4][2];

struct EpiInProj {
    static constexpr bool PERM = true;
    unsigned char* ws; const LAS float* gl; const LAS float* rs_tab;
    __device__ __forceinline__ void operator()(Acc& acc, const Unit& u, int wr, int wc, int fr, int fq) const {
        const int row0 = u.pm * 256 + wr * 64 + fr; const int pn = u.pn;
        float rs[2][4];
#pragma unroll
        for (int ai = 0; ai < 2; ++ai)
#pragma unroll
            for (int m = 0; m < 4; ++m) rs[ai][m] = rs_tab[u.slot * 256 + wr * 64 + fr + ai * 128 + m * 16];
        if (pn < 4) {
            const LAS float* g = gl + (pn >> 1) * 64 + 8 * fq;
            bf16* dst = (bf16*)(ws + WS_DQ + (size_t)(pn >> 1) * (32 * MiB)) + wc * 128 + (pn & 1) * 64 + 8 * fq;
#pragma unroll
            for (int ai = 0; ai < 2; ++ai)
#pragma unroll
                for (int m = 0; m < 4; ++m) {
                    const int row = row0 + ai * 128 + m * 16; const float r_ = rs[ai][m]; float ss = 0.f; f32x4 v[2][2];
#pragma unroll
                    for (int bj = 0; bj < 2; ++bj)
#pragma unroll
                        for (int n = 0; n < 2; ++n) { v[bj][n] = acc[ai][bj][m][n] * r_; ss += (v[bj][n][0] * v[bj][n][0] + v[bj][n][1] * v[bj][n][1]) + (v[bj][n][2] * v[bj][n][2] + v[bj][n][3] * v[bj][n][3]); }
                    ss += __shfl_xor(ss, 16); ss += __shfl_xor(ss, 32);
                    const float inv = __builtin_amdgcn_rsqf(ss * (1.0f / 64.0f) + EPS);
                    bf16* rowp = dst + (size_t)row * 512;
#pragma unroll
                    for (int bj = 0; bj < 2; ++bj) { const f32x4 g0 = *(const LAS f32x4*)(g + 32 * bj) * inv, g1 = *(const LAS f32x4*)(g + 32 * bj + 4) * inv; u32x4 w;
                        w.x = cvt_pk_bf16(v[bj][0][0] * g0[0], v[bj][0][1] * g0[1]); w.y = cvt_pk_bf16(v[bj][0][2] * g0[2], v[bj][0][3] * g0[3]);
                        w.z = cvt_pk_bf16(v[bj][1][0] * g1[0], v[bj][1][1] * g1[1]); w.w = cvt_pk_bf16(v[bj][1][2] * g1[2], v[bj][1][3] * g1[3]);
                        *(u32x4*)(rowp + bj * 32) = w; }
                }
        } else if (pn < 12) {
            const int sec = (pn - 4) >> 1; bf16* dst = (bf16*)(ws + WS_VA + (size_t)sec * (32 * MiB)) + ((pn - 4) & 1) * 256 + wc * 32 + 8 * fq; const float sc = (sec == 1) ? C2 : 1.f;
#pragma unroll
            for (int ai = 0; ai < 2; ++ai)
#pragma unroll
                for (int m = 0; m < 4; ++m) { const int row = row0 + ai * 128 + m * 16; const float r_ = rs[ai][m] * sc; bf16* rowp = dst + (size_t)row * 512;
#pragma unroll
                    for (int bj = 0; bj < 2; ++bj) { const f32x4 v0 = acc[ai][bj][m][0] * r_, v1 = acc[ai][bj][m][1] * r_; u32x4 w;
                        w.x = cvt_pk_bf16(v0[0], v0[1]); w.y = cvt_pk_bf16(v0[2], v0[3]); w.z = cvt_pk_bf16(v1[0], v1[1]); w.w = cvt_pk_bf16(v1[2], v1[3]);
                        *(u32x4*)(rowp + bj * 128) = w; } }
        } else {
            const int col0 = (pn - 12) * 128 + wc * 32 + 8 * fq; unsigned char* G = ws + WS_G1;
#pragma unroll
            for (int ai = 0; ai < 2; ++ai)
#pragma unroll
                for (int m = 0; m < 4; ++m) { const int row = row0 + ai * 128 + m * 16; const float r_ = rs[ai][m];
                    unsigned qa[8], qb[8];
#pragma unroll
                    for (int n = 0; n < 2; ++n)
#pragma unroll
                        for (int j = 0; j < 4; ++j) { const float ga = acc[ai][0][m][n][j] * r_, gb = acc[ai][1][m][n][j] * r_;
                            const float sa = __builtin_amdgcn_rcpf(1.f + fexp2(-ga * LOG2E)), sb = __builtin_amdgcn_rcpf(1.f + fexp2(-gb * LOG2E));
                            qa[n * 4 + j] = (unsigned)(sa * 255.f + 0.5f); qb[n * 4 + j] = max(1u, (unsigned)(sb * 255.f + 0.5f)); }
                    u32x4 w;
                    w.x = qa[0] | (qa[1] << 8) | (qa[2] << 16) | (qa[3] << 24); w.y = qa[4] | (qa[5] << 8) | (qa[6] << 16) | (qa[7] << 24);
                    w.z = qb[0] | (qb[1] << 8) | (qb[2] << 16) | (qb[3] << 24); w.w = qb[4] | (qb[5] << 8) | (qb[6] << 16) | (qb[7] << 24);
                    *(u32x4*)(G + (size_t)row * 2048 + (size_t)col0 * 2) = w; }
        }
    }
};

struct EpiBranch {
    static constexpr bool PERM = true;
    const unsigned char* G; bf16* MIXED;
    __device__ __forceinline__ void operator()(Acc& acc, const Unit& u, int wr, int wc, int fr, int fq) const {
        const int row0 = u.pm * 256 + wr * 64 + fr; const int col0 = u.pn * 256 + wc * 32 + 8 * fq; const bool first = (u.kind & 0xff) == 0;
        const unsigned char* Gp = G + (size_t)row0 * 2048 + (size_t)col0 * 2;
        u32x4 g[2][4][2];
#pragma unroll
        for (int ai = 0; ai < 2; ++ai)
#pragma unroll
            for (int m = 0; m < 4; ++m)
#pragma unroll
                for (int bj = 0; bj < 2; ++bj) g[ai][m][bj] = *(const u32x4*)(Gp + (size_t)(ai * 128 + m * 16) * 2048 + bj * 256);
#define UB(w, k) ((float)(((w) >> (8 * (k))) & 0xffu))
        if (first) {
#pragma unroll
            for (int ai = 0; ai < 2; ++ai)
#pragma unroll
                for (int m = 0; m < 4; ++m)
#pragma unroll
                    for (int bj = 0; bj < 2; ++bj) { u32x4 gg = g[ai][m][bj]; asm volatile("" : "+v"(gg));
                        f32x4 v0 = acc[ai][bj][m][0], v1 = acc[ai][bj][m][1];
                        v0[0] *= UB(gg.x, 0) * __builtin_amdgcn_rcpf(UB(gg.z, 0)); v0[1] *= UB(gg.x, 1) * __builtin_amdgcn_rcpf(UB(gg.z, 1)); v0[2] *= UB(gg.x, 2) * __builtin_amdgcn_rcpf(UB(gg.z, 2)); v0[3] *= UB(gg.x, 3) * __builtin_amdgcn_rcpf(UB(gg.z, 3));
                        v1[0] *= UB(gg.y, 0) * __builtin_amdgcn_rcpf(UB(gg.w, 0)); v1[1] *= UB(gg.y, 1) * __builtin_amdgcn_rcpf(UB(gg.w, 1)); v1[2] *= UB(gg.y, 2) * __builtin_amdgcn_rcpf(UB(gg.w, 2)); v1[3] *= UB(gg.y, 3) * __builtin_amdgcn_rcpf(UB(gg.w, 3));
                        acc[ai][bj][m][0] = v0; acc[ai][bj][m][1] = v1; }
        } else {
            bf16* Mp = MIXED + (size_t)row0 * 1024 + col0; asm volatile("" : "+v"(Mp)); const float q = 1.0f / 255.0f;
#pragma unroll
            for (int ai = 0; ai < 2; ++ai)
#pragma unroll
                for (int m = 0; m < 4; ++m)
#pragma unroll
                    for (int bj = 0; bj < 2; ++bj) { u32x4 gg = g[ai][m][bj]; asm volatile("" : "+v"(gg)); const f32x4 v0 = acc[ai][bj][m][0] * q, v1 = acc[ai][bj][m][1] * q; u32x4 w;
                        w.x = cvt_pk_bf16(v0[0] * UB(gg.z, 0), v0[1] * UB(gg.z, 1)); w.y = cvt_pk_bf16(v0[2] * UB(gg.z, 2), v0[3] * UB(gg.z, 3));
                        w.z = cvt_pk_bf16(v1[0] * UB(gg.w, 0), v1[1] * UB(gg.w, 1)); w.w = cvt_pk_bf16(v1[2] * UB(gg.w, 2), v1[3] * UB(gg.w, 3));
                        *(u32x4*)(Mp + (size_t)(ai * 128 + m * 16) * 1024 + bj * 128) = w; }
        }
#undef UB
    }
};

struct EpiOutProj {
    static constexpr bool PERM = true;
    bf16* XB; unsigned char* XB8;
    __device__ __forceinline__ void operator()(Acc& acc, const Unit& u, int wr, int wc, int fr, int fq) const {
        const int row0 = u.pm * 256 + wr * 64 + fr; const int col0 = u.pn * 256 + wc * 32 + 8 * fq;
        bf16* base = XB + (size_t)row0 * 1024 + col0; unsigned char* base8 = XB8 + (size_t)row0 * 1024 + col0;
        u32x4 g[2][4][2];
#pragma unroll
        for (int ai = 0; ai < 2; ++ai)
#pragma unroll
            for (int m = 0; m < 4; ++m)
#pragma unroll
                for (int bj = 0; bj < 2; ++bj) g[ai][m][bj] = *(const u32x4*)(base + (size_t)(ai * 128 + m * 16) * 1024 + bj * 128);
#pragma unroll
        for (int ai = 0; ai < 2; ++ai)
#pragma unroll
            for (int m = 0; m < 4; ++m)
#pragma unroll
                for (int bj = 0; bj < 2; ++bj) { const u32x4 gg = g[ai][m][bj]; const f32x4 a0 = acc[ai][bj][m][0], a1 = acc[ai][bj][m][1]; u32x4 w;
                    w.x = cvt_pk_bf16(a0[0] + bf_lo(gg.x), a0[1] + bf_hi(gg.x)); w.y = cvt_pk_bf16(a0[2] + bf_lo(gg.y), a0[3] + bf_hi(gg.y));
                    w.z = cvt_pk_bf16(a1[0] + bf_lo(gg.z), a1[1] + bf_hi(gg.z)); w.w = cvt_pk_bf16(a1[2] + bf_lo(gg.w), a1[3] + bf_hi(gg.w));
                    *(u32x4*)(base + (size_t)(ai * 128 + m * 16) * 1024 + bj * 128) = w;
                    const float v8[8] = {bf_lo(w.x), bf_hi(w.x), bf_lo(w.y), bf_hi(w.y), bf_lo(w.z), bf_hi(w.z), bf_lo(w.w), bf_hi(w.w)};
                    *(u32x2*)(base8 + (size_t)(ai * 128 + m * 16) * 1024 + bj * 128) = pack8_fp8(v8); }
    }
};

struct EpiMoe1 {
    static constexpr bool PERM = true;
    const LAS float* rs_tab; unsigned char* ACT;
    __device__ __forceinline__ void operator()(Acc& acc, const Unit& u, int wr, int wc, int fr, int fq) const {
        const int row0 = u.pm * 256 + wr * 64 + fr; const int col0 = u.pn * 128 + wc * 32 + 8 * fq; const int r0 = wr * 64 + fr;
        float rs[2][4];
#pragma unroll
        for (int ai = 0; ai < 2; ++ai)
#pragma unroll
            for (int m = 0; m < 4; ++m) { const int r = r0 + ai * 128 + m * 16; rs[ai][m] = (r < u.nvalid) ? rs_tab[u.slot * 256 + r] * (1.0f / W8_SCALE) : 0.f; }
#pragma unroll
        for (int ai = 0; ai < 2; ++ai)
#pragma unroll
            for (int m = 0; m < 4; ++m) { const int prow = row0 + ai * 128 + m * 16; const float r_ = rs[ai][m]; float a[8];
#pragma unroll
                for (int n = 0; n < 2; ++n)
#pragma unroll
                    for (int j = 0; j < 4; ++j) { const float g = acc[ai][0][m][n][j] * r_, up = acc[ai][1][m][n][j] * r_;
                        a[n * 4 + j] = A8_SCALE * g * up * __builtin_amdgcn_rcpf(1.f + fexp2(-g * LOG2E)); }
                *(u32x2*)(ACT + (size_t)prow * 512 + col0) = pack8_fp8(a); }
    }
};

struct EpiMoe2 {
    static constexpr bool PERM = true;
    const LAS int* tok_tab; unsigned char* CONTRIB;
    __device__ __forceinline__ void operator()(Acc& acc, const Unit& u, int wr, int wc, int fr, int fq) const {
        const int col0 = u.pn * 256 + wc * 32 + 8 * fq; const int r0 = wr * 64 + fr;
        int tk[2][4]; float ww[2][4];
#pragma unroll
        for (int ai = 0; ai < 2; ++ai)
#pragma unroll
            for (int m = 0; m < 4; ++m) { const int r = r0 + ai * 128 + m * 16; const bool ok = r < u.nvalid; tk[ai][m] = ok ? tok_tab[u.slot * 256 + r] : -1; ww[ai][m] = ok ? __int_as_float(tok_tab[768 + u.slot * 256 + r]) * (C8_SCALE / (W8_SCALE * A8_SCALE)) : 0.f; }
#pragma unroll
        for (int ai = 0; ai < 2; ++ai)
#pragma unroll
            for (int m = 0; m < 4; ++m) { const int tok2 = tk[ai][m]; const float w_ = ww[ai][m];
                if (tok2 >= 0) {
#pragma unroll
                    for (int bj = 0; bj < 2; ++bj) { const f32x4 v0 = acc[ai][bj][m][0] * w_, v1 = acc[ai][bj][m][1] * w_;
                        const float v8[8] = {v0[0], v0[1], v0[2], v0[3], v1[0], v1[1], v1[2], v1[3]};
                        *(u32x2*)(CONTRIB + (size_t)tok2 * 1024 + col0 + bj * 128) = pack8_fp8(v8); } } }
    }
};

struct SchedPlain {
    static constexpr bool GATHER = false; static constexpr bool FP8 = false;
    const char* A; const char* Bt; int nM, nN, K, G, c; const int* aux0 = nullptr; const int* aux1 = nullptr;
    __device__ __forceinline__ bool next(int i, Unit& u) const {
        const long L = (long)i * G + c; if (L >= (long)nM * nN) return false;
        pg8::tile_order((int)L, nM, nN, u.pm, u.pn); u.kind = 0; u.eoff = 256 * u.pm; u.nvalid = 256; u.goff = 0; u.gnv = 0;
        u.A = A + (size_t)u.pm * 256 * K * 2; u.B = Bt + (size_t)u.pn * 256 * K * 2; return true;
    }
};
struct SchedBranch {
    static constexpr bool GATHER = false; static constexpr bool FP8 = false;
    const char *OA, *OB, *WBD, *WBS; int G, c; const int* aux0 = nullptr; const int* aux1 = nullptr;
    __device__ __forceinline__ bool next(int i, Unit& u) const {
        const long L = (long)(i >> 1) * G + c; if (L >= 128 * 4) return false;
        pg8::tile_order((int)L, 128, 4, u.pm, u.pn); const int br = i & 1; u.kind = br ? 1 : (0 | pg8::KEEP); u.eoff = 0; u.nvalid = 256; u.goff = 0; u.gnv = 0;
        u.A = (br ? OB : OA) + (size_t)u.pm * 256 * 512 * 2; u.B = (br ? WBS : WBD) + (size_t)u.pn * 256 * 512 * 2; return true;
    }
};
template <bool G>
struct SchedMoe {
    static constexpr bool GATHER = true; static constexpr bool FP8 = true;
    const char* A; const char* W; const LAS int* ust; const int* ids; const int* aux0; const int* aux1; int K; size_t wstride; int Gn, c;
    __device__ __forceinline__ bool next(int i, Unit& u) const {
        const int v = (Gn % 8 == 0) ? (c % 8) * (Gn / 8) + c / 8 : c;
        const long L = (long)i * Gn + v; const int nrb = ust[32]; if (L >= (long)nrb * 4) return false;
        const int rb = (int)(L >> 2), pn = (int)(L & 3); int e = 0;
        for (int j = 1; j < 32; ++j) e += (ust[j] <= rb) ? 1 : 0;
        const int rbl = rb - ust[e]; const int left = ust[64 + e] - 256 * rbl;
        u.pm = rb; u.pn = pn; u.kind = 0; u.eoff = e * ECAP + 256 * rbl; u.nvalid = left < 256 ? left : 256;
        if (G) { u.goff = u.eoff; u.gnv = u.nvalid; } else { u.goff = 256 * rb; u.gnv = 256; }
        u.A = A; u.B = W + (size_t)e * wstride + (size_t)pn * 256 * K * 2; return true;
    }
};

template <class RowMap>
__device__ __forceinline__ void transpose_item(const float* W, int N, bf16* WT, int Kd, const float* gk, LAS unsigned* scr, int kb, int nb, int lane, const RowMap& map) {
    const int k0 = 64 * kb, n0 = 64 * nb, n4 = lane & 15, kq = lane >> 4;
    f32x4 va[8], vb[8];
    const float* wp = W + (size_t)(k0 + 2 * kq) * N + n0 + 4 * n4;
#pragma unroll
    for (int i = 0; i < 8; ++i) { va[i] = __builtin_nontemporal_load((const f32x4*)(wp + (size_t)(8 * i) * N)); vb[i] = __builtin_nontemporal_load((const f32x4*)(wp + (size_t)(8 * i + 1) * N)); }
#pragma unroll
    for (int i = 0; i < 8; ++i) {
        float ga = 1.f, gb = 1.f; if (gk) { ga = gk[k0 + 8 * i + 2 * kq]; gb = gk[k0 + 8 * i + 2 * kq + 1]; }
#pragma unroll
        for (int j = 0; j < 4; ++j) scr[(4 * n4 + j) * 33 + 4 * i + kq] = cvt_pk_bf16(va[i][j] * ga, vb[i][j] * gb);
    }
    LDS_WAIT(); asm volatile("" ::: "memory");
    const int nl = lane >> 3, c = lane & 7;
#pragma unroll
    for (int p = 0; p < 8; ++p) { const int n = 8 * p + nl; const LAS unsigned* sp = scr + n * 33 + 4 * c;
        u32x4 o; o.x = sp[0]; o.y = sp[1]; o.z = sp[2]; o.w = sp[3];
        *(u32x4*)(WT + (size_t)map(n0 + n) * Kd + k0 + 8 * c) = o; }
    LDS_WAIT(); asm volatile("" ::: "memory");
}
template <class RowMap>
__device__ __forceinline__ void transpose_item8(const float* W, int N, unsigned char* WT, int Kd, const float* gk, float scale, LAS unsigned char* scr, int kb, int nb, int lane, const RowMap& map) {
    const int k0 = 64 * kb, n0 = 64 * nb, n4 = lane & 15, kq = lane >> 4;
    f32x4 va[8], vb[8];
    const float* wp = W + (size_t)(k0 + 2 * kq) * N + n0 + 4 * n4;
#pragma unroll
    for (int i = 0; i < 8; ++i) { va[i] = __builtin_nontemporal_load((const f32x4*)(wp + (size_t)(8 * i) * N)); vb[i] = __builtin_nontemporal_load((const f32x4*)(wp + (size_t)(8 * i + 1) * N)); }
#pragma unroll
    for (int i = 0; i < 8; ++i) {
        float ga = scale, gb = scale; if (gk) { ga *= gk[k0 + 8 * i + 2 * kq]; gb *= gk[k0 + 8 * i + 2 * kq + 1]; }
#pragma unroll
        for (int j = 0; j < 4; ++j) *(LAS unsigned short*)(scr + (4 * n4 + j) * 72 + 8 * i + 2 * kq) = (unsigned short)(__builtin_amdgcn_cvt_pk_fp8_f32(va[i][j] * ga, vb[i][j] * gb, 0, false) & 0xffff);
    }
    LDS_WAIT(); asm volatile("" ::: "memory");
    const int nl = lane >> 3, c = lane & 7;
#pragma unroll
    for (int p = 0; p < 8; ++p) { const int n = 8 * p + nl; const u32x2 o = *(const LAS u32x2*)(scr + n * 72 + 8 * c);
        *(u32x2*)(WT + (size_t)map(n0 + n) * Kd + k0 + 8 * c) = o; }
    LDS_WAIT(); asm volatile("" ::: "memory");
}
struct MapPlain { __device__ __forceinline__ int operator()(int c) const { return c; } };
struct MapIn {
    __device__ __forceinline__ int operator()(int c) const {
        if (c < 1024) { const int pn = c >> 8, hh = (c >> 6) & 3, d = c & 63; return 256 * pn + 128 * (d >> 5) + 32 * hh + (d & 31); }
        if (c < 3072) return c;
        if (c < 4096) { const int cc = c - 3072; return 3072 + 256 * (cc >> 7) + (cc & 127); }
        const int cc = c - 4096; return 3072 + 256 * (cc >> 7) + 128 + (cc & 127);
    }
};
struct MapGU { int up; __device__ __forceinline__ int operator()(int c) const { return 256 * (c >> 7) + 128 * up + (c & 127); } };

__device__ __forceinline__ void convert_moe_weights(Frame& F, int l, int gw, int NGW) {
    LAS unsigned char* scr = (LAS unsigned char*)(F.lds + F.wave * 16384);
    const float* g2 = KIN(14) + l * D;
    for (int it = gw; it < NE * 384; it += NGW) {
        const int e = it / 384, r = it % 384;
        if (r < 256) { const int up = r >> 7, q = r & 127, kb = q >> 3, nb = q & 7;
            const float* W = (up ? KIN(18) : KIN(17)) + ((size_t)l * NE + e) * (size_t)D * DFF;
            transpose_item8(W, DFF, (unsigned char*)(F.ws + WS_WGU_T) + (size_t)e * 1024 * 1024, 1024, g2, W8_SCALE, scr, kb, nb, F.lane, MapGU{up});
        } else { const int q = r - 256, kb = q >> 4, nb = q & 15;
            const float* W = KIN(19) + ((size_t)l * NE + e) * (size_t)DFF * D;
            transpose_item8(W, D, (unsigned char*)(F.ws + WS_WDN_T) + (size_t)e * 1024 * 512, 512, nullptr, W8_SCALE, scr, kb, nb, F.lane, MapPlain{});
        }
    }
}
__device__ __forceinline__ void convert_small_weights(Frame& F, int gw, int NGW) {
    LAS unsigned* scr = (LAS unsigned*)(F.lds + F.wave * 16384);
    for (int it = gw; it < 2 * 1792; it += NGW) {
        const int l = it / 1792; int r = it % 1792;
        if (r < 1280) { const int kb = r / 80, nb = r % 80;
            transpose_item(KIN(3) + (size_t)l * D * NIN, NIN, (bf16*)(F.ws + WS_WIN_T) + (size_t)l * NIN * D, D, KIN(2) + l * D, scr, kb, nb, F.lane, MapIn{}); continue; }
        r -= 1280;
        if (r < 128) { transpose_item(KIN(11) + (size_t)l * 512 * D, D, (bf16*)(F.ws + WS_WBD_T) + (size_t)l * D * 512, 512, nullptr, scr, r >> 4, r & 15, F.lane, MapPlain{}); continue; }
        r -= 128;
        if (r < 128) { transpose_item(KIN(12) + (size_t)l * 512 * D, D, (bf16*)(F.ws + WS_WBS_T) + (size_t)l * D * 512, 512, nullptr, scr, r >> 4, r & 15, F.lane, MapPlain{}); continue; }
        r -= 128;
        transpose_item(KIN(13) + (size_t)l * D * D, D, (bf16*)(F.ws + WS_WOUT_T) + (size_t)l * D * D, D, nullptr, scr, r >> 4, r & 15, F.lane, MapPlain{});
    }
    const int gt = (gw * 64 + F.lane), NT_ = NGW * 64;
    for (int i = gt; i < PMAX; i += NT_) ((int*)(F.ws + WS_IDENT))[i] = 2 * i;
    for (int idx = gt; idx < 2 * 48 * 1024; idx += NT_) {
        const int l = idx / (48 * 1024), r = idx % (48 * 1024), n = r >> 10, k = r & 1023; float v = 0.f;
        if (n < 32) v = KIN(16)[((size_t)l * D + k) * 32 + n]; else if (n < 36) v = KIN(15)[((size_t)l * D + k) * 4 + (n - 32)];
        v *= KIN(14)[l * D + k];
        ((bf16*)(F.ws + WS_WR_T))[idx] = (bf16)(cvt_pk_bf16(v, 0.f) & 0xffffu);
    }
}
template <bool INB, bool ADD, bool WX, bool WB>
__device__ __forceinline__ void rows_phase(Frame& F, const float* xin, float* xout, int m_first, int m_step, int m_end) {
    const unsigned char* C = (const unsigned char*)(F.ws + WS_CONTRIB); bf16* XB = (bf16*)(F.ws + WS_XB); float* rstd = (float*)(F.ws + WS_RSTD1);
    for (int m0 = m_first; m0 < m_end; m0 += m_step) {
        f32x4 v[2][4]; u32x2 xa[2][4]; unsigned ca[2][4], cb[2][4];
#pragma unroll
        for (int q = 0; q < 2; ++q) {
            if (INB) { const u32x2* xr = (const u32x2*)(XB + (size_t)(m0 + q) * D) + F.lane;
#pragma unroll
                for (int j = 0; j < 4; ++j) xa[q][j] = xr[64 * j]; }
            else { const f32x4* xr = (const f32x4*)(xin + (size_t)(m0 + q) * D) + F.lane;
#pragma unroll
                for (int j = 0; j < 4; ++j) v[q][j] = __builtin_nontemporal_load(xr + 64 * j); }
            if (ADD) { const unsigned* c0 = (const unsigned*)(C + (size_t)(2 * (m0 + q)) * D) + F.lane; const unsigned* c1 = (const unsigned*)(C + (size_t)(2 * (m0 + q) + 1) * D) + F.lane;
#pragma unroll
                for (int j = 0; j < 4; ++j) { ca[q][j] = c0[64 * j]; cb[q][j] = c1[64 * j]; } } }
#pragma unroll
        for (int q = 0; q < 2; ++q) { const int m = m0 + q;
            if (INB) {
#pragma unroll
                for (int j = 0; j < 4; ++j) { const u32x2 a = xa[q][j]; v[q][j] = (f32x4){bf_lo(a.x), bf_hi(a.x), bf_lo(a.y), bf_hi(a.y)}; } }
            if (ADD) {
#pragma unroll
                for (int j = 0; j < 4; ++j) { const int a = (int)ca[q][j], b = (int)cb[q][j];
                    const f32x2 a0 = __builtin_amdgcn_cvt_pk_f32_fp8(a, false), a1 = __builtin_amdgcn_cvt_pk_f32_fp8(a, true), b0 = __builtin_amdgcn_cvt_pk_f32_fp8(b, false), b1 = __builtin_amdgcn_cvt_pk_f32_fp8(b, true);
                    v[q][j][0] += (a0[0] + b0[0]) * (1.0f / C8_SCALE); v[q][j][1] += (a0[1] + b0[1]) * (1.0f / C8_SCALE); v[q][j][2] += (a1[0] + b1[0]) * (1.0f / C8_SCALE); v[q][j][3] += (a1[1] + b1[1]) * (1.0f / C8_SCALE); } }
            if (WX) { f32x4* xo = (f32x4*)(xout + (size_t)m * D) + F.lane;
#pragma unroll
                for (int j = 0; j < 4; ++j) __builtin_nontemporal_store(v[q][j], xo + 64 * j); }
            if (WB) {
                u32x2 w[4]; float s_ = 0.f;
#pragma unroll
                for (int j = 0; j < 4; ++j) { w[j].x = cvt_pk_bf16(v[q][j][0], v[q][j][1]); w[j].y = cvt_pk_bf16(v[q][j][2], v[q][j][3]);
                    const float r0 = bf_lo(w[j].x), r1 = bf_hi(w[j].x), r2 = bf_lo(w[j].y), r3 = bf_hi(w[j].y); s_ += (r0 * r0 + r1 * r1) + (r2 * r2 + r3 * r3); }
                s_ = wave_sum(s_);
                if (F.lane == 0) rstd[m] = 1.0f / sqrtf(s_ * (1.0f / D) + EPS);
                u32x2* o = (u32x2*)(XB + (size_t)m * D) + F.lane;
#pragma unroll
                for (int j = 0; j < 4; ++j) o[64 * j] = w[j];
            } }
    }
}

__device__ __forceinline__ void router_phase(Frame& F, int l) {
    const bf16* XB = (const bf16*)(F.ws + WS_XB); const bf16* WR = (const bf16*)(F.ws + WS_WR_T) + (size_t)l * 48 * 1024;
    int* ent_tok = (int*)(F.ws + WS_ENT_TOK); float* ent_w = (float*)(F.ws + WS_ENT_W); float* ent_rs = (float*)(F.ws + WS_ENT_RS);
    unsigned* gcnt = (unsigned*)(F.ctl + CW_CNT + 64 * l);
    LAS int* lcnt = (LAS int*)(F.lds + MOE_OFF) + 64; LAS int* lbase = lcnt + 32;
    const int fr = F.lane & 15, fq = F.lane >> 4;
    { LAS u32x4* wl = (LAS u32x4*)F.lds; u32x4 tmp[12];
#pragma unroll
        for (int j = 0; j < 12; ++j) { const int f = F.tid + 512 * j, ln = f & 63, kk = (f >> 6) & 31, nb = f >> 11; tmp[j] = *(const u32x4*)(WR + (size_t)(16 * nb + (ln & 15)) * D + 32 * kk + 8 * (ln >> 4)); }
#pragma unroll
        for (int j = 0; j < 12; ++j) wl[F.tid + 512 * j] = tmp[j];
    }
    __syncthreads();
    for (int chunk = F.vcu; chunk < T / 128; chunk += F.G) {
        if (F.tid < 32) lcnt[F.tid] = 0;
        __syncthreads();
        const int row = chunk * 128 + F.wave * 16 + fr;
        f32x4 a0 = {0.f, 0.f, 0.f, 0.f}, a1 = a0, a2 = a0; float ss = 0.f;
        const bf16* xp = XB + (size_t)row * D + 8 * fq; const LAS bf16x8* wl = (const LAS bf16x8*)F.lds + F.lane;
#pragma unroll
        for (int kb_ = 0; kb_ < 2; ++kb_) {
        u32x4 xa[16];
#pragma unroll
        for (int kk = 0; kk < 16; ++kk) xa[kk] = *(const u32x4*)(xp + 32 * (16 * kb_ + kk));
#pragma unroll
        for (int k_ = 0; k_ < 16; ++k_) { const int kk = 16 * kb_ + k_;
            { const u32x4 x_ = xa[k_]; float t0 = bf_lo(x_.x), t1 = bf_hi(x_.x), t2 = bf_lo(x_.y), t3 = bf_hi(x_.y), t4 = bf_lo(x_.z), t5 = bf_hi(x_.z), t6 = bf_lo(x_.w), t7 = bf_hi(x_.w);
              ss += (t0 * t0 + t1 * t1) + (t2 * t2 + t3 * t3) + (t4 * t4 + t5 * t5) + (t6 * t6 + t7 * t7); }
            const bf16x8 xf = __builtin_bit_cast(bf16x8, xa[k_]);
            a0 = __builtin_amdgcn_mfma_f32_16x16x32_bf16(wl[(0 * 32 + kk) * 64], xf, a0, 0, 0, 0);
            a1 = __builtin_amdgcn_mfma_f32_16x16x32_bf16(wl[(1 * 32 + kk) * 64], xf, a1, 0, 0, 0);
            a2 = __builtin_amdgcn_mfma_f32_16x16x32_bf16(wl[(2 * 32 + kk) * 64], xf, a2, 0, 0, 0);
            if ((k_ & 3) == 3) __builtin_amdgcn_sched_barrier(0);
        }
        asm volatile("" ::: "memory");
        }
        ss += __shfl_xor(ss, 16); ss += __shfl_xor(ss, 32);
        const float rstd = 1.0f / sqrtf(ss * (1.0f / D) + EPS);
        float gl[4];
#pragma unroll
        for (int j = 0; j < 4; ++j) gl[j] = __shfl(a2[j], fr) * rstd;
        int g = 0; float gm = gl[0];
#pragma unroll
        for (int j = 1; j < 4; ++j) if (gl[j] > gm) { gm = gl[j]; g = j; }
        float gs = 0.f;
#pragma unroll
        for (int j = 0; j < 4; ++j) gs += __expf(gl[j] - gm);
        const float pg = 1.0f / gs;
        f32x4 sel = (g >> 1) ? a1 : a0;
        float el[8];
#pragma unroll
        for (int i = 0; i < 8; ++i) { const int src = fr + 16 * (2 * (g & 1) + (i >> 2)); el[i] = __shfl(sel[i & 3], src) * rstd; }
        int i1 = 0; float m1 = el[0];
#pragma unroll
        for (int i = 1; i < 8; ++i) if (el[i] > m1) { m1 = el[i]; i1 = i; }
        int i2 = -1; float m2 = -3.0e38f;
#pragma unroll
        for (int i = 0; i < 8; ++i) if (i != i1 && el[i] > m2) { m2 = el[i]; i2 = i; }
        const float p2 = __expf(m2 - m1); const float w0 = pg / (1.f + p2), w1 = pg * p2 / (1.f + p2);
        const int e0 = 8 * g + i1, e1 = 8 * g + i2;
        int lp0 = 0, lp1 = 0;
        if (fq == 0) { lp0 = __hip_atomic_fetch_add(lcnt + e0, 1, __ATOMIC_RELAXED, __HIP_MEMORY_SCOPE_WORKGROUP); lp1 = __hip_atomic_fetch_add(lcnt + e1, 1, __ATOMIC_RELAXED, __HIP_MEMORY_SCOPE_WORKGROUP); }
        __syncthreads();
        if (F.tid < 32) lbase[F.tid] = (int)__hip_atomic_fetch_add(gcnt + F.tid, (unsigned)lcnt[F.tid], RLX_AGENT);
        __syncthreads();
        if (fq == 0) {
            const int s0 = e0 * ECAP + lbase[e0] + lp0, s1 = e1 * ECAP + lbase[e1] + lp1;
            ent_tok[s0] = 2 * row; ent_tok[s1] = 2 * row + 1; ent_w[s0] = w0; ent_w[s1] = w1; ent_rs[s0] = rstd; ent_rs[s1] = rstd;
        }
        __syncthreads();
    }
}
__device__ __forceinline__ void build_ust(Frame& F, int l) {
    LAS int* ust = (LAS int*)(F.lds + MOE_OFF); LAS int* cnt = ust + 64;
    if (F.tid < 32) cnt[F.tid] = (int)__hip_atomic_load((unsigned*)(F.ctl + CW_CNT + 64 * l) + F.tid, RLX_AGENT);
    __syncthreads();
    if (F.tid == 0) { int acc = 0;
        for (int e = 0; e < 32; ++e) { ust[e] = acc; acc += (cnt[e] + 255) >> 8; }
        ust[32] = acc; }
    __syncthreads();
}
__device__ __forceinline__ int crow(int r, int hi) { return (r & 3) + 8 * (r >> 2) + 4 * hi; }
__device__ __forceinline__ s16x4 vtr(const LAS unsigned char* p) { return __builtin_bit_cast(s16x4, __builtin_amdgcn_ds_read_tr16_b64_v4i16((LAS v4i16_t*)p)); }
__device__ __forceinline__ void glds(const void* g, LAS unsigned char* l) { __builtin_amdgcn_global_load_lds((const unsigned*)g, (LAS unsigned*)l, 16, 0, 0); }
#define PKV(lo, hi4) (bf16x8){lo[0], lo[1], lo[2], lo[3], hi4[0], hi4[1], hi4[2], hi4[3]}

__device__ __forceinline__ void pack_p(const f32x16& p0, const f32x16& p1, bf16x8 (&pa)[4]) {
    u32x4 w0, w1, w2, w3;
    w0.x = cvt_pk_bf16(p0[0], p0[1]); w0.y = cvt_pk_bf16(p0[2], p0[3]); w0.z = cvt_pk_bf16(p0[4], p0[5]); w0.w = cvt_pk_bf16(p0[6], p0[7]);
    w1.x = cvt_pk_bf16(p0[8], p0[9]); w1.y = cvt_pk_bf16(p0[10], p0[11]); w1.z = cvt_pk_bf16(p0[12], p0[13]); w1.w = cvt_pk_bf16(p0[14], p0[15]);
    w2.x = cvt_pk_bf16(p1[0], p1[1]); w2.y = cvt_pk_bf16(p1[2], p1[3]); w2.z = cvt_pk_bf16(p1[4], p1[5]); w2.w = cvt_pk_bf16(p1[6], p1[7]);
    w3.x = cvt_pk_bf16(p1[8], p1[9]); w3.y = cvt_pk_bf16(p1[10], p1[11]); w3.z = cvt_pk_bf16(p1[12], p1[13]); w3.w = cvt_pk_bf16(p1[14], p1[15]);
    pa[0] = __builtin_bit_cast(bf16x8, w0); pa[1] = __builtin_bit_cast(bf16x8, w1); pa[2] = __builtin_bit_cast(bf16x8, w2); pa[3] = __builtin_bit_cast(bf16x8, w3);
}
#define VTR_ASM(dst, addr, off) asm volatile("ds_read_b64_tr_b16 %0, %1 offset:%2" : "=v"(dst) : "v"(addr), "n"(off) : "memory")
#define VTR_WAIT(n, b) asm volatile("s_waitcnt lgkmcnt(" #n ")" : "+v"(lo[b][0]), "+v"(lo[b][1]), "+v"(lo[b][2]), "+v"(lo[b][3]), "+v"(hi4[b][0]), "+v"(hi4[b][1]), "+v"(hi4[b][2]), "+v"(hi4[b][3]) :: "memory")
template <int NDB>
__device__ __forceinline__ void pv_mma(f32x16 (&o)[NDB], const LAS unsigned char* vp, const bf16x8 (&pa)[4]) {
    s16x4 lo[2][4], hi4[2][4];
    const unsigned va = (unsigned)(size_t)vp;
#pragma unroll
    for (int ks = 0; ks < 4; ++ks) { VTR_ASM(lo[0][ks], va, ks * 1024); VTR_ASM(hi4[0][ks], va, ks * 1024 + 512); }
#pragma unroll
    for (int db = 0; db < NDB; ++db) {
        if (db + 1 < NDB) {
#pragma unroll
            for (int ks = 0; ks < 4; ++ks) { VTR_ASM(lo[(db + 1) & 1][ks], va, (db + 1) * 4096 + ks * 1024); VTR_ASM(hi4[(db + 1) & 1][ks], va, (db + 1) * 4096 + ks * 1024 + 512); }
            if (db & 1) VTR_WAIT(8, 1); else VTR_WAIT(8, 0);
        } else { if (db & 1) VTR_WAIT(0, 1); else VTR_WAIT(0, 0); }
        __builtin_amdgcn_sched_barrier(0);
#pragma unroll
        for (int ks = 0; ks < 4; ++ks) o[db] = __builtin_amdgcn_mfma_f32_32x32x16_bf16(pa[ks], PKV(lo[db & 1][ks], hi4[db & 1][ks]), o[db], 0, 0, 0);
        __builtin_amdgcn_sched_barrier(0);
    }
}
__device__ __forceinline__ void qk_mma(f32x16& p0, f32x16& p1, const LAS unsigned char* Kb, const LAS unsigned char* Qs, int lane, int r32, int hi) {
    const LAS unsigned char* kb = Kb + hi * 1024 + r32 * 16;
#pragma unroll
    for (int d0 = 0; d0 < 4; ++d0) {
        const bf16x8 b0 = *(const LAS bf16x8*)(kb + d0 * 2048), b1 = *(const LAS bf16x8*)(kb + d0 * 2048 + 512), q = *(const LAS bf16x8*)(Qs + d0 * 1024 + lane * 16);
        p0 = __builtin_amdgcn_mfma_f32_32x32x16_bf16(b0, q, p0, 0, 0, 0); p1 = __builtin_amdgcn_mfma_f32_32x32x16_bf16(b1, q, p1, 0, 0, 0);
    }
}

__device__ __forceinline__ void diff_epilogue(Frame& F, f32x16 (&o)[4], LAS float* xch, const float* subg, float lam_init, bf16* Ow);
template <int VAR>
__device__ __forceinline__ void diff_stream(f32x16 (&o)[4], float& l, const LAS unsigned char* Kb, const LAS unsigned char* Vb, const bf16x8 (&qr)[4], const LAS float* lut,
                                            bool near, float cfar, int qrow, int kmin, int lane, int r32, int hi) {
    f32x16 p0, p1; const float init = near ? 0.f : cfar;
#pragma unroll
    for (int r = 0; r < 16; ++r) { p0[r] = init; p1[r] = init; }
    const LAS unsigned char* kb = Kb + r32 * 128; const int sw = (r32 >> 1) & 7;
    bf16x8 kf[8];
#pragma unroll
    for (int d0 = 0; d0 < 4; ++d0) { const int so = (((2 * d0 + hi) ^ sw) << 4); kf[2 * d0] = *(const LAS bf16x8*)(kb + so); kf[2 * d0 + 1] = *(const LAS bf16x8*)(kb + 4096 + so); }
    __builtin_amdgcn_sched_barrier(0);
#pragma unroll
    for (int d0 = 0; d0 < 4; ++d0) { if (!(VAR & 4)) { p0 = __builtin_amdgcn_mfma_f32_32x32x16_bf16(kf[2 * d0], qr[d0], p0, 0, 0, 0); p1 = __builtin_amdgcn_mfma_f32_32x32x16_bf16(kf[2 * d0 + 1], qr[d0], p1, 0, 0, 0); }
        else { p0[d0] += __builtin_bit_cast(f32x4, kf[2 * d0])[0]; p1[d0] += __builtin_bit_cast(f32x4, kf[2 * d0 + 1])[0]; } }
    if (VAR & 1) { } else if (near) {
#pragma unroll
        for (int r = 0; r < 16; ++r) { const int d0 = qrow - (kmin + crow(r, hi)), d1 = d0 - 32;
            const float b0 = lut[min(max(d0, 0), 127)], b1 = lut[min(max(d1, 0), 127)];
            p0[r] = d0 < 0 ? 0.f : fexp2(p0[r] + b0); p1[r] = d1 < 0 ? 0.f : fexp2(p1[r] + b1); }
    } else {
#pragma unroll
        for (int r = 0; r < 16; ++r) { p0[r] = fexp2(p0[r]); p1[r] = fexp2(p1[r]); }
    }
    float s = 0.f;
#pragma unroll
    for (int r = 0; r < 16; ++r) s += p0[r] + p1[r];
    l += s;
    bf16x8 pa[4]; pack_p(p0, p1, pa);
    const LAS unsigned char* vp = Vb + ((lane >> 4) & 1) * 32 + (lane & 3) * 8 + (4 * hi + ((lane & 15) >> 2)) * 64;
    if (!(VAR & 2)) pv_mma<4>(o, vp, pa); else { o[0][0] += __builtin_bit_cast(f32x4, pa[0])[0] + __builtin_bit_cast(f32x4, pa[3])[1]; }
}

__device__ __forceinline__ void diff_first(float& l, bf16x8 (&pa)[4], const LAS unsigned char* Kb, const bf16x8 (&qr)[4], const LAS float* lut,
                                           bool near, float cfar, int qrow, int kmin, int r32, int hi) {
    f32x16 p0, p1; const float init = near ? 0.f : cfar;
#pragma unroll
    for (int r = 0; r < 16; ++r) { p0[r] = init; p1[r] = init; }
    const LAS unsigned char* kb = Kb + r32 * 128; const int sw = (r32 >> 1) & 7;
    bf16x8 kf[8];
#pragma unroll
    for (int d0 = 0; d0 < 4; ++d0) { const int so = (((2 * d0 + hi) ^ sw) << 4); kf[2 * d0] = *(const LAS bf16x8*)(kb + so); kf[2 * d0 + 1] = *(const LAS bf16x8*)(kb + 4096 + so); }
    __builtin_amdgcn_sched_barrier(0);
#pragma unroll
    for (int d0 = 0; d0 < 4; ++d0) { p0 = __builtin_amdgcn_mfma_f32_32x32x16_bf16(kf[2 * d0], qr[d0], p0, 0, 0, 0); p1 = __builtin_amdgcn_mfma_f32_32x32x16_bf16(kf[2 * d0 + 1], qr[d0], p1, 0, 0, 0); }
    if (near) {
#pragma unroll
        for (int r = 0; r < 16; ++r) { const int d0 = qrow - (kmin + crow(r, hi)), d1 = d0 - 32;
            const float b0 = lut[min(max(d0, 0), 127)], b1 = lut[min(max(d1, 0), 127)];
            p0[r] = d0 < 0 ? 0.f : fexp2(p0[r] + b0); p1[r] = d1 < 0 ? 0.f : fexp2(p1[r] + b1); }
    } else {
#pragma unroll
        for (int r = 0; r < 16; ++r) { p0[r] = fexp2(p0[r]); p1[r] = fexp2(p1[r]); }
    }
    float s = 0.f;
#pragma unroll
    for (int r = 0; r < 16; ++r) s += p0[r] + p1[r];
    l += s;
    pack_p(p0, p1, pa);
}
template <bool NEAR>
__device__ __forceinline__ void diff_step(f32x16 (&o)[4], float& l, bf16x8 (&pa)[4], const LAS unsigned char* Kn, const LAS unsigned char* Vc, const bf16x8 (&qr)[4],
                                          const LAS float* lut, float cfar, int qrow, int kmin, int lane, int r32, int hi) {
    f32x16 p0, p1; const float init = NEAR ? 0.f : cfar;
#pragma unroll
    for (int r = 0; r < 16; ++r) { p0[r] = init; p1[r] = init; }
    const LAS unsigned char* kb = Kn + r32 * 128; const int sw = (r32 >> 1) & 7;
    const LAS unsigned char* vp = Vc + ((lane >> 4) & 1) * 32 + (lane & 3) * 8 + (4 * hi + ((lane & 15) >> 2)) * 64;
    bf16x8 kf[8];
#pragma unroll
    for (int d0 = 0; d0 < 4; ++d0) { const int so = (((2 * d0 + hi) ^ sw) << 4); kf[2 * d0] = *(const LAS bf16x8*)(kb + so); kf[2 * d0 + 1] = *(const LAS bf16x8*)(kb + 4096 + so); }
    __builtin_amdgcn_sched_barrier(0);
#pragma unroll
    for (int d0 = 0; d0 < 4; ++d0) { p0 = __builtin_amdgcn_mfma_f32_32x32x16_bf16(kf[2 * d0], qr[d0], p0, 0, 0, 0); p1 = __builtin_amdgcn_mfma_f32_32x32x16_bf16(kf[2 * d0 + 1], qr[d0], p1, 0, 0, 0); }
    __builtin_amdgcn_sched_barrier(0);
    if (NEAR) {
        pv_mma<4>(o, vp, pa);
#pragma unroll
        for (int r = 0; r < 16; ++r) { const int d0 = qrow - (kmin + crow(r, hi)), d1 = d0 - 32;
            const float b0 = lut[min(max(d0, 0), 127)], b1 = lut[min(max(d1, 0), 127)];
            p0[r] = d0 < 0 ? 0.f : fexp2(p0[r] + b0); p1[r] = d1 < 0 ? 0.f : fexp2(p1[r] + b1); }
        float s = 0.f;
#pragma unroll
        for (int r = 0; r < 16; ++r) s += p0[r] + p1[r];
        l += s;
    } else {
        s16x4 lo[2][4], hi4[2][4];
        const unsigned va = (unsigned)(size_t)vp;
#pragma unroll
        for (int ks = 0; ks < 4; ++ks) { VTR_ASM(lo[0][ks], va, ks * 1024); VTR_ASM(hi4[0][ks], va, ks * 1024 + 512); }
        float s0 = 0.f, s1 = 0.f;
#pragma unroll
        for (int db = 0; db < 4; ++db) {
            if (db + 1 < 4) {
#pragma unroll
                for (int ks = 0; ks < 4; ++ks) { VTR_ASM(lo[(db + 1) & 1][ks], va, (db + 1) * 4096 + ks * 1024); VTR_ASM(hi4[(db + 1) & 1][ks], va, (db + 1) * 4096 + ks * 1024 + 512); }
                if (db & 1) VTR_WAIT(8, 1); else VTR_WAIT(8, 0);
            } else { if (db & 1) VTR_WAIT(0, 1); else VTR_WAIT(0, 0); }
#pragma unroll
            for (int ks = 0; ks < 4; ++ks) o[db] = __builtin_amdgcn_mfma_f32_32x32x16_bf16(pa[ks], PKV(lo[db & 1][ks], hi4[db & 1][ks]), o[db], 0, 0, 0);
#pragma unroll
            for (int r = 4 * db; r < 4 * db + 4; ++r) { p0[r] = fexp2(p0[r]); p1[r] = fexp2(p1[r]); s0 += p0[r]; s1 += p1[r]; }
        }
        l += s0 + s1;
#pragma unroll
        for (int i = 0; i < 16; ++i) { __builtin_amdgcn_sched_group_barrier(0x8, 1, 0); __builtin_amdgcn_sched_group_barrier(0x2, 4, 0); }
        __builtin_amdgcn_sched_barrier(0);
    }
    pack_p(p0, p1, pa);
}
template <int VAR>
__device__ __forceinline__ void diff_unit(Frame& F, int b, int h, int qb, const float* subg, float lam, float lam_init, bf16* Odst) {
    const int lane = F.lane, r32 = lane & 31, hi = lane >> 5, wid = F.wave, js = wid >> 2, wq = wid & 3;
    bf16* DQ = (bf16*)(F.ws + WS_DQ); const bf16* DK = (const bf16*)(F.ws + WS_DK); const bf16* VA = (const bf16*)(F.ws + WS_VA);
    const long rowbase = (long)b * SEQ; const int q0 = qb * 128, qw = q0 + 32 * wq;
    LAS unsigned char* kv = F.lds;
    LAS float* wsf = (LAS float*)(F.lds + WSF_OFF) + wid * 64; const LAS float* lut = (const LAS float*)(F.lds + LUT_OFF) + h * 128;
    const int NT = (q0 + 128) / 64;
    const int krow_ = 8 * wid + (lane >> 3);
    const bf16* k1src = DK + (rowbase + krow_) * 512 + h * 128 + (((lane & 7) ^ ((krow_ >> 1) & 7)) * 8);
    const bf16* vsrc0 = VA + (rowbase + 16 * (wid & 3) + (lane >> 2)) * 512 + h * 128 + (wid >> 2) * 32 + (lane & 3) * 8;
#define DIFF_ISSUE(t, bufi) do { LAS unsigned char* bb_ = kv + (bufi) * 32768; const long ro_ = (long)(t) * 64 * 512; \
        glds(k1src + ro_, bb_ + wid * 1024); glds(k1src + ro_ + 64, bb_ + 8192 + wid * 1024); \
        glds(vsrc0 + ro_, bb_ + 16384 + wid * 1024); glds(vsrc0 + ro_ + 64, bb_ + 16384 + (wid + 8) * 1024); } while (0)
    bf16x8 qr[4];
#pragma unroll
    for (int d0 = 0; d0 < 4; ++d0) qr[d0] = *(const bf16x8*)(DQ + (rowbase + qw + r32) * 512 + h * 128 + js * 64 + d0 * 16 + hi * 8);
    asm volatile("" ::: "memory");
    DIFF_ISSUE(0, 0); DIFF_ISSUE(1, 1);
    if (NT > 2) DIFF_ISSUE(2, 2);
    f32x16 o[4];
#pragma unroll
    for (int i = 0; i < 4; ++i)
#pragma unroll
        for (int r = 0; r < 16; ++r) o[i][r] = 0.f;
    float l = 0.f;
    const float cfar = lut[127];
    if (NT > 2) asm volatile("s_waitcnt vmcnt(8)" ::: "memory"); else asm volatile("s_waitcnt vmcnt(4)" ::: "memory");
    __builtin_amdgcn_s_barrier(); asm volatile("" ::: "memory");
    bf16x8 pa[4];
    diff_first(l, pa, kv + js * 8192, qr, lut, (qw - 63) < 113, cfar, qw + r32, 0, r32, hi);
    if (NT > 2) asm volatile("s_waitcnt vmcnt(4) lgkmcnt(0)" ::: "memory"); else asm volatile("s_waitcnt vmcnt(0) lgkmcnt(0)" ::: "memory");
    __builtin_amdgcn_s_barrier(); asm volatile("" ::: "memory");
    const int NTw = ((qw + 31) >> 6) + 1, tn0 = max(0, (qw - 112) >> 6);
    const int vpo = 16384 + ((lane >> 4) & 1) * 32 + (lane & 3) * 8 + (4 * hi + ((lane & 15) >> 2)) * 64;
#define STEP_PRE(t) if ((t) + 3 < NT) DIFF_ISSUE((t) + 3, ((t) + 3) & 3); \
        const LAS unsigned char* Kn = kv + (((t) + 1) & 3) * 32768 + js * 8192; const LAS unsigned char* Vc = kv + ((t) & 3) * 32768;
#define STEP_POST(t) if ((t) + 3 < NT) asm volatile("s_waitcnt vmcnt(4) lgkmcnt(0)" ::: "memory"); else asm volatile("s_waitcnt vmcnt(0) lgkmcnt(0)" ::: "memory"); \
        __builtin_amdgcn_s_barrier(); asm volatile("" ::: "memory");
    int t = 0;
    const int tA = min(tn0, NTw) - 1;
    for (; t < tA; ++t) { STEP_PRE(t); diff_step<false>(o, l, pa, Kn, Vc + 16384, qr, lut, cfar, qw + r32, 64 * (t + 1), lane, r32, hi); STEP_POST(t); }
    for (; t < NTw - 1; ++t) { STEP_PRE(t); diff_step<true>(o, l, pa, Kn, Vc + 16384, qr, lut, cfar, qw + r32, 64 * (t + 1), lane, r32, hi); STEP_POST(t); }
    { STEP_PRE(t); (void)Kn; pv_mma<4>(o, Vc + vpo, pa); STEP_POST(t); ++t; }
    for (; t < NT; ++t) { STEP_PRE(t); (void)Kn; (void)Vc; STEP_POST(t); }
#undef STEP_PRE
#undef STEP_POST
#undef DIFF_ISSUE
    l += __shfl_xor(l, 32);
    if (hi == 0) wsf[r32] = l;
    LDS_WAIT();
    const float sc = js ? lam : 1.0f;
#pragma unroll
    for (int r = 0; r < 16; ++r) { const float rl = sc * __builtin_amdgcn_rcpf(wsf[crow(r, hi)]);
#pragma unroll
        for (int db = 0; db < 4; ++db) o[db][r] *= rl; }
    LAS float* xch = (LAS float*)(F.lds + wq * 16384);
    if (js) {
#pragma unroll
        for (int db = 0; db < 4; ++db)
#pragma unroll
            for (int r = 0; r < 16; ++r) xch[(db * 16 + r) * 64 + lane] = o[db][r];
    }
    asm volatile("s_waitcnt lgkmcnt(0)" ::: "memory"); __syncthreads();
    if (!js && !(VAR & 32)) diff_epilogue(F, o, xch, subg, lam_init, Odst + (rowbase + qw) * 512 + h * 128);
    asm volatile("s_waitcnt lgkmcnt(0)" ::: "memory"); __syncthreads();
}
__device__ __forceinline__ void diff_epilogue(Frame& F, f32x16 (&o)[4], LAS float* xch, const float* subg, float lam_init, bf16* Ow) {
    int lane = F.lane; asm volatile("" : "+v"(lane));
    const int r32 = lane & 31, hi = lane >> 5;
    float ssq[16];
#pragma unroll
    for (int r = 0; r < 16; ++r) { float s = 0.f;
#pragma unroll
        for (int db = 0; db < 4; ++db) { const float v = o[db][r] - xch[(db * 16 + r) * 64 + lane]; o[db][r] = v; s += v * v; }
        ssq[r] = s; }
#pragma unroll
    for (int r = 0; r < 16; ++r) { float s = ssq[r]; s += __shfl_xor(s, 1); s += __shfl_xor(s, 2); s += __shfl_xor(s, 4); s += __shfl_xor(s, 8); s += __shfl_xor(s, 16);
        ssq[r] = (1.0f - lam_init) * __builtin_amdgcn_rsqf(s * (1.0f / 128.0f) + EPS); }
    float sg[4];
#pragma unroll
    for (int db = 0; db < 4; ++db) sg[db] = subg[32 * db + r32];
    LDS_WAIT();
    LAS bf16* stl = (LAS bf16*)xch;
#pragma unroll
    for (int r = 0; r < 16; ++r) { const int orow = crow(r, hi);
#pragma unroll
        for (int db = 0; db < 4; ++db) stl[orow * 128 + db * 32 + r32] = (bf16)(cvt_pk_bf16(o[db][r] * ssq[r] * sg[db], 0.f) & 0xffffu); }
    LDS_WAIT();
#pragma unroll
    for (int i = 0; i < 8; ++i) { const int row = i * 4 + (lane >> 4), ch = lane & 15; const u32x4 v = *(const LAS u32x4*)(stl + row * 128 + ch * 8); *(u32x4*)(Ow + (long)row * 512 + ch * 8) = v; }
}

template <bool M>
__device__ __forceinline__ bool sb_tile(f32x16 (&o)[2], float& carry, const bf16x8 (&qr)[4], const LAS unsigned char* kp, int ksw, const LAS unsigned char* vp, int hi, int lane, int qrow, int t,
                                        const bf16* ksrc, const bf16* vsrc, LAS unsigned char* kb_, LAS unsigned char* vb_) {
#define SB_ISSUE_K(t_) do { _Pragma("unroll") for (int c = 0; c < 8; ++c) { const int kr_ = 8 * c + (lane >> 3); glds(ksrc + (long)(64 * (t_) + 8 * c) * 512 + (((lane & 7) ^ ((kr_ >> 1) & 7)) * 8), kb_ + c * 1024); } } while (0)
#define SB_ISSUE_V(t_) do { _Pragma("unroll") for (int p = 0; p < 8; ++p) glds(vsrc + (long)(64 * (t_) + 16 * (p & 3)) * 512 + (p >> 2) * 32, vb_ + p * 1024); } while (0)
    {
        const int kmin = 64 * t;
        asm volatile("s_waitcnt vmcnt(8)" ::: "memory");
        bf16x8 kf[8];
#pragma unroll
        for (int d0 = 0; d0 < 4; ++d0) { const int so = (((2 * d0 + hi) ^ ksw) << 4); kf[2 * d0] = *(const LAS bf16x8*)(kp + so); kf[2 * d0 + 1] = *(const LAS bf16x8*)(kp + 4096 + so); }
        asm volatile("s_waitcnt lgkmcnt(0)" ::: "memory");
        if (t > 0) SB_ISSUE_K(t - 1);
        f32x16 p0, p1;
#pragma unroll
        for (int r = 0; r < 16; ++r) { p0[r] = 0.f; p1[r] = 0.f; }
#pragma unroll
        for (int d0 = 0; d0 < 4; ++d0) { p0 = __builtin_amdgcn_mfma_f32_32x32x16_bf16(kf[2 * d0], qr[d0], p0, 0, 0, 0); p1 = __builtin_amdgcn_mfma_f32_32x32x16_bf16(kf[2 * d0 + 1], qr[d0], p1, 0, 0, 0); }
        float Lb[8][4], T_own[8], T_oth[8];
#pragma unroll
        for (int i = 0; i < 8; ++i) {
#pragma unroll
            for (int e = 0; e < 4; ++e) { const float y = (i < 4) ? p0[4 * i + e] : p1[4 * (i - 4) + e]; const int key = kmin + 8 * i + 4 * hi + e;
                const float sp = fmaxf(y, 0.f) + flog2(1.f + fexp2(-fabsf(y)));
                Lb[i][e] = (!M || key < qrow) ? sp : 0.f; }
            T_own[i] = (Lb[i][0] + Lb[i][1]) + (Lb[i][2] + Lb[i][3]);
        }
#pragma unroll
        for (int i = 0; i < 8; ++i) T_oth[i] = __shfl_xor(T_own[i], 32);
        float after = carry;
#pragma unroll
        for (int i = 7; i >= 0; --i) {
            const float off = after + (hi == 0 ? T_oth[i] : 0.f);
            after += T_own[i] + T_oth[i];
            float suf = off;
#pragma unroll
            for (int e = 3; e >= 0; --e) { const float y = (i < 4) ? p0[4 * i + e] : p1[4 * (i - 4) + e]; const int key = kmin + 8 * i + 4 * hi + e;
                const float a = (!M || key < qrow) ? fexp2(y - Lb[i][e] - suf) : 0.f; suf += Lb[i][e];
                if (i < 4) p0[4 * i + e] = a; else p1[4 * (i - 4) + e] = a; }
        }
        carry = after;
        bf16x8 pa[4]; pack_p(p0, p1, pa);
        if (t > 0) asm volatile("s_waitcnt vmcnt(8)" ::: "memory"); else asm volatile("s_waitcnt vmcnt(0)" ::: "memory");
        pv_mma<2>(o, vp, pa);
        asm volatile("s_waitcnt lgkmcnt(0)" ::: "memory");
#if SB_EARLY_EXIT
        if (__all(carry > SB_EXIT_LOG2)) return true;
#endif
        if (t > 0) SB_ISSUE_V(t - 1);
        return false;
    }
#undef SB_ISSUE_K
#undef SB_ISSUE_V
}

__device__ __forceinline__ void sb_unit(Frame& F, int b, int h, int blk) {
    const int lane = F.lane, r32 = lane & 31, hi = lane >> 5, wid = F.wave;
    bf16* SBQ = (bf16*)(F.ws + WS_SBQ); const bf16* SBK = (const bf16*)(F.ws + WS_SBK); const bf16* SBV = (const bf16*)(F.ws + WS_SBV);
    const long rowbase = (long)b * SEQ; const int qw = 32 * blk; const int qrow = qw + r32;
    LAS unsigned char* kb_ = F.lds + wid * 16384; LAS unsigned char* vb_ = kb_ + 8192;
    bf16x8 qr[4];
#pragma unroll
    for (int d0 = 0; d0 < 4; ++d0) qr[d0] = *(const bf16x8*)(SBQ + (rowbase + qrow) * 512 + h * 64 + d0 * 16 + hi * 8);
    f32x16 o[2];
#pragma unroll
    for (int i = 0; i < 2; ++i)
#pragma unroll
        for (int r = 0; r < 16; ++r) o[i][r] = 0.f;
    float carry = 0.f;
    const bf16* ksrc = SBK + (rowbase + (lane >> 3)) * 512 + h * 64;
    const bf16* vsrc = SBV + (rowbase + (lane >> 2)) * 512 + h * 64 + (lane & 3) * 8;
    const LAS unsigned char* kp = kb_ + r32 * 128; const int ksw = (r32 >> 1) & 7;
    const LAS unsigned char* vp = vb_ + ((lane >> 4) & 1) * 32 + (lane & 3) * 8 + (4 * hi + ((lane & 15) >> 2)) * 64;
#define SB_ISSUE_K(t_) do { _Pragma("unroll") for (int c = 0; c < 8; ++c) { const int kr_ = 8 * c + (lane >> 3); glds(ksrc + (long)(64 * (t_) + 8 * c) * 512 + (((lane & 7) ^ ((kr_ >> 1) & 7)) * 8), kb_ + c * 1024); } } while (0)
#define SB_ISSUE_V(t_) do { _Pragma("unroll") for (int p = 0; p < 8; ++p) glds(vsrc + (long)(64 * (t_) + 16 * (p & 3)) * 512 + (p >> 2) * 32, vb_ + p * 1024); } while (0)
    const int t0 = qw >> 6;
    asm volatile("s_waitcnt lgkmcnt(0)" ::: "memory");
    SB_ISSUE_K(t0); SB_ISSUE_V(t0);
    if (!sb_tile<true>(o, carry, qr, kp, ksw, vp, hi, lane, qrow, t0, ksrc, vsrc, kb_, vb_))
        for (int t = t0 - 1; t >= 0; --t) if (sb_tile<false>(o, carry, qr, kp, ksw, vp, hi, lane, qrow, t, ksrc, vsrc, kb_, vb_)) break;
#undef SB_ISSUE_K
#undef SB_ISSUE_V
    asm volatile("s_waitcnt vmcnt(0) lgkmcnt(0)" ::: "memory");
    LAS bf16* stl = (LAS bf16*)kb_;
#pragma unroll
    for (int r = 0; r < 16; ++r) { const int orow = crow(r, hi);
#pragma unroll
        for (int db = 0; db < 2; ++db) stl[orow * 64 + db * 32 + r32] = (bf16)(cvt_pk_bf16(o[db][r], 0.f) & 0xffffu); }
    LDS_WAIT();
    bf16* Ow = SBQ + (rowbase + qw) * 512 + h * 64;
#pragma unroll
    for (int i = 0; i < 4; ++i) { const int row = i * 8 + (lane >> 3), ch = lane & 7; const u32x4 v = *(const LAS u32x4*)(stl + row * 64 + ch * 8); *(u32x4*)(Ow + (long)row * 512 + ch * 8) = v; }
    asm volatile("s_waitcnt lgkmcnt(0)" ::: "memory");
}

__device__ __forceinline__ int t5_bucket(int n) {
    if (n < 16) return n;
    int b = 16;
    const int thr[15] = {19, 21, 24, 27, 31, 35, 40, 46, 52, 59, 67, 77, 87, 99, 113};
#pragma unroll
    for (int j = 0; j < 15; ++j) b += (n >= thr[j]) ? 1 : 0;
    return b;
}

__device__ __forceinline__ void attention_phase(Frame& F, int l) {
    const float* relb = KIN(1); const float* gq = KIN(4) + l * 64; const float* gk = KIN(5) + l * 64;
    LAS float* scal = (LAS float*)(F.lds + WSF_OFF);
    if (F.wave == 0) { const int d = F.lane;
        float a1 = KIN(6)[l * 64 + d] * KIN(7)[l * 64 + d], a2 = KIN(8)[l * 64 + d] * KIN(9)[l * 64 + d], mq = fabsf(gq[d]), mk = fabsf(gk[d]);
        a1 = wave_sum(a1); a2 = wave_sum(a2);
#pragma unroll
        for (int o = 1; o < 64; o <<= 1) { mq = fmaxf(mq, __shfl_xor(mq, o)); mk = fmaxf(mk, __shfl_xor(mk, o)); }
        if (d == 0) { scal[0] = a1; scal[1] = a2; scal[2] = mq; scal[3] = mk; } }
    if (F.tid >= 64 && F.tid < 192) scal[16 + F.tid - 64] = relb[F.tid - 64];
    __syncthreads();
    const float s1 = scal[0], s2 = scal[1], gqm = scal[2], gkm = scal[3];
    const float lam_init = 0.8f - 0.6f * expf(-0.3f * (float)l);
    const float lam = expf(s1) - expf(s2) + lam_init;
    float lutv;
    {
        const int h = F.tid >> 7, d = F.tid & 127; float mb = -3.0e38f;
        for (int bkt = 0; bkt < 32; ++bkt) mb = fmaxf(mb, scal[16 + bkt * 4 + h]);
        const float M = 8.f * gqm * gkm + mb;
        lutv = (scal[16 + t5_bucket(d) * 4 + h] - M) * LOG2E;
    }
    __syncthreads();
    ((LAS float*)(F.lds + LUT_OFF))[F.tid] = lutv;
    __syncthreads();
    const float* subg = KIN(10) + l * 128;
#ifndef ATT_MASK
#define ATT_MASK 3
#endif
#ifndef DIFF_VARIANT
#define DIFF_VARIANT -1
#endif
    if (DIFF_VARIANT >= 0) { for (int i = 0;; ++i) { const long L = (long)i * F.G + F.vcu; if (L >= 1024) break;
        const int Lm = (int)(L & 255), bh = Lm >> 3, s = Lm & 7, k = (int)(L >> 8), qb = (k == 0) ? 31 - s : (k == 1) ? 16 + s : (k == 2) ? 15 - s : s;
        diff_unit<(DIFF_VARIANT >= 0 ? DIFF_VARIANT : 0)>(F, bh >> 2, bh & 3, qb, subg, lam, lam_init, (bf16*)(F.ws + WS_XB)); }
        __syncthreads(); }
    PB_START(10);
    const int vcu = F.vcu;
    if (ATT_MASK & 1) for (int i = 0;; ++i) { const long L = (long)i * F.G + vcu; if (L >= 1024) break;
        const int Lm = (int)(L & 255), bh = Lm >> 3, s = Lm & 7, k = (int)(L >> 8), qb = (k == 0) ? 31 - s : (k == 1) ? 16 + s : (k == 2) ? 15 - s : s;
        diff_unit<0>(F, bh >> 2, bh & 3, qb, subg, lam, lam_init, (bf16*)(F.ws + WS_DQ)); }
    __syncthreads();
    PB_END(10);
    PB_START(11);
    const int gw = F.vcu * NWAVES + F.wave, NGW = F.G * NWAVES;
    if (ATT_MASK & 2) for (int i = 0;; ++i) { int bh, x;
        if (F.G == 256) { const int xg = F.vcu >> 5, lw = (F.vcu & 31) * NWAVES + F.wave, pp = (i >> 1) * 256 + lw; if (pp >= 512) break; bh = 8 * xg + (pp >> 6); x = pp & 63; }
        else { const long p = (long)(i >> 1) * NGW + gw; if (p >= 4096) break; bh = (int)(p >> 6); x = (int)(p & 63); }
        const int blk = (i & 1) ? 127 - x : x;
        sb_unit(F, bh >> 3, bh & 7, blk); }
    __syncthreads();
    PB_END(11);
}

constexpr int NPHASE = 1 + 8 * DEPTH;
__global__ void __launch_bounds__(NWAVES * 64, 2) mk_fwd(Args args) {
    extern __shared__ __attribute__((aligned(16))) unsigned char lds_raw[];
    Frame F;
    F.lds = (LAS unsigned char*)lds_raw;
    F.MISC = (volatile LAS unsigned*)(F.lds + MISC_OFF);
    F.tid = threadIdx.x; F.lane = F.tid & 63; F.wave = __builtin_amdgcn_readfirstlane(F.tid >> 6); F.G = gridDim.x;
    F.ws = args.ws; F.ctl = (gu32*)(args.ws + WS_CTL); F.out = args.out;
    for (int u = F.tid; u < (LDS_BYTES - LDSCTL_OFF) / 4; u += NWAVES * 64) ((LAS unsigned*)(F.lds + LDSCTL_OFF))[u] = 0u;
    __syncthreads();
    const unsigned my_xcc = xb_xcc_id(); unsigned my_rank = 0;
    if (F.tid == 0) my_rank = __hip_atomic_fetch_add((unsigned*)(F.ctl + CW_XRANK) + my_xcc, 1u, RLX_AGENT);
    my_rank = (unsigned)__builtin_amdgcn_readfirstlane((int)my_rank);
    if (F.tid == 0) ((volatile LAS unsigned*)(F.lds + MISC_OFF))[12] = my_rank;
    __syncthreads();
    my_rank = ((volatile LAS unsigned*)(F.lds + MISC_OFF))[12];
    F.vcu = (int)blockIdx.x; F.cx = (int)blockIdx.x; F.local_ok = 0;
    XcdBarrier bar; bar.bar = (unsigned*)(F.ctl + CW_BAR); bar.x = 0; bar.st = nullptr;
    if (!MK_SPLIT) bar = xcd_barrier_post((unsigned*)(F.ctl + CW_BAR), F.MISC + 8);
    F.pb_t0 = 0; F.pb_acc = 0;
    const int lo = args.ph_lo, hi = args.ph_hi;
#define IN(k) (lo <= (k) && (k) < hi)
#define SEAM(k) do { if (IN(k) && IN((k) + 1)) xcd_barrier(bar); } while (0)
#define SEAM_L(k) do { if (IN(k) && IN((k) + 1)) { if (F.local_ok) xcc_barrier((unsigned*)(F.ctl + CW_LBAR), my_xcc, (unsigned)F.G / 8u, (unsigned*)(F.ctl + CW_BAR) + XB_TMO); else xcd_barrier(bar); } } while (0)
#define REFRESH() int gw, NGW, c; do { int t_ = threadIdx.x; asm volatile("" : "+v"(t_)); F.tid = t_; F.lane = t_ & 63; F.wave = __builtin_amdgcn_readfirstlane(t_ >> 6); \
        gw = F.vcu * NWAVES + F.wave; NGW = F.G * NWAVES; c = F.cx; (void)gw; (void)NGW; (void)c; } while (0)

    PB_START(0);
    if (PH_ON(0) && IN(0)) { REFRESH();
        convert_small_weights(F, gw, NGW);
        convert_moe_weights(F, 0, gw, NGW);
        rows_phase<false, false, false, true>(F, KIN(0), nullptr, 2 * gw, 2 * NGW, T);
    }
    SEAM(0);
    PB_END(0);
    if (!MK_SPLIT) {
        LAS unsigned* xc = (LAS unsigned*)(F.lds + WSF_OFF);
        if (F.tid < 16) xc[F.tid] = __hip_atomic_load((unsigned*)(F.ctl + CW_XRANK) + F.tid, RLX_AGENT);
        __syncthreads();
        unsigned pre = 0, tot = 0, uni = 1u;
#pragma unroll
        for (unsigned j = 0; j < 16; ++j) { const unsigned cj = xc[j]; pre += (j < my_xcc) ? cj : 0u; tot += cj; uni &= (cj == 0u || cj * 8u == (unsigned)F.G) ? 1u : 0u; }
        F.local_ok = (uni && tot == (unsigned)F.G && F.G == 256) ? 1 : 0;
        if (tot == (unsigned)F.G) { F.vcu = (int)(pre + my_rank); const int per = F.G / 8; F.cx = (F.G % 8 == 0) ? (F.vcu % per) * 8 + F.vcu / per : F.vcu; }
        __syncthreads(); }
#pragma nounroll
    for (int l = 0; l < DEPTH; ++l) {
        const int pb = 1 + 8 * l;
        PB_START(1);
        if (PH_ON(1) && IN(pb + 0)) {   REFRESH();
            SchedPlain S{(const char*)(F.ws + WS_XB), (const char*)(F.ws + WS_WIN_T) + (size_t)l * NIN * D * 2, 128, 20, D, F.G, c, (const int*)(F.ws + WS_RSTD1), nullptr};
            LAS float* gl = (LAS float*)(F.lds + LUT_OFF);
            if (F.tid < 128) gl[F.tid] = (F.tid < 64) ? KIN(4)[l * 64 + F.tid] * C2 : KIN(5)[l * 64 + F.tid - 64];
            __syncthreads();
            EpiInProj E{F.ws, gl, (const LAS float*)(F.lds + AUX_OFF)};
            pg8::gemm_phase<EpiInProj, SchedPlain>(F.lds, D, S, E);
        }
        SEAM_L(pb + 0);
        PB_END(1);
        PB_START(2);
        if (PH_ON(2) && IN(pb + 1)) { REFRESH(); attention_phase(F, l); }
        SEAM_L(pb + 1);
        PB_END(2);
        PB_START(3);
        if (PH_ON(3) && IN(pb + 2)) {   REFRESH();
            SchedBranch S{(const char*)(F.ws + WS_DQ), (const char*)(F.ws + WS_SBQ), (const char*)(F.ws + WS_WBD_T) + (size_t)l * D * 512 * 2, (const char*)(F.ws + WS_WBS_T) + (size_t)l * D * 512 * 2, F.G, c};
            EpiBranch E{(const unsigned char*)(F.ws + WS_G1), (bf16*)(F.ws + WS_MIXED)};
            pg8::gemm_phase<EpiBranch, SchedBranch>(F.lds, 512, S, E);
        }
        SEAM_L(pb + 2);
        PB_END(3);
        PB_START(4);
        if (PH_ON(4) && IN(pb + 3)) {   REFRESH();
            SchedPlain S{(const char*)(F.ws + WS_MIXED), (const char*)(F.ws + WS_WOUT_T) + (size_t)l * D * D * 2, 128, 4, D, F.G, c};
            EpiOutProj E{(bf16*)(F.ws + WS_XB), (unsigned char*)(F.ws + WS_XB8)};
            pg8::gemm_phase<EpiOutProj, SchedPlain>(F.lds, D, S, E);
        }
        SEAM_L(pb + 3);
        PB_END(4);
        PB_START(5);
        if (PH_ON(5) && IN(pb + 4)) { REFRESH(); router_phase(F, l); }
        SEAM(pb + 4);
        PB_END(5);
        PB_START(7);
        if (PH_ON(7) && IN(pb + 5)) {   REFRESH();
            build_ust(F, l);
            SchedMoe<true> S{(const char*)(F.ws + WS_XB8), (const char*)(F.ws + WS_WGU_T), (const LAS int*)(F.lds + MOE_OFF), (const int*)(F.ws + WS_ENT_TOK), (const int*)(F.ws + WS_ENT_RS), nullptr, D / 2, (size_t)1024 * 1024, F.G, c};
            EpiMoe1 E{(const LAS float*)(F.lds + AUX_OFF), (unsigned char*)(F.ws + WS_ACT)};
            pg8::gemm_phase<EpiMoe1, SchedMoe<true>>(F.lds, D / 2, S, E);
        }
        SEAM_L(pb + 5);
        PB_END(7);
        PB_START(8);
        if (PH_ON(8) && IN(pb + 6)) {   REFRESH();
            build_ust(F, l);
            SchedMoe<false> S{(const char*)(F.ws + WS_ACT), (const char*)(F.ws + WS_WDN_T), (const LAS int*)(F.lds + MOE_OFF), (const int*)(F.ws + WS_IDENT), (const int*)(F.ws + WS_ENT_TOK), (const int*)(F.ws + WS_ENT_W), DFF / 2, (size_t)1024 * 512, F.G, c};
            EpiMoe2 E{(const LAS int*)(F.lds + AUX_OFF), (unsigned char*)(F.ws + WS_CONTRIB)};
            pg8::gemm_phase<EpiMoe2, SchedMoe<false>>(F.lds, DFF / 2, S, E);
        }
        SEAM(pb + 6);
        PB_END(8);
        PB_START(9);
        if (PH_ON(9) && IN(pb + 7)) {   REFRESH();
            const int per = F.G / 8, xg = F.vcu / per, lw = (F.vcu % per) * NWAVES + F.wave; const bool al = (F.G == 256);
            const int mf = al ? 4096 * xg + 2 * lw : 2 * gw, ms = al ? 512 : 2 * NGW, me = al ? 4096 * xg + 4096 : T;
            if (l + 1 < DEPTH) { rows_phase<true, true, false, true>(F, nullptr, nullptr, mf, ms, me); convert_moe_weights(F, l + 1, gw, NGW); }
            else rows_phase<true, true, true, false>(F, nullptr, F.out, mf, ms, me);
        }
        if (l + 1 < DEPTH) SEAM_L(pb + 7);
        PB_END(9);
    }
    if (PROBE_TYPE >= 0 && blockIdx.x == 0 && threadIdx.x == 0) { const unsigned long long te = __builtin_amdgcn_s_memrealtime();
        while (__builtin_amdgcn_s_memrealtime() - te < PROBE_AMP * F.pb_acc) __builtin_amdgcn_s_sleep(8); }
#undef IN
#undef SEAM
}

extern "C" void kernel_launch(void* const* d_in, const int* in_sizes, int n_in, void* d_out, int out_size, void* d_ws, size_t ws_size, hipStream_t stream) {
    static int grid = 0;
    if (grid == 0) {
        if (n_in != 20 || in_sizes[0] != T * D || out_size != T * D || ws_size < WS_END) { fprintf(stderr, "kernel_launch: unexpected shapes / workspace (n_in %d, ws %zu, need %zu)\n", n_in, ws_size, (size_t)WS_END); grid = -1; return; }
        int dev = 0, cus = 0, per_cu = 0;
        if (hipGetDevice(&dev) != hipSuccess || hipDeviceGetAttribute(&cus, hipDeviceAttributeMultiprocessorCount, dev) != hipSuccess) { grid = -1; return; }
        if (hipFuncSetAttribute((const void*)mk_fwd, hipFuncAttributeMaxDynamicSharedMemorySize, LDS_BYTES) != hipSuccess) { fprintf(stderr, "kernel_launch: hipFuncSetAttribute failed\n"); grid = -1; return; }
        if (hipOccupancyMaxActiveBlocksPerMultiprocessor(&per_cu, (const void*)mk_fwd, NWAVES * 64, LDS_BYTES) != hipSuccess || per_cu < 1) fprintf(stderr, "kernel_launch: occupancy query reports %d\n", per_cu);
        (void)hipGetLastError();
        grid = cus;
    }
    if (grid < 0) return;
    if (hipMemsetAsync((char*)d_ws + WS_CTL, 0, CTL_ZERO_BYTES, stream) != hipSuccess) return;
    Args a{};
    for (int i = 0; i < 20; ++i) a.in[i] = (const float*)d_in[i];
    a.out = (float*)d_out; a.ws = (unsigned char*)d_ws;
#if MK_SPLIT
    for (int p = 0; p < NPHASE; ++p) { a.ph_lo = p; a.ph_hi = p + 1; hipLaunchKernelGGL(mk_fwd, dim3(grid), dim3(NWAVES * 64), LDS_BYTES, stream, a); }
#else
    a.ph_lo = 0; a.ph_hi = NPHASE;
    hipLaunchKernelGGL(mk_fwd, dim3(grid), dim3(NWAVES * 64), LDS_BYTES, stream, a);
#endif
}
```

```cpp
#include <hip/hip_runtime.h>
#include <cstdio>
#include <cstdint>

#define GAS __attribute__((address_space(1)))
#define LAS __attribute__((address_space(3)))
typedef unsigned short bf16;
typedef short bf16x8 __attribute__((ext_vector_type(8)));
typedef short s16x4 __attribute__((ext_vector_type(4)));
typedef short v4i16_t __attribute__((ext_vector_type(4)));
typedef float f32x2 __attribute__((ext_vector_type(2)));
typedef float f32x4 __attribute__((ext_vector_type(4)));
typedef float f32x16 __attribute__((ext_vector_type(16)));
typedef unsigned u32x2 __attribute__((ext_vector_type(2)));
typedef unsigned u32x4 __attribute__((ext_vector_type(4)));
typedef int v4i_t __attribute__((ext_vector_type(4)));
typedef GAS unsigned gu32;

constexpr int T = 32768, SEQ = 4096, NB = 8, D = 1024, NIN = 5120, DEPTH = 2;
constexpr int NE = 32, DFF = 512;
constexpr float EPS = 1e-6f;
constexpr float LOG2E = 1.4426950408889634f;
constexpr float C2 = 0.125f * LOG2E;
constexpr int NWAVES = 8;
#ifndef SB_EARLY_EXIT
#define SB_EARLY_EXIT 1
#endif
#define SB_EXIT_LOG2 64.f
#ifndef MK_SPLIT
#define MK_SPLIT 0
#endif
#ifndef PH_MASK
#define PH_MASK 0x3ff
#endif
#define PH_ON(k) (((PH_MASK) >> (k)) & 1)
#ifndef PROBE_TYPE
#define PROBE_TYPE -1
#endif
#define PROBE_AMP 8
#define PB_START(k) do { if (PROBE_TYPE == (k)) F.pb_t0 = __builtin_amdgcn_s_memrealtime(); } while (0)
#define PB_END(k) do { if (PROBE_TYPE == (k)) F.pb_acc += __builtin_amdgcn_s_memrealtime() - F.pb_t0; } while (0)

constexpr size_t MiB = 1u << 20;
constexpr size_t WS_CTL = 0, CTL_ZERO_BYTES = 1 * MiB;
constexpr size_t WS_RSTD1 = 1 * MiB;
constexpr size_t WS_IDENT = 2 * MiB;
constexpr size_t WS_WR_T = 5 * MiB;
constexpr size_t WS_WIN_T = 8 * MiB;
constexpr size_t WS_WBD_T = 28 * MiB;
constexpr size_t WS_WBS_T = 30 * MiB;
constexpr size_t WS_WOUT_T = 32 * MiB;
constexpr size_t WS_WGU_T = 36 * MiB;
constexpr size_t WS_WDN_T = 100 * MiB;
constexpr size_t WS_XB = 132 * MiB;
constexpr size_t WS_R0 = 196 * MiB;
constexpr size_t WS_DQ = WS_R0;
constexpr size_t WS_DK = WS_R0 + 32 * MiB;
constexpr size_t WS_VA = WS_R0 + 64 * MiB;
constexpr size_t WS_SBQ = WS_R0 + 96 * MiB;
constexpr size_t WS_SBK = WS_R0 + 128 * MiB;
constexpr size_t WS_SBV = WS_R0 + 160 * MiB;
constexpr size_t WS_G1 = WS_R0 + 192 * MiB;
constexpr size_t WS_MIXED = WS_G1;
constexpr int PMAX = 65536 + 32 * 256;
constexpr size_t WS_ACT = WS_SBK;
constexpr size_t WS_XB8 = WS_DK;
constexpr float W8_SCALE = 64.f, A8_SCALE = 2.f, C8_SCALE = 32.f;
constexpr size_t WS_CONTRIB = WS_G1;
constexpr int ECAP = 32768;
constexpr size_t WS_ENT_TOK = 68 * MiB;
constexpr size_t WS_ENT_W = 72 * MiB;
constexpr size_t WS_ENT_RS = 76 * MiB;
constexpr size_t WS_XB8IN = WS_R0 + 256 * MiB;
constexpr size_t WS_WG8_T = 84 * MiB;
constexpr size_t WS_END = WS_R0 + 288 * MiB;

constexpr int CW_BAR = 4096;
constexpr int CW_LBAR = 20480;
constexpr int CW_XRANK = 12288;
constexpr int CW_CNT = 16384;

constexpr int RING_BYTES = 131072;
constexpr int LDSCTL_OFF = RING_BYTES, MISC_OFF = LDSCTL_OFF + 320;
constexpr int LUT_OFF = LDSCTL_OFF + 512;
constexpr int WSF_OFF = LDSCTL_OFF + 2560;
constexpr int MOE_OFF = LDSCTL_OFF + 4608;
constexpr int AUX_OFF = LDSCTL_OFF + 7680;
constexpr int IDT_OFF = LDSCTL_OFF + 5632;
constexpr int LDS_BYTES = 147456;

#define RLX_AGENT __ATOMIC_RELAXED, __HIP_MEMORY_SCOPE_AGENT
#define LDS_WAIT() asm volatile("s_waitcnt lgkmcnt(0)" ::: "memory")
#define VM_WAIT() asm volatile("s_waitcnt vmcnt(0)" ::: "memory")
__device__ __forceinline__ unsigned cvt_pk_bf16(float lo, float hi) { unsigned r; asm volatile("v_cvt_pk_bf16_f32 %0, %1, %2" : "=v"(r) : "v"(lo), "v"(hi)); return r; }
__device__ __forceinline__ float bf_lo(unsigned w) { return __uint_as_float(w << 16); }
__device__ __forceinline__ float bf_hi(unsigned w) { return __uint_as_float(w & 0xffff0000u); }
__device__ __forceinline__ float wave_sum(float v) {
#pragma unroll
    for (int o = 1; o < 64; o <<= 1) v += __shfl_xor(v, o);
    return v;
}
__device__ __forceinline__ u32x2 pack8_fp8(const float (&a)[8]) {
    int w0 = 0, w1 = 0;
    w0 = __builtin_amdgcn_cvt_pk_fp8_f32(a[0], a[1], w0, false); w0 = __builtin_amdgcn_cvt_pk_fp8_f32(a[2], a[3], w0, true);
    w1 = __builtin_amdgcn_cvt_pk_fp8_f32(a[4], a[5], w1, false); w1 = __builtin_amdgcn_cvt_pk_fp8_f32(a[6], a[7], w1, true);
    u32x2 r; r.x = (unsigned)w0; r.y = (unsigned)w1; return r;
}
__device__ __forceinline__ float fexp2(float x) { return __builtin_amdgcn_exp2f(x); }
__device__ __forceinline__ float flog2(float x) { return __builtin_amdgcn_logf(x); }

#define XB_TMO      128
#define XB_XCNT(j)  (256  + 64 * (j))
#define XB_XSUB(j)  (1280 + 64 * (j))
#define XB_XGEN(j)  (2304 + 64 * (j))
#define XB_TOP      3328
#define XB_TOPGEN   3392
#define XCD_BAR_WORDS 3456
#define XB_SPIN_CAP (1u << 23)
__device__ __forceinline__ unsigned xb_ld(unsigned* p)              { return __hip_atomic_load(p, __ATOMIC_RELAXED, __HIP_MEMORY_SCOPE_AGENT); }
__device__ __forceinline__ unsigned xb_add(unsigned* p, unsigned v) { return __hip_atomic_fetch_add(p, v, __ATOMIC_RELAXED, __HIP_MEMORY_SCOPE_AGENT); }
__device__ __forceinline__ unsigned xb_xcc_id() { return (unsigned)__builtin_amdgcn_s_getreg((3 << 11) | 20) & 0xFu; }
#define XB_SPIN(cond, bar) do { unsigned _sp = 0; while (cond) { __builtin_amdgcn_s_sleep(1); \
    if ((++_sp & 255u) == 0u) { if (xb_ld(&(bar)[XB_TMO])) break; if (_sp > XB_SPIN_CAP) { atomicAdd(&(bar)[XB_TMO], 1u); break; } } } } while (0)
struct XcdBarrier { unsigned* bar; unsigned x; volatile LAS unsigned* st; };
__device__ __forceinline__ XcdBarrier xcd_barrier_post(unsigned* bar, volatile LAS unsigned* st) {
    XcdBarrier b; b.bar = bar; b.x = xb_xcc_id(); b.st = st;
    if (threadIdx.x == 0) (void)xb_add(&bar[XB_XCNT(b.x)], 1u);
    return b;
}
__device__ __forceinline__ void xcd_barrier_complete(unsigned* bar, unsigned x, unsigned& nloc, unsigned& nx) {
    const unsigned G = gridDim.x * gridDim.y * gridDim.z;
    unsigned sum, cnt, mine, sp = 0u;
    for (;;) {
        sum = 0u; cnt = 0u; mine = 0u;
#pragma unroll
        for (unsigned j = 0; j < 16; ++j) { const unsigned c = xb_ld(&bar[XB_XCNT(j)]); sum += c; cnt += (c > 0u) ? 1u : 0u; mine = (j == x) ? c : mine; }
        if (sum == G) break;
        __builtin_amdgcn_s_sleep(1);
        if ((++sp & 255u) == 0u) { if (xb_ld(&bar[XB_TMO])) break; if (sp > XB_SPIN_CAP) { atomicAdd(&bar[XB_TMO], 1u); break; } }
    }
    nloc = mine > 0u ? mine : 1u; nx = cnt > 0u ? cnt : 1u;
}
__device__ __forceinline__ void xcd_barrier(const XcdBarrier& b) {
    asm volatile("s_waitcnt vmcnt(0)" ::: "memory");
    __syncthreads();
    if (threadIdx.x == 0) {
        unsigned* bar = b.bar;
        __builtin_amdgcn_s_waitcnt(0);
        unsigned nloc = b.st[0], nx = b.st[1];
        if (nloc == 0u) { xcd_barrier_complete(bar, b.x, nloc, nx); b.st[0] = nloc; b.st[1] = nx; }
        const unsigned old = xb_add(&bar[XB_XSUB(b.x)], 1u);
        const unsigned gen = old / nloc;
        if (old + 1u == (gen + 1u) * nloc) {
            __builtin_amdgcn_fence(__ATOMIC_RELEASE, "agent");
            asm volatile("s_waitcnt vmcnt(0)" ::: "memory");
            const unsigned og = xb_add(&bar[XB_TOP], 1u);
            const unsigned tg = og / nx;
            if (og + 1u == (tg + 1u) * nx) xb_add(&bar[XB_TOPGEN], 1u);
            else XB_SPIN(xb_ld(&bar[XB_TOPGEN]) == tg, bar);
            __builtin_amdgcn_fence(__ATOMIC_ACQUIRE, "agent");
            xb_add(&bar[XB_XGEN(b.x)], 1u);
            asm volatile("s_waitcnt vmcnt(0)" ::: "memory");
        } else {
            XB_SPIN(xb_ld(&bar[XB_XGEN(b.x)]) == gen, bar);
            __builtin_amdgcn_fence(__ATOMIC_ACQUIRE, "agent");
            asm volatile("s_waitcnt vmcnt(0)" ::: "memory");
        }
    }
    __syncthreads();
}

__device__ __forceinline__ void xcc_barrier(unsigned* lb, unsigned x, unsigned nloc, unsigned* tmo) {
    asm volatile("s_waitcnt vmcnt(0)" ::: "memory");
    __syncthreads();
    if (threadIdx.x == 0) {
        const unsigned old = xb_add(&lb[64 * x], 1u), gen = old / nloc;
        if (old + 1u == (gen + 1u) * nloc) xb_add(&lb[1024 + 64 * x], 1u);
        else { unsigned sp = 0; while (xb_ld(&lb[1024 + 64 * x]) == gen) { __builtin_amdgcn_s_sleep(1);
                   if ((++sp & 255u) == 0u) { if (xb_ld(tmo)) break; if (sp > XB_SPIN_CAP) { atomicAdd(tmo, 1u); break; } } } }
        __builtin_amdgcn_fence(__ATOMIC_ACQUIRE, "agent");
        asm volatile("s_waitcnt vmcnt(0)" ::: "memory");
    }
    __syncthreads();
}

namespace pg8 {
constexpr int BM = 256, BK = 64, HALF = 128, HTB = HALF * BK * 2, STAGE_BYTES = 8 * HTB, NXCD = 8, WGM = 8;
__host__ __device__ __forceinline__ int lds_byte(int r, int c) { const int st = (r >> 4) * 2 + (c >> 5), rr = r & 15, cc = c & 31, ob = rr * 64 + cc * 2; return st * 1024 + (ob ^ (((ob >> 9) & 1) << 5)); }
__host__ __device__ __forceinline__ void stage_rc(int b, int& R, int& C) { const int st = b / 1024, sb = b % 1024, swz = sb ^ (((sb >> 9) & 1) << 5); R = (st >> 1) * 16 + swz / 64; C = (st & 1) * 32 + (swz % 64) / 2; }
__host__ __device__ __forceinline__ int perm32(int rho) { const int n = rho >> 4, i = rho & 15; return 8 * (i >> 2) + 4 * n + (i & 3); }

struct Unit { const char* A; const char* B; int pm, pn, kind, eoff, nvalid, goff, gnv, slot; };
constexpr int KEEP = 0x100;

__device__ __forceinline__ void tile_order(int L, int nM, int nN, int& pm, int& pn) {
    const int nwg = nM * nN; int wgid = L;
    { const int q = nwg / NXCD, r = nwg % NXCD, xcd = wgid % NXCD, off = wgid / NXCD; wgid = (xcd < r ? xcd * (q + 1) : r * (q + 1) + (xcd - r) * q) + off; }
    const int nig = WGM * nN, gid = wgid / nig, fm = gid * WGM, gsz = (nM - fm) < WGM ? (nM - fm) : WGM;
    pm = fm + ((wgid % nig) % gsz); pn = (wgid % nig) / gsz;
}

template <class Epi, class Sched, bool ALIGN_EPI = true, bool SP2 = true>
__device__ __forceinline__ void gemm_phase(LAS unsigned char* lds, const int K_, const Sched& S, const Epi& E, unsigned long long* pb = nullptr) {
    int tid_ = threadIdx.x; asm volatile("" : "+v"(tid_));
    const int tid = tid_, wid = __builtin_amdgcn_readfirstlane(tid >> 6), lane = tid & 63, wr = wid >> 2, wc = wid & 3, fr = lane & 15, fq = lane >> 4;
    int K = K_; asm volatile("" : "+s"(K));
    const int nt = K / BK;
    unsigned voffA[2], voffB[2]; int gR[2]; unsigned gC[2];
#pragma unroll
    for (int i = 0; i < 2; ++i) { int R, C; stage_rc(tid * 16 + i * 8192, R, C); const int Rb = Epi::PERM ? ((R & ~31) + perm32(R & 31)) : R;
        voffA[i] = (unsigned)(R * K + C) * 2u; voffB[i] = (unsigned)(Rb * K + C) * 2u; gR[i] = R; gC[i] = (unsigned)C * 2u; }
    unsigned voffG[2][2]; (void)gR; (void)gC;
    LAS int* idtab = (LAS int*)(lds + STAGE_BYTES + (IDT_OFF - RING_BYTES));
#define PG8_IDS_DMA(u_, slot) do { if (wid < 4) { int t_ = tid; asm volatile("" : "+v"(t_));   \
        __builtin_amdgcn_global_load_lds((const unsigned*)(S.ids + (u_).goff + t_), (LAS unsigned*)(idtab + (slot) * 256 + wid * 64), 4, 0, 0); } } while (0)
    LAS int* auxt = (LAS int*)(lds + STAGE_BYTES + (AUX_OFF - RING_BYTES));
#define PG8_AUX_DMA(u_) do { if (wid < 4) { int t_ = tid; asm volatile("" : "+v"(t_)); \
        if (S.aux0) __builtin_amdgcn_global_load_lds((const unsigned*)(S.aux0 + (u_).eoff + t_), (LAS unsigned*)(auxt + (u_).slot * 256 + wid * 64), 4, 0, 0); \
        if (S.aux1) __builtin_amdgcn_global_load_lds((const unsigned*)(S.aux1 + (u_).eoff + t_), (LAS unsigned*)(auxt + 768 + (u_).slot * 256 + wid * 64), 4, 0, 0); } } while (0)
#define PG8_IDS_READ(u_, slot) do { _Pragma("unroll") for (int i_ = 0; i_ < 2; ++i_) { int g_ = gR[i_]; asm volatile("" : "+v"(g_)); _Pragma("unroll") for (int h_ = 0; h_ < 2; ++h_) { const int r_ = h_ * 128 + g_; int id_ = idtab[(slot) * 256 + r_]; \
        id_ = (r_ < (u_).gnv) ? (id_ >> 1) : 0; voffG[h_][i_] = (unsigned)id_ * (unsigned)(K * 2) + gC[i_]; } } } while (0)
#define PG8_STAGE_A(buf, h, gbase) do { if constexpr (Sched::GATHER) { PG8_STAGE(PG8_SA(buf, h), gbase, voffG[h]); } else { PG8_STAGE(PG8_SA(buf, h), (gbase) + (h) * hstep, voffA); } } while (0)
    const size_t kstep = (size_t)(BK * 2);
    const size_t hstep = (size_t)HALF * K * 2;
    const unsigned ldsw = (unsigned)wid * 1024u;
    constexpr bool F8 = Sched::FP8;
    const int aoff = lds_byte(wr * 64 + fr, fq * 8), boff = lds_byte(wc * 32 + fr, fq * 8);
    constexpr int KSTEP = 1024;
#define PG8_SA(b, h) (((b) * 2 + (h)) * HTB)
#define PG8_SB(b, h) ((4 + (b) * 2 + (h)) * HTB)
#define PG8_STAGE(bufoff, gbase, voff) do { _Pragma("unroll") for (int _i = 0; _i < 2; ++_i) \
        __builtin_amdgcn_global_load_lds((const unsigned*)((const char*)(gbase) + (voff)[_i]), (LAS unsigned*)(lds + (bufoff) + ldsw + _i * 8192), 16, 0, 0); } while (0)
#define PG8_LDA(dst, b, h) do { _Pragma("unroll") for (int m = 0; m < 4; ++m) _Pragma("unroll") for (int k = 0; k < 2; ++k) dst[m][k] = *(const LAS bf16x8*)(lds + PG8_SA(b, h) + aoff + m * 2048 + k * KSTEP); } while (0)
#define PG8_LDB(dst, b, h) do { _Pragma("unroll") for (int n = 0; n < 2; ++n) _Pragma("unroll") for (int k = 0; k < 2; ++k) dst[n][k] = *(const LAS bf16x8*)(lds + PG8_SB(b, h) + boff + n * 2048 + k * KSTEP); } while (0)
#define PG8_CAT(x) __builtin_shufflevector(__builtin_bit_cast(v4i_t, (x)[0]), __builtin_bit_cast(v4i_t, (x)[1]), 0, 1, 2, 3, 4, 5, 6, 7)
#define PG8_MMA(ai, bj, At, Bt) do { __builtin_amdgcn_s_setprio(1); if constexpr (F8) { _Pragma("unroll") for (int m = 0; m < 4; ++m) _Pragma("unroll") for (int n = 0; n < 2; ++n) \
        acc[ai][bj][m][n] = __builtin_amdgcn_mfma_scale_f32_16x16x128_f8f6f4(PG8_CAT(Bt[n]), PG8_CAT(At[m]), acc[ai][bj][m][n], 0, 0, 0, 0x7f7f7f7f, 0, 0x7f7f7f7f); } else { \
        _Pragma("unroll") for (int m = 0; m < 4; ++m) _Pragma("unroll") for (int n = 0; n < 2; ++n) _Pragma("unroll") for (int k = 0; k < 2; ++k) \
        acc[ai][bj][m][n] = __builtin_amdgcn_mfma_f32_16x16x32_bf16(Bt[n][k], At[m][k], acc[ai][bj][m][n], 0, 0, 0); } __builtin_amdgcn_s_setprio(0); } while (0)
#define PG8_WAIT_V(n) asm volatile("s_waitcnt vmcnt(" #n ")" ::: "memory")
#define PG8_WAIT_L(n) asm volatile("s_waitcnt lgkmcnt(" #n ")" ::: "memory")
#define PG8_BAR __builtin_amdgcn_s_barrier()
#define PG8_SCHED __builtin_amdgcn_sched_barrier(0)
    Unit cur, nxt; int ui = 0;
    if (!S.next(0, cur)) return;
    f32x4 acc[2][2][4][2];
#pragma unroll
    for (int a = 0; a < 2; ++a)
#pragma unroll
        for (int b = 0; b < 2; ++b)
#pragma unroll
            for (int m = 0; m < 4; ++m)
#pragma unroll
                for (int n = 0; n < 2; ++n) acc[a][b][m][n] = (f32x4){0.f, 0.f, 0.f, 0.f};
    bf16x8 At[4][2], B0[2][2], B1[2][2];
    const char* cA = cur.A; const char* cB = cur.B;
    static_assert(SP2, "only the SP2 loop is kept here");
    cur.slot = 0;
    if constexpr (Sched::GATHER) { PG8_IDS_DMA(cur, 0); PG8_AUX_DMA(cur); PG8_WAIT_V(0); __syncthreads(); PG8_IDS_READ(cur, 0); }
    else if (S.aux0) { PG8_AUX_DMA(cur); PG8_WAIT_V(0); __syncthreads(); }
    PG8_STAGE(PG8_SB(0, 0), cB, voffB); PG8_STAGE(PG8_SB(0, 1), cB + hstep, voffB); PG8_STAGE_A(0, 0, cA); PG8_STAGE_A(0, 1, cA);
    if (wr == 1) PG8_BAR;
    PG8_WAIT_V(2); PG8_BAR;
    PG8_STAGE(PG8_SB(1, 0), cB + kstep, voffB); PG8_STAGE_A(1, 0, cA + kstep); PG8_STAGE(PG8_SB(1, 1), cB + hstep + kstep, voffB);
    PG8_WAIT_V(6); PG8_BAR;
    for (;;) {
        const bool has_next = S.next(ui + 1, nxt);
        const char* nA = has_next ? nxt.A : cA; const char* nB = has_next ? nxt.B : cB;
        nxt.slot = (cur.slot == 2) ? 0 : cur.slot + 1;
        if constexpr (Sched::GATHER) { if (has_next) { PG8_IDS_DMA(nxt, (ui + 1) & 1); PG8_AUX_DMA(nxt); } }
        else { if (has_next && S.aux0) PG8_AUX_DMA(nxt); }
#pragma nounroll
        for (int t = 0; t < nt; t += 2) {
            unsigned long long pbt = 0; if (pb && (PROBE_TYPE == 21 || PROBE_TYPE == 22)) pbt = __builtin_amdgcn_s_memrealtime();
            const bool last = (t == nt - 2);
            const char* a1 = cA + (size_t)(t + 1) * kstep;
            const char* a2 = last ? nA : cA + (size_t)(t + 2) * kstep; const char* b2 = last ? nB : cB + (size_t)(t + 2) * kstep;
            const char* a3 = a2 + kstep; const char* b3 = b2 + kstep;
            PG8_LDB(B0, 0, 0); PG8_LDB(B1, 0, 1); PG8_SCHED; PG8_LDA(At, 0, 0); PG8_STAGE_A(1, 1, a1);
            if constexpr (Sched::GATHER) { if (last && has_next) PG8_IDS_READ(nxt, (ui + 1) & 1); }
            PG8_WAIT_V(8); PG8_WAIT_L(0); PG8_BAR; PG8_MMA(0, 0, At, B0); PG8_MMA(0, 1, At, B1); PG8_BAR; PG8_SCHED;
            PG8_LDA(At, 0, 1); PG8_STAGE(PG8_SB(0, 0), b2, voffB); PG8_STAGE(PG8_SB(0, 1), b2 + hstep, voffB); PG8_STAGE_A(0, 0, a2);
            PG8_WAIT_V(8); PG8_WAIT_L(0); PG8_BAR; PG8_MMA(1, 0, At, B0); PG8_MMA(1, 1, At, B1); PG8_BAR; PG8_SCHED;
            PG8_LDB(B0, 1, 0); PG8_LDB(B1, 1, 1); PG8_SCHED; PG8_LDA(At, 1, 0); PG8_STAGE_A(0, 1, a2);
            PG8_WAIT_V(8); PG8_WAIT_L(0); PG8_BAR; PG8_MMA(0, 0, At, B0); PG8_MMA(0, 1, At, B1); PG8_BAR; PG8_SCHED;
            PG8_LDA(At, 1, 1); PG8_STAGE(PG8_SB(1, 0), b3, voffB); PG8_STAGE(PG8_SB(1, 1), b3 + hstep, voffB); PG8_STAGE_A(1, 0, a3);
            PG8_WAIT_V(8); PG8_WAIT_L(0); PG8_BAR; PG8_MMA(1, 0, At, B0); PG8_MMA(1, 1, At, B1); PG8_BAR; PG8_SCHED;
            if (pb && ((PROBE_TYPE == 21 && t == 0) || (PROBE_TYPE == 22 && t != 0))) *pb += __builtin_amdgcn_s_memrealtime() - pbt;
        }
        unsigned long long pbe = 0; if (pb && PROBE_TYPE == 20) pbe = __builtin_amdgcn_s_memrealtime();
        if constexpr (ALIGN_EPI) { if (wr == 0) PG8_BAR; }
        { unsigned z_ = 0u; asm volatile("" : "+v"(z_));
          const int l_ = (int)__builtin_amdgcn_mbcnt_hi(~0u, __builtin_amdgcn_mbcnt_lo(~0u, z_));
          E(acc, cur, wr, wc, l_ & 15, l_ >> 4); }
        if (pb && PROBE_TYPE == 20) *pb += __builtin_amdgcn_s_memrealtime() - pbe;
        if (!has_next) break;
        if (!(cur.kind & KEEP)) {
#pragma unroll
            for (int a = 0; a < 2; ++a)
#pragma unroll
                for (int b = 0; b < 2; ++b)
#pragma unroll
                    for (int m = 0; m < 4; ++m)
#pragma unroll
                        for (int n = 0; n < 2; ++n) acc[a][b][m][n] = (f32x4){0.f, 0.f, 0.f, 0.f};
        }
        cur = nxt; cA = nA; cB = nB; ++ui;
        if constexpr (ALIGN_EPI) { if (wr == 1) PG8_BAR; }
    }
    PG8_WAIT_V(0);
    if constexpr (!ALIGN_EPI) { if (wr == 0) PG8_BAR; }
    PG8_BAR;
#undef PG8_SA
#undef PG8_SB
#undef PG8_STAGE
#undef PG8_STAGE_A
#undef PG8_IDS_DMA
#undef PG8_AUX_DMA
#undef PG8_IDS_READ
#undef PG8_LDA
#undef PG8_LDB
#undef PG8_MMA
#undef PG8_CAT
#undef PG8_WAIT_V
#undef PG8_WAIT_L
#undef PG8_BAR
#undef PG8_SCHED
}
}

struct Args { const float* in[20]; float* out; unsigned char* ws; int ph_lo, ph_hi; };
#define KIN(i) (((const __attribute__((address_space(4))) Args*)__builtin_amdgcn_kernarg_segment_ptr())->in[i])
struct Frame {
    LAS unsigned char* lds;
    volatile LAS unsigned* MISC;
    gu32* ctl;
    int tid, lane, wave, G;
    int vcu, cx, local_ok;
    unsigned char* ws;
    float* out;
    unsigned long long pb_t0, pb_acc;
};

using pg8::Unit;
typedef f32x4 Acc[2][2][4][2];

struct EpiInProj {
    static constexpr bool PERM = true;
    unsigned char* ws; const LAS float* gl; const LAS float* rs_tab;
    __device__ __forceinline__ void operator()(Acc& acc, const Unit& u, int wr, int wc, int fr, int fq) const {
        const int row0 = u.pm * 256 + wr * 64 + fr; const int pn = u.pn;
        float rs[2][4];
#pragma unroll
        for (int ai = 0; ai < 2; ++ai)
#pragma unroll
            for (int m = 0; m < 4; ++m) rs[ai][m] = rs_tab[u.slot * 256 + wr * 64 + fr + ai * 128 + m * 16];
        if (pn < 4) {
            const LAS float* g = gl + (pn >> 1) * 64 + 8 * fq;
            bf16* dst = (bf16*)(ws + WS_DQ + (size_t)(pn >> 1) * (32 * MiB)) + wc * 128 + (pn & 1) * 64 + 8 * fq;
#pragma unroll
            for (int ai = 0; ai < 2; ++ai)
#pragma unroll
                for (int m = 0; m < 4; ++m) {
                    const int row = row0 + ai * 128 + m * 16; const float r_ = rs[ai][m]; float ss = 0.f; f32x4 v[2][2];
#pragma unroll
                    for (int bj = 0; bj < 2; ++bj)
#pragma unroll
                        for (int n = 0; n < 2; ++n) { v[bj][n] = acc[ai][bj][m][n] * r_; ss += (v[bj][n][0] * v[bj][n][0] + v[bj][n][1] * v[bj][n][1]) + (v[bj][n][2] * v[bj][n][2] + v[bj][n][3] * v[bj][n][3]); }
                    ss += __shfl_xor(ss, 16); ss += __shfl_xor(ss, 32);
                    const float inv = __builtin_amdgcn_rsqf(ss * (1.0f / 64.0f) + EPS);
                    bf16* rowp = dst + (size_t)row * 512;
#pragma unroll
                    for (int bj = 0; bj < 2; ++bj) { const f32x4 g0 = *(const LAS f32x4*)(g + 32 * bj) * inv, g1 = *(const LAS f32x4*)(g + 32 * bj + 4) * inv; u32x4 w;
                        w.x = cvt_pk_bf16(v[bj][0][0] * g0[0], v[bj][0][1] * g0[1]); w.y = cvt_pk_bf16(v[bj][0][2] * g0[2], v[bj][0][3] * g0[3]);
                        w.z = cvt_pk_bf16(v[bj][1][0] * g1[0], v[bj][1][1] * g1[1]); w.w = cvt_pk_bf16(v[bj][1][2] * g1[2], v[bj][1][3] * g1[3]);
                        *(u32x4*)(rowp + bj * 32) = w; }
                }
        } else if (pn < 12) {
            const int sec = (pn - 4) >> 1; bf16* dst = (bf16*)(ws + WS_VA + (size_t)sec * (32 * MiB)) + ((pn - 4) & 1) * 256 + wc * 32 + 8 * fq; const float sc = (sec == 1) ? C2 : 1.f;
#pragma unroll
            for (int ai = 0; ai < 2; ++ai)
#pragma unroll
                for (int m = 0; m < 4; ++m) { const int row = row0 + ai * 128 + m * 16; const float r_ = rs[ai][m] * sc; bf16* rowp = dst + (size_t)row * 512;
#pragma unroll
                    for (int bj = 0; bj < 2; ++bj) { const f32x4 v0 = acc[ai][bj][m][0] * r_, v1 = acc[ai][bj][m][1] * r_; u32x4 w;
                        w.x = cvt_pk_bf16(v0[0], v0[1]); w.y = cvt_pk_bf16(v0[2], v0[3]); w.z = cvt_pk_bf16(v1[0], v1[1]); w.w = cvt_pk_bf16(v1[2], v1[3]);
                        *(u32x4*)(rowp + bj * 128) = w; } }
        } else {
            const int col0 = (pn - 12) * 128 + wc * 32 + 8 * fq; unsigned char* G = ws + WS_G1;
#pragma unroll
            for (int ai = 0; ai < 2; ++ai)
#pragma unroll
                for (int m = 0; m < 4; ++m) { const int row = row0 + ai * 128 + m * 16; const float r_ = rs[ai][m];
                    unsigned qa[8], qb[8];
#pragma unroll
                    for (int n = 0; n < 2; ++n)
#pragma unroll
                        for (int j = 0; j < 4; ++j) { const float ga = acc[ai][0][m][n][j] * r_, gb = acc[ai][1][m][n][j] * r_;
                            const float sa = __builtin_amdgcn_rcpf(1.f + fexp2(-ga * LOG2E)), sb = __builtin_amdgcn_rcpf(1.f + fexp2(-gb * LOG2E));
                            qa[n * 4 + j] = (unsigned)(sa * 255.f + 0.5f); qb[n * 4 + j] = max(1u, (unsigned)(sb * 255.f + 0.5f)); }
                    u32x4 w;
                    w.x = qa[0] | (qa[1] << 8) | (qa[2] << 16) | (qa[3] << 24); w.y = qa[4] | (qa[5] << 8) | (qa[6] << 16) | (qa[7] << 24);
                    w.z = qb[0] | (qb[1] << 8) | (qb[2] << 16) | (qb[3] << 24); w.w = qb[4] | (qb[5] << 8) | (qb[6] << 16) | (qb[7] << 24);
                    *(u32x4*)(G + (size_t)row * 2048 + (size_t)col0 * 2) = w; }
        }
    }
};

struct EpiBranch {
    static constexpr bool PERM = true;
    const unsigned char* G; bf16* MIXED;
    __device__ __forceinline__ void operator()(Acc& acc, const Unit& u, int wr, int wc, int fr, int fq) const {
        const int row0 = u.pm * 256 + wr * 64 + fr; const int col0 = u.pn * 256 + wc * 32 + 8 * fq; const bool first = (u.kind & 0xff) == 0;
        const unsigned char* Gp = G + (size_t)row0 * 2048 + (size_t)col0 * 2;
        u32x4 g[2][4][2];
#pragma unroll
        for (int ai = 0; ai < 2; ++ai)
#pragma unroll
            for (int m = 0; m < 4; ++m)
#pragma unroll
                for (int bj = 0; bj < 2; ++bj) g[ai][m][bj] = *(const u32x4*)(Gp + (size_t)(ai * 128 + m * 16) * 2048 + bj * 256);
#define UB(w, k) ((float)(((w) >> (8 * (k))) & 0xffu))
        if (first) {
#pragma unroll
            for (int ai = 0; ai < 2; ++ai)
#pragma unroll
                for (int m = 0; m < 4; ++m)
#pragma unroll
                    for (int bj = 0; bj < 2; ++bj) { u32x4 gg = g[ai][m][bj]; asm volatile("" : "+v"(gg));
                        f32x4 v0 = acc[ai][bj][m][0], v1 = acc[ai][bj][m][1];
                        v0[0] *= UB(gg.x, 0) * __builtin_amdgcn_rcpf(UB(gg.z, 0)); v0[1] *= UB(gg.x, 1) * __builtin_amdgcn_rcpf(UB(gg.z, 1)); v0[2] *= UB(gg.x, 2) * __builtin_amdgcn_rcpf(UB(gg.z, 2)); v0[3] *= UB(gg.x, 3) * __builtin_amdgcn_rcpf(UB(gg.z, 3));
                        v1[0] *= UB(gg.y, 0) * __builtin_amdgcn_rcpf(UB(gg.w, 0)); v1[1] *= UB(gg.y, 1) * __builtin_amdgcn_rcpf(UB(gg.w, 1)); v1[2] *= UB(gg.y, 2) * __builtin_amdgcn_rcpf(UB(gg.w, 2)); v1[3] *= UB(gg.y, 3) * __builtin_amdgcn_rcpf(UB(gg.w, 3));
                        acc[ai][bj][m][0] = v0; acc[ai][bj][m][1] = v1; }
        } else {
            bf16* Mp = MIXED + (size_t)row0 * 1024 + col0; asm volatile("" : "+v"(Mp)); const float q = 1.0f / 255.0f;
#pragma unroll
            for (int ai = 0; ai < 2; ++ai)
#pragma unroll
                for (int m = 0; m < 4; ++m)
#pragma unroll
                    for (int bj = 0; bj < 2; ++bj) { u32x4 gg = g[ai][m][bj]; asm volatile("" : "+v"(gg)); const f32x4 v0 = acc[ai][bj][m][0] * q, v1 = acc[ai][bj][m][1] * q; u32x4 w;
                        w.x = cvt_pk_bf16(v0[0] * UB(gg.z, 0), v0[1] * UB(gg.z, 1)); w.y = cvt_pk_bf16(v0[2] * UB(gg.z, 2), v0[3] * UB(gg.z, 3));
                        w.z = cvt_pk_bf16(v1[0] * UB(gg.w, 0), v1[1] * UB(gg.w, 1)); w.w = cvt_pk_bf16(v1[2] * UB(gg.w, 2), v1[3] * UB(gg.w, 3));
                        *(u32x4*)(Mp + (size_t)(ai * 128 + m * 16) * 1024 + bj * 128) = w; }
        }
#undef UB
    }
};

struct EpiOutProj {
    static constexpr bool PERM = true;
    bf16* XB; unsigned char* XB8;
    __device__ __forceinline__ void operator()(Acc& acc, const Unit& u, int wr, int wc, int fr, int fq) const {
        const int row0 = u.pm * 256 + wr * 64 + fr; const int col0 = u.pn * 256 + wc * 32 + 8 * fq;
        bf16* base = XB + (size_t)row0 * 1024 + col0; unsigned char* base8 = XB8 + (size_t)row0 * 1024 + col0;
        u32x4 g[2][4][2];
#pragma unroll
        for (int ai = 0; ai < 2; ++ai)
#pragma unroll
            for (int m = 0; m < 4; ++m)
#pragma unroll
                for (int bj = 0; bj < 2; ++bj) g[ai][m][bj] = *(const u32x4*)(base + (size_t)(ai * 128 + m * 16) * 1024 + bj * 128);
#pragma unroll
        for (int ai = 0; ai < 2; ++ai)
#pragma unroll
            for (int m = 0; m < 4; ++m)
#pragma unroll
                for (int bj = 0; bj < 2; ++bj) { const u32x4 gg = g[ai][m][bj]; const f32x4 a0 = acc[ai][bj][m][0], a1 = acc[ai][bj][m][1]; u32x4 w;
                    w.x = cvt_pk_bf16(a0[0] + bf_lo(gg.x), a0[1] + bf_hi(gg.x)); w.y = cvt_pk_bf16(a0[2] + bf_lo(gg.y), a0[3] + bf_hi(gg.y));
                    w.z = cvt_pk_bf16(a1[0] + bf_lo(gg.z), a1[1] + bf_hi(gg.z)); w.w = cvt_pk_bf16(a1[2] + bf_lo(gg.w), a1[3] + bf_hi(gg.w));
                    *(u32x4*)(base + (size_t)(ai * 128 + m * 16) * 1024 + bj * 128) = w;
                    const float v8[8] = {bf_lo(w.x), bf_hi(w.x), bf_lo(w.y), bf_hi(w.y), bf_lo(w.z), bf_hi(w.z), bf_lo(w.w), bf_hi(w.w)};
                    *(u32x2*)(base8 + (size_t)(ai * 128 + m * 16) * 1024 + bj * 128) = pack8_fp8(v8); }
    }
};

struct EpiGate8 {
    static constexpr bool PERM = true;
    unsigned char* G; const LAS float* rs_tab; unsigned char* VSB;
    __device__ __forceinline__ void operator()(Acc& acc, const Unit& u, int wr, int wc, int fr, int fq) const {
        const int row0 = u.pm * 256 + wr * 64 + fr; const int col0 = u.pn * 128 + wc * 32 + 8 * fq;
        if (u.pn >= 8) {
            const int sec = (u.pn - 8) >> 1; const float sc = (sec == 0) ? C2 * (1.0f / W8_SCALE) : (1.0f / W8_SCALE);
            bf16* dst = (bf16*)(VSB + (size_t)sec * (32 * MiB)) + (u.pn & 1) * 256 + wc * 32 + 8 * fq;
#pragma unroll
            for (int ai = 0; ai < 2; ++ai)
#pragma unroll
                for (int m = 0; m < 4; ++m) { const int row = row0 + ai * 128 + m * 16; const float r_ = rs_tab[u.slot * 256 + wr * 64 + fr + ai * 128 + m * 16] * sc; bf16* rowp = dst + (size_t)row * 512;
#pragma unroll
                    for (int bj = 0; bj < 2; ++bj) { const f32x4 v0 = acc[ai][bj][m][0] * r_, v1 = acc[ai][bj][m][1] * r_; u32x4 w;
                        w.x = cvt_pk_bf16(v0[0], v0[1]); w.y = cvt_pk_bf16(v0[2], v0[3]); w.z = cvt_pk_bf16(v1[0], v1[1]); w.w = cvt_pk_bf16(v1[2], v1[3]);
                        *(u32x4*)(rowp + bj * 128) = w; } }
            return; }
#pragma unroll
        for (int ai = 0; ai < 2; ++ai)
#pragma unroll
            for (int m = 0; m < 4; ++m) { const int row = row0 + ai * 128 + m * 16; const float r_ = rs_tab[u.slot * 256 + wr * 64 + fr + ai * 128 + m * 16] * (-LOG2E / W8_SCALE);
                unsigned qa[8], qb[8];
#pragma unroll
                for (int n = 0; n < 2; ++n)
#pragma unroll
                    for (int j = 0; j < 4; ++j) {
                        const float sa = __builtin_amdgcn_rcpf(1.f + fexp2(acc[ai][0][m][n][j] * r_)), sb = __builtin_amdgcn_rcpf(1.f + fexp2(acc[ai][1][m][n][j] * r_));
                        qa[n * 4 + j] = (unsigned)(sa * 255.f + 0.5f); qb[n * 4 + j] = max(1u, (unsigned)(sb * 255.f + 0.5f)); }
                u32x4 w;
                w.x = qa[0] | (qa[1] << 8) | (qa[2] << 16) | (qa[3] << 24); w.y = qa[4] | (qa[5] << 8) | (qa[6] << 16) | (qa[7] << 24);
                w.z = qb[0] | (qb[1] << 8) | (qb[2] << 16) | (qb[3] << 24); w.w = qb[4] | (qb[5] << 8) | (qb[6] << 16) | (qb[7] << 24);
                *(u32x4*)(G + (size_t)row * 2048 + (size_t)col0 * 2) = w; }
    }
};

struct EpiMoe1 {
    static constexpr bool PERM = true;
    const LAS float* rs_tab; unsigned char* ACT;
    __device__ __forceinline__ void operator()(Acc& acc, const Unit& u, int wr, int wc, int fr, int fq) const {
        const int row0 = u.pm * 256 + wr * 64 + fr; const int col0 = u.pn * 128 + wc * 32 + 8 * fq; const int r0 = wr * 64 + fr;
        float rs[2][4];
#pragma unroll
        for (int ai = 0; ai < 2; ++ai)
#pragma unroll
            for (int m = 0; m < 4; ++m) { const int r = r0 + ai * 128 + m * 16; rs[ai][m] = (r < u.nvalid) ? rs_tab[u.slot * 256 + r] * (1.0f / W8_SCALE) : 0.f; }
#pragma unroll
        for (int ai = 0; ai < 2; ++ai)
#pragma unroll
            for (int m = 0; m < 4; ++m) { const int prow = row0 + ai * 128 + m * 16; const float r_ = rs[ai][m]; float a[8];
#pragma unroll
                for (int n = 0; n < 2; ++n)
#pragma unroll
                    for (int j = 0; j < 4; ++j) { const float g = acc[ai][0][m][n][j] * r_, up = acc[ai][1][m][n][j] * r_;
                        a[n * 4 + j] = A8_SCALE * g * up * __builtin_amdgcn_rcpf(1.f + fexp2(-g * LOG2E)); }
                *(u32x2*)(ACT + (size_t)prow * 512 + col0) = pack8_fp8(a); }
    }
};

struct EpiMoe2 {
    static constexpr bool PERM = true;
    const LAS int* tok_tab; unsigned char* CONTRIB;
    __device__ __forceinline__ void operator()(Acc& acc, const Unit& u, int wr, int wc, int fr, int fq) const {
        const int col0 = u.pn * 256 + wc * 32 + 8 * fq; const int r0 = wr * 64 + fr;
        int tk[2][4]; float ww[2][4];
#pragma unroll
        for (int ai = 0; ai < 2; ++ai)
#pragma unroll
            for (int m = 0; m < 4; ++m) { const int r = r0 + ai * 128 + m * 16; const bool ok = r < u.nvalid; tk[ai][m] = ok ? tok_tab[u.slot * 256 + r] : -1; ww[ai][m] = ok ? __int_as_float(tok_tab[768 + u.slot * 256 + r]) * (C8_SCALE / (W8_SCALE * A8_SCALE)) : 0.f; }
#pragma unroll
        for (int ai = 0; ai < 2; ++ai)
#pragma unroll
            for (int m = 0; m < 4; ++m) { const int tok2 = tk[ai][m]; const float w_ = ww[ai][m];
                if (tok2 >= 0) {
#pragma unroll
                    for (int bj = 0; bj < 2; ++bj) { const f32x4 v0 = acc[ai][bj][m][0] * w_, v1 = acc[ai][bj][m][1] * w_;
                        const float v8[8] = {v0[0], v0[1], v0[2], v0[3], v1[0], v1[1], v1[2], v1[3]};
                        *(u32x2*)(CONTRIB + (size_t)tok2 * 1024 + col0 + bj * 128) = pack8_fp8(v8); } } }
    }
};

struct SchedPlain {
    static constexpr bool GATHER = false; static constexpr bool FP8 = false;
    const char* A; const char* Bt; int nM, nN, K, G, c; const int* aux0 = nullptr; const int* aux1 = nullptr;
    __device__ __forceinline__ bool next(int i, Unit& u) const {
        const long L = (long)i * G + c; if (L >= (long)nM * nN) return false;
        pg8::tile_order((int)L, nM, nN, u.pm, u.pn); u.kind = 0; u.eoff = 256 * u.pm; u.nvalid = 256; u.goff = 0; u.gnv = 0;
        u.A = A + (size_t)u.pm * 256 * K * 2; u.B = Bt + (size_t)u.pn * 256 * K * 2; return true;
    }
};
struct SchedGate8 {
    static constexpr bool GATHER = true; static constexpr bool FP8 = true;
    const char* A; const char* Bt; int nM, nN, K, G, c; const int* ids; const int* aux0; const int* aux1 = nullptr;
    __device__ __forceinline__ bool next(int i, Unit& u) const {
        const long L = (long)i * G + c; if (L >= (long)nM * nN) return false;
        pg8::tile_order((int)L, nM, nN, u.pm, u.pn); u.kind = 0; u.eoff = 256 * u.pm; u.nvalid = 256; u.goff = 256 * u.pm; u.gnv = 256;
        u.A = A; u.B = Bt + (size_t)u.pn * 256 * K * 2; return true;
    }
};
struct SchedBranch {
    static constexpr bool GATHER = false; static constexpr bool FP8 = false;
    const char *OA, *OB, *WBD, *WBS; int G, c; const int* aux0 = nullptr; const int* aux1 = nullptr;
    __device__ __forceinline__ bool next(int i, Unit& u) const {
        const long L = (long)(i >> 1) * G + c; if (L >= 128 * 4) return false;
        pg8::tile_order((int)L, 128, 4, u.pm, u.pn); const int br = i & 1; u.kind = br ? 1 : (0 | pg8::KEEP); u.eoff = 0; u.nvalid = 256; u.goff = 0; u.gnv = 0;
        u.A = (br ? OB : OA) + (size_t)u.pm * 256 * 512 * 2; u.B = (br ? WBS : WBD) + (size_t)u.pn * 256 * 512 * 2; return true;
    }
};
template <bool G>
struct SchedMoe {
    static constexpr bool GATHER = true; static constexpr bool FP8 = true;
    const char* A; const char* W; const LAS int* ust; const int* ids; const int* aux0; const int* aux1; int K; size_t wstride; int Gn, c;
    __device__ __forceinline__ bool next(int i, Unit& u) const {
        const int v = (Gn % 8 == 0) ? (c % 8) * (Gn / 8) + c / 8 : c;
        unsigned ub_ = (unsigned)(size_t)this->ust; asm volatile("" : "+v"(ub_)); const LAS int* ust = (const LAS int*)(size_t)ub_;
        const long L = (long)i * Gn + v; const int nrb = ust[32]; if (L >= (long)nrb * 4) return false;
        const int rb = (int)(L >> 2), pn = (int)(L & 3); int e = 0;
        for (int j = 1; j < 32; ++j) e += (ust[j] <= rb) ? 1 : 0;
        const int rbl = rb - ust[e]; const int left = ust[64 + e] - 256 * rbl;
        u.pm = rb; u.pn = pn; u.kind = 0; u.eoff = e * ECAP + 256 * rbl; u.nvalid = left < 256 ? left : 256;
        if (G) { u.goff = u.eoff; u.gnv = u.nvalid; } else { u.goff = 256 * rb; u.gnv = 256; }
        u.A = A; u.B = W + (size_t)e * wstride + (size_t)pn * 256 * K * 2; return true;
    }
};

template <class RowMap>
__device__ __forceinline__ void transpose_item(const float* W, int N, bf16* WT, int Kd, const float* gk, LAS unsigned* scr, int kb, int nb, int lane, const RowMap& map) {
    const int k0 = 64 * kb, n0 = 64 * nb, n4 = lane & 15, kq = lane >> 4;
    f32x4 va[8], vb[8];
    const float* wp = W + (size_t)(k0 + 2 * kq) * N + n0 + 4 * n4;
#pragma unroll
    for (int i = 0; i < 8; ++i) { va[i] = __builtin_nontemporal_load((const f32x4*)(wp + (size_t)(8 * i) * N)); vb[i] = __builtin_nontemporal_load((const f32x4*)(wp + (size_t)(8 * i + 1) * N)); }
#pragma unroll
    for (int i = 0; i < 8; ++i) {
        float ga = 1.f, gb = 1.f; if (gk) { ga = gk[k0 + 8 * i + 2 * kq]; gb = gk[k0 + 8 * i + 2 * kq + 1]; }
#pragma unroll
        for (int j = 0; j < 4; ++j) scr[(4 * n4 + j) * 33 + 4 * i + kq] = cvt_pk_bf16(va[i][j] * ga, vb[i][j] * gb);
    }
    LDS_WAIT(); asm volatile("" ::: "memory");
    const int nl = lane >> 3, c = lane & 7;
#pragma unroll
    for (int p = 0; p < 8; ++p) { const int n = 8 * p + nl; const LAS unsigned* sp = scr + n * 33 + 4 * c;
        u32x4 o; o.x = sp[0]; o.y = sp[1]; o.z = sp[2]; o.w = sp[3];
        *(u32x4*)(WT + (size_t)map(n0 + n) * Kd + k0 + 8 * c) = o; }
    LDS_WAIT(); asm volatile("" ::: "memory");
}
template <class RowMap>
__device__ __forceinline__ void transpose_item8(const float* W, int N, unsigned char* WT, int Kd, const float* gk, float scale, LAS unsigned char* scr, int kb, int nb, int lane, const RowMap& map) {
    const int k0 = 64 * kb, n0 = 64 * nb, n4 = lane & 15, kq = lane >> 4;
    f32x4 va[8], vb[8];
    const float* wp = W + (size_t)(k0 + 2 * kq) * N + n0 + 4 * n4;
#pragma unroll
    for (int i = 0; i < 8; ++i) { va[i] = __builtin_nontemporal_load((const f32x4*)(wp + (size_t)(8 * i) * N)); vb[i] = __builtin_nontemporal_load((const f32x4*)(wp + (size_t)(8 * i + 1) * N)); }
#pragma unroll
    for (int i = 0; i < 8; ++i) {
        float ga = scale, gb = scale; if (gk) { ga *= gk[k0 + 8 * i + 2 * kq]; gb *= gk[k0 + 8 * i + 2 * kq + 1]; }
#pragma unroll
        for (int j = 0; j < 4; ++j) *(LAS unsigned short*)(scr + (4 * n4 + j) * 72 + 8 * i + 2 * kq) = (unsigned short)(__builtin_amdgcn_cvt_pk_fp8_f32(va[i][j] * ga, vb[i][j] * gb, 0, false) & 0xffff);
    }
    LDS_WAIT(); asm volatile("" ::: "memory");
    const int nl = lane >> 3, c = lane & 7;
#pragma unroll
    for (int p = 0; p < 8; ++p) { const int n = 8 * p + nl; const u32x2 o = *(const LAS u32x2*)(scr + n * 72 + 8 * c);
        *(u32x2*)(WT + (size_t)map(n0 + n) * Kd + k0 + 8 * c) = o; }
    LDS_WAIT(); asm volatile("" ::: "memory");
}
struct MapPlain { __device__ __forceinline__ int operator()(int c) const { return c; } };
struct MapIn {
    __device__ __forceinline__ int operator()(int c) const {
        if (c < 1024) { const int pn = c >> 8, hh = (c >> 6) & 3, d = c & 63; return 256 * pn + 128 * (d >> 5) + 32 * hh + (d & 31); }
        if (c < 3072) return c;
        if (c < 4096) { const int cc = c - 3072; return 3072 + 256 * (cc >> 7) + (cc & 127); }
        const int cc = c - 4096; return 3072 + 256 * (cc >> 7) + 128 + (cc & 127);
    }
};
struct MapGate8 { __device__ __forceinline__ int operator()(int c) const { return c >= 3072 ? MapIn{}(c) - 3072 : c + 512; } };
struct MapGU { int up; __device__ __forceinline__ int operator()(int c) const { return 256 * (c >> 7) + 128 * up + (c & 127); } };

__device__ __forceinline__ void convert_moe_weights(Frame& F, int l, int gw, int NGW) {
    LAS unsigned char* scr = (LAS unsigned char*)(F.lds + F.wave * 16384);
    const float* g2 = KIN(14) + l * D;
    for (int it = gw; it < NE * 384; it += NGW) {
        const int e = it / 384, r = it % 384;
        if (r < 256) { const int up = r >> 7, q = r & 127, kb = q >> 3, nb = q & 7;
            const float* W = (up ? KIN(18) : KIN(17)) + ((size_t)l * NE + e) * (size_t)D * DFF;
            transpose_item8(W, DFF, (unsigned char*)(F.ws + WS_WGU_T) + (size_t)e * 1024 * 1024, 1024, g2, W8_SCALE, scr, kb, nb, F.lane, MapGU{up});
        } else { const int q = r - 256, kb = q >> 4, nb = q & 15;
            const float* W = KIN(19) + ((size_t)l * NE + e) * (size_t)DFF * D;
            transpose_item8(W, D, (unsigned char*)(F.ws + WS_WDN_T) + (size_t)e * 1024 * 512, 512, nullptr, W8_SCALE, scr, kb, nb, F.lane, MapPlain{});
        }
    }
}
__device__ __forceinline__ void convert_small_weights(Frame& F, int gw, int NGW) {
    LAS unsigned* scr = (LAS unsigned*)(F.lds + F.wave * 16384);
    for (int it = gw; it < 2 * 1792; it += NGW) {
        const int l = it / 1792; int r = it % 1792;
        if (r < 1280) { const int kb = r / 80, nb = r % 80;
            if (nb < 24) transpose_item(KIN(3) + (size_t)l * D * NIN, NIN, (bf16*)(F.ws + WS_WIN_T) + (size_t)l * NIN * D, D, KIN(2) + l * D, scr, kb, nb, F.lane, MapIn{});
            else transpose_item8(KIN(3) + (size_t)l * D * NIN, NIN, (unsigned char*)(F.ws + WS_WG8_T) + (size_t)l * 3584 * D, D, KIN(2) + l * D, W8_SCALE, (LAS unsigned char*)scr, kb, nb, F.lane, MapGate8{});
            continue; }
        r -= 1280;
        if (r < 128) { transpose_item(KIN(11) + (size_t)l * 512 * D, D, (bf16*)(F.ws + WS_WBD_T) + (size_t)l * D * 512, 512, nullptr, scr, r >> 4, r & 15, F.lane, MapPlain{}); continue; }
        r -= 128;
        if (r < 128) { transpose_item(KIN(12) + (size_t)l * 512 * D, D, (bf16*)(F.ws + WS_WBS_T) + (size_t)l * D * 512, 512, nullptr, scr, r >> 4, r & 15, F.lane, MapPlain{}); continue; }
        r -= 128;
        transpose_item(KIN(13) + (size_t)l * D * D, D, (bf16*)(F.ws + WS_WOUT_T) + (size_t)l * D * D, D, nullptr, scr, r >> 4, r & 15, F.lane, MapPlain{});
    }
    const int gt = (gw * 64 + F.lane), NT_ = NGW * 64;
    for (int i = gt; i < PMAX; i += NT_) ((int*)(F.ws + WS_IDENT))[i] = 2 * i;
    for (int idx = gt; idx < 2 * 48 * 1024; idx += NT_) {
        const int l = idx / (48 * 1024), r = idx % (48 * 1024), n = r >> 10, k = r & 1023; float v = 0.f;
        if (n < 32) v = KIN(16)[((size_t)l * D + k) * 32 + n]; else if (n < 36) v = KIN(15)[((size_t)l * D + k) * 4 + (n - 32)];
        v *= KIN(14)[l * D + k];
        ((bf16*)(F.ws + WS_WR_T))[idx] = (bf16)(cvt_pk_bf16(v, 0.f) & 0xffffu);
    }
}
template <bool INB, bool ADD, bool WX, bool WB>
__device__ __forceinline__ void rows_phase(Frame& F, const float* xin, float* xout, int m_first, int m_step, int m_end) {
    const unsigned char* C = (const unsigned char*)(F.ws + WS_CONTRIB); bf16* XB = (bf16*)(F.ws + WS_XB); float* rstd = (float*)(F.ws + WS_RSTD1);
    for (int m0 = m_first; m0 < m_end; m0 += m_step) {
        f32x4 v[2][4]; u32x2 xa[2][4]; unsigned ca[2][4], cb[2][4];
#pragma unroll
        for (int q = 0; q < 2; ++q) {
            if (INB) { const u32x2* xr = (const u32x2*)(XB + (size_t)(m0 + q) * D) + F.lane;
#pragma unroll
                for (int j = 0; j < 4; ++j) xa[q][j] = xr[64 * j]; }
            else { const f32x4* xr = (const f32x4*)(xin + (size_t)(m0 + q) * D) + F.lane;
#pragma unroll
                for (int j = 0; j < 4; ++j) v[q][j] = __builtin_nontemporal_load(xr + 64 * j); }
            if (ADD) { const unsigned* c0 = (const unsigned*)(C + (size_t)(2 * (m0 + q)) * D) + F.lane; const unsigned* c1 = (const unsigned*)(C + (size_t)(2 * (m0 + q) + 1) * D) + F.lane;
#pragma unroll
                for (int j = 0; j < 4; ++j) { ca[q][j] = c0[64 * j]; cb[q][j] = c1[64 * j]; } } }
#pragma unroll
        for (int q = 0; q < 2; ++q) { const int m = m0 + q;
            if (INB) {
#pragma unroll
                for (int j = 0; j < 4; ++j) { const u32x2 a = xa[q][j]; v[q][j] = (f32x4){bf_lo(a.x), bf_hi(a.x), bf_lo(a.y), bf_hi(a.y)}; } }
            if (ADD) {
#pragma unroll
                for (int j = 0; j < 4; ++j) { const int a = (int)ca[q][j], b = (int)cb[q][j];
                    const f32x2 a0 = __builtin_amdgcn_cvt_pk_f32_fp8(a, false), a1 = __builtin_amdgcn_cvt_pk_f32_fp8(a, true), b0 = __builtin_amdgcn_cvt_pk_f32_fp8(b, false), b1 = __builtin_amdgcn_cvt_pk_f32_fp8(b, true);
                    v[q][j][0] += (a0[0] + b0[0]) * (1.0f / C8_SCALE); v[q][j][1] += (a0[1] + b0[1]) * (1.0f / C8_SCALE); v[q][j][2] += (a1[0] + b1[0]) * (1.0f / C8_SCALE); v[q][j][3] += (a1[1] + b1[1]) * (1.0f / C8_SCALE); } }
            if (WX) { f32x4* xo = (f32x4*)(xout + (size_t)m * D) + F.lane;
#pragma unroll
                for (int j = 0; j < 4; ++j) __builtin_nontemporal_store(v[q][j], xo + 64 * j); }
            if (WB) {
                u32x2 w[4]; float s_ = 0.f;
#pragma unroll
                for (int j = 0; j < 4; ++j) { w[j].x = cvt_pk_bf16(v[q][j][0], v[q][j][1]); w[j].y = cvt_pk_bf16(v[q][j][2], v[q][j][3]);
                    const float r0 = bf_lo(w[j].x), r1 = bf_hi(w[j].x), r2 = bf_lo(w[j].y), r3 = bf_hi(w[j].y); s_ += (r0 * r0 + r1 * r1) + (r2 * r2 + r3 * r3); }
                s_ = wave_sum(s_);
                if (F.lane == 0) rstd[m] = 1.0f / sqrtf(s_ * (1.0f / D) + EPS);
                u32x2* o = (u32x2*)(XB + (size_t)m * D) + F.lane; unsigned* o8 = (unsigned*)(F.ws + WS_XB8IN + (size_t)m * D) + F.lane;
#pragma unroll
                for (int j = 0; j < 4; ++j) { o[64 * j] = w[j];
                    int p8 = __builtin_amdgcn_cvt_pk_fp8_f32(bf_lo(w[j].x), bf_hi(w[j].x), 0, false); p8 = __builtin_amdgcn_cvt_pk_fp8_f32(bf_lo(w[j].y), bf_hi(w[j].y), p8, true);
                    o8[64 * j] = (unsigned)p8; }
            } }
    }
}

__device__ __forceinline__ void router_phase(Frame& F, int l) {
    const bf16* XB = (const bf16*)(F.ws + WS_XB); const bf16* WR = (const bf16*)(F.ws + WS_WR_T) + (size_t)l * 48 * 1024;
    int* ent_tok = (int*)(F.ws + WS_ENT_TOK); float* ent_w = (float*)(F.ws + WS_ENT_W); float* ent_rs = (float*)(F.ws + WS_ENT_RS);
    unsigned* gcnt = (unsigned*)(F.ctl + CW_CNT + 64 * l);
    LAS int* lcnt = (LAS int*)(F.lds + MOE_OFF) + 64; LAS int* lbase = lcnt + 32;
    const int fr = F.lane & 15, fq = F.lane >> 4;
    { LAS u32x4* wl = (LAS u32x4*)F.lds; u32x4 tmp[12];
#pragma unroll
        for (int j = 0; j < 12; ++j) { const int f = F.tid + 512 * j, ln = f & 63, kk = (f >> 6) & 31, nb = f >> 11; tmp[j] = *(const u32x4*)(WR + (size_t)(16 * nb + (ln & 15)) * D + 32 * kk + 8 * (ln >> 4)); }
#pragma unroll
        for (int j = 0; j < 12; ++j) wl[F.tid + 512 * j] = tmp[j];
    }
    __syncthreads();
    for (int chunk = F.vcu; chunk < T / 128; chunk += F.G) {
        if (F.tid < 32) lcnt[F.tid] = 0;
        __syncthreads();
        const int row = chunk * 128 + F.wave * 16 + fr;
        f32x4 a0 = {0.f, 0.f, 0.f, 0.f}, a1 = a0, a2 = a0; float ss = 0.f;
        const bf16* xp = XB + (size_t)row * D + 8 * fq; const LAS bf16x8* wl = (const LAS bf16x8*)F.lds + F.lane;
#pragma unroll
        for (int kb_ = 0; kb_ < 2; ++kb_) {
        u32x4 xa[16];
#pragma unroll
        for (int kk = 0; kk < 16; ++kk) xa[kk] = *(const u32x4*)(xp + 32 * (16 * kb_ + kk));
#pragma unroll
        for (int k_ = 0; k_ < 16; ++k_) { const int kk = 16 * kb_ + k_;
            { const u32x4 x_ = xa[k_]; float t0 = bf_lo(x_.x), t1 = bf_hi(x_.x), t2 = bf_lo(x_.y), t3 = bf_hi(x_.y), t4 = bf_lo(x_.z), t5 = bf_hi(x_.z), t6 = bf_lo(x_.w), t7 = bf_hi(x_.w);
              ss += (t0 * t0 + t1 * t1) + (t2 * t2 + t3 * t3) + (t4 * t4 + t5 * t5) + (t6 * t6 + t7 * t7); }
            const bf16x8 xf = __builtin_bit_cast(bf16x8, xa[k_]);
            a0 = __builtin_amdgcn_mfma_f32_16x16x32_bf16(wl[(0 * 32 + kk) * 64], xf, a0, 0, 0, 0);
            a1 = __builtin_amdgcn_mfma_f32_16x16x32_bf16(wl[(1 * 32 + kk) * 64], xf, a1, 0, 0, 0);
            a2 = __builtin_amdgcn_mfma_f32_16x16x32_bf16(wl[(2 * 32 + kk) * 64], xf, a2, 0, 0, 0);
            if ((k_ & 3) == 3) __builtin_amdgcn_sched_barrier(0);
        }
        asm volatile("" ::: "memory");
        }
        ss += __shfl_xor(ss, 16); ss += __shfl_xor(ss, 32);
        const float rstd = 1.0f / sqrtf(ss * (1.0f / D) + EPS);
        float gl[4];
#pragma unroll
        for (int j = 0; j < 4; ++j) gl[j] = __shfl(a2[j], fr) * rstd;
        int g = 0; float gm = gl[0];
#pragma unroll
        for (int j = 1; j < 4; ++j) if (gl[j] > gm) { gm = gl[j]; g = j; }
        float gs = 0.f;
#pragma unroll
        for (int j = 0; j < 4; ++j) gs += __expf(gl[j] - gm);
        const float pg = 1.0f / gs;
        f32x4 sel = (g >> 1) ? a1 : a0;
        float el[8];
#pragma unroll
        for (int i = 0; i < 8; ++i) { const int src = fr + 16 * (2 * (g & 1) + (i >> 2)); el[i] = __shfl(sel[i & 3], src) * rstd; }
        int i1 = 0; float m1 = el[0];
#pragma unroll
        for (int i = 1; i < 8; ++i) if (el[i] > m1) { m1 = el[i]; i1 = i; }
        int i2 = -1; float m2 = -3.0e38f;
#pragma unroll
        for (int i = 0; i < 8; ++i) if (i != i1 && el[i] > m2) { m2 = el[i]; i2 = i; }
        const float p2 = __expf(m2 - m1); const float w0 = pg / (1.f + p2), w1 = pg * p2 / (1.f + p2);
        const int e0 = 8 * g + i1, e1 = 8 * g + i2;
        int lp0 = 0, lp1 = 0;
        if (fq == 0) { lp0 = __hip_atomic_fetch_add(lcnt + e0, 1, __ATOMIC_RELAXED, __HIP_MEMORY_SCOPE_WORKGROUP); lp1 = __hip_atomic_fetch_add(lcnt + e1, 1, __ATOMIC_RELAXED, __HIP_MEMORY_SCOPE_WORKGROUP); }
        __syncthreads();
        if (F.tid < 32) lbase[F.tid] = (int)__hip_atomic_fetch_add(gcnt + F.tid, (unsigned)lcnt[F.tid], RLX_AGENT);
        __syncthreads();
        if (fq == 0) {
            const int s0 = e0 * ECAP + lbase[e0] + lp0, s1 = e1 * ECAP + lbase[e1] + lp1;
            ent_tok[s0] = 2 * row; ent_tok[s1] = 2 * row + 1; ent_w[s0] = w0; ent_w[s1] = w1; ent_rs[s0] = rstd; ent_rs[s1] = rstd;
        }
        __syncthreads();
    }
}
__device__ __forceinline__ void build_ust(Frame& F, int l) {
    LAS int* ust = (LAS int*)(F.lds + MOE_OFF); LAS int* cnt = ust + 64;
    if (F.tid < 32) cnt[F.tid] = (int)__hip_atomic_load((unsigned*)(F.ctl + CW_CNT + 64 * l) + F.tid, RLX_AGENT);
    __syncthreads();
    if (F.tid == 0) { int acc = 0;
        for (int e = 0; e < 32; ++e) { ust[e] = acc; acc += (cnt[e] + 255) >> 8; }
        ust[32] = acc; }
    __syncthreads();
}
__device__ __forceinline__ int crow(int r, int hi) { return (r & 3) + 8 * (r >> 2) + 4 * hi; }
__device__ __forceinline__ s16x4 vtr(const LAS unsigned char* p) { return __builtin_bit_cast(s16x4, __builtin_amdgcn_ds_read_tr16_b64_v4i16((LAS v4i16_t*)p)); }
__device__ __forceinline__ void glds(const void* g, LAS unsigned char* l) { __builtin_amdgcn_global_load_lds((const unsigned*)g, (LAS unsigned*)l, 16, 0, 0); }
#define PKV(lo, hi4) (bf16x8){lo[0], lo[1], lo[2], lo[3], hi4[0], hi4[1], hi4[2], hi4[3]}

__device__ __forceinline__ void pack_p(const f32x16& p0, const f32x16& p1, bf16x8 (&pa)[4]) {
    u32x4 w0, w1, w2, w3;
    w0.x = cvt_pk_bf16(p0[0], p0[1]); w0.y = cvt_pk_bf16(p0[2], p0[3]); w0.z = cvt_pk_bf16(p0[4], p0[5]); w0.w = cvt_pk_bf16(p0[6], p0[7]);
    w1.x = cvt_pk_bf16(p0[8], p0[9]); w1.y = cvt_pk_bf16(p0[10], p0[11]); w1.z = cvt_pk_bf16(p0[12], p0[13]); w1.w = cvt_pk_bf16(p0[14], p0[15]);
    w2.x = cvt_pk_bf16(p1[0], p1[1]); w2.y = cvt_pk_bf16(p1[2], p1[3]); w2.z = cvt_pk_bf16(p1[4], p1[5]); w2.w = cvt_pk_bf16(p1[6], p1[7]);
    w3.x = cvt_pk_bf16(p1[8], p1[9]); w3.y = cvt_pk_bf16(p1[10], p1[11]); w3.z = cvt_pk_bf16(p1[12], p1[13]); w3.w = cvt_pk_bf16(p1[14], p1[15]);
    pa[0] = __builtin_bit_cast(bf16x8, w0); pa[1] = __builtin_bit_cast(bf16x8, w1); pa[2] = __builtin_bit_cast(bf16x8, w2); pa[3] = __builtin_bit_cast(bf16x8, w3);
}
#define VTR_ASM(dst, addr, off) asm volatile("ds_read_b64_tr_b16 %0, %1 offset:%2" : "=v"(dst) : "v"(addr), "n"(off) : "memory")
#define VTR_WAIT(n, b) asm volatile("s_waitcnt lgkmcnt(" #n ")" : "+v"(lo[b][0]), "+v"(lo[b][1]), "+v"(lo[b][2]), "+v"(lo[b][3]), "+v"(hi4[b][0]), "+v"(hi4[b][1]), "+v"(hi4[b][2]), "+v"(hi4[b][3]) :: "memory")
template <int NDB>
__device__ __forceinline__ void pv_mma(f32x16 (&o)[NDB], const LAS unsigned char* vp, const bf16x8 (&pa)[4]) {
    s16x4 lo[2][4], hi4[2][4];
    const unsigned va = (unsigned)(size_t)vp;
#pragma unroll
    for (int ks = 0; ks < 4; ++ks) { VTR_ASM(lo[0][ks], va, ks * 1024); VTR_ASM(hi4[0][ks], va, ks * 1024 + 512); }
#pragma unroll
    for (int db = 0; db < NDB; ++db) {
        if (db + 1 < NDB) {
#pragma unroll
            for (int ks = 0; ks < 4; ++ks) { VTR_ASM(lo[(db + 1) & 1][ks], va, (db + 1) * 4096 + ks * 1024); VTR_ASM(hi4[(db + 1) & 1][ks], va, (db + 1) * 4096 + ks * 1024 + 512); }
            if (db & 1) VTR_WAIT(8, 1); else VTR_WAIT(8, 0);
        } else { if (db & 1) VTR_WAIT(0, 1); else VTR_WAIT(0, 0); }
        __builtin_amdgcn_sched_barrier(0);
#pragma unroll
        for (int ks = 0; ks < 4; ++ks) o[db] = __builtin_amdgcn_mfma_f32_32x32x16_bf16(pa[ks], PKV(lo[db & 1][ks], hi4[db & 1][ks]), o[db], 0, 0, 0);
        __builtin_amdgcn_sched_barrier(0);
    }
}
__device__ __forceinline__ void qk_mma(f32x16& p0, f32x16& p1, const LAS unsigned char* Kb, const LAS unsigned char* Qs, int lane, int r32, int hi) {
    const LAS unsigned char* kb = Kb + hi * 1024 + r32 * 16;
#pragma unroll
    for (int d0 = 0; d0 < 4; ++d0) {
        const bf16x8 b0 = *(const LAS bf16x8*)(kb + d0 * 2048), b1 = *(const LAS bf16x8*)(kb + d0 * 2048 + 512), q = *(const LAS bf16x8*)(Qs + d0 * 1024 + lane * 16);
        p0 = __builtin_amdgcn_mfma_f32_32x32x16_bf16(b0, q, p0, 0, 0, 0); p1 = __builtin_amdgcn_mfma_f32_32x32x16_bf16(b1, q, p1, 0, 0, 0);
    }
}

__device__ __forceinline__ void diff_epilogue(Frame& F, f32x16 (&o)[4], LAS float* xch, const float* subg, float lam_init, bf16* Ow);
template <int VAR>
__device__ __forceinline__ void diff_stream(f32x16 (&o)[4], float& l, const LAS unsigned char* Kb, const LAS unsigned char* Vb, const bf16x8 (&qr)[4], const LAS float* lut,
                                            bool near, float cfar, int qrow, int kmin, int lane, int r32, int hi) {
    f32x16 p0, p1; const float init = near ? 0.f : cfar;
#pragma unroll
    for (int r = 0; r < 16; ++r) { p0[r] = init; p1[r] = init; }
    const LAS unsigned char* kb = Kb + r32 * 128; const int sw = (r32 >> 1) & 7;
    bf16x8 kf[8];
#pragma unroll
    for (int d0 = 0; d0 < 4; ++d0) { const int so = (((2 * d0 + hi) ^ sw) << 4); kf[2 * d0] = *(const LAS bf16x8*)(kb + so); kf[2 * d0 + 1] = *(const LAS bf16x8*)(kb + 4096 + so); }
    __builtin_amdgcn_sched_barrier(0);
#pragma unroll
    for (int d0 = 0; d0 < 4; ++d0) { if (!(VAR & 4)) { p0 = __builtin_amdgcn_mfma_f32_32x32x16_bf16(kf[2 * d0], qr[d0], p0, 0, 0, 0); p1 = __builtin_amdgcn_mfma_f32_32x32x16_bf16(kf[2 * d0 + 1], qr[d0], p1, 0, 0, 0); }
        else { p0[d0] += __builtin_bit_cast(f32x4, kf[2 * d0])[0]; p1[d0] += __builtin_bit_cast(f32x4, kf[2 * d0 + 1])[0]; } }
    if (VAR & 1) { } else if (near) {
#pragma unroll
        for (int r = 0; r < 16; ++r) { const int d0 = qrow - (kmin + crow(r, hi)), d1 = d0 - 32;
            const float b0 = lut[min(max(d0, 0), 127)], b1 = lut[min(max(d1, 0), 127)];
            p0[r] = d0 < 0 ? 0.f : fexp2(p0[r] + b0); p1[r] = d1 < 0 ? 0.f : fexp2(p1[r] + b1); }
    } else {
#pragma unroll
        for (int r = 0; r < 16; ++r) { p0[r] = fexp2(p0[r]); p1[r] = fexp2(p1[r]); }
    }
    float s = 0.f;
#pragma unroll
    for (int r = 0; r < 16; ++r) s += p0[r] + p1[r];
    l += s;
    bf16x8 pa[4]; pack_p(p0, p1, pa);
    const LAS unsigned char* vp = Vb + ((lane >> 4) & 1) * 32 + (lane & 3) * 8 + (4 * hi + ((lane & 15) >> 2)) * 64;
    if (!(VAR & 2)) pv_mma<4>(o, vp, pa); else { o[0][0] += __builtin_bit_cast(f32x4, pa[0])[0] + __builtin_bit_cast(f32x4, pa[3])[1]; }
}

__device__ __forceinline__ void diff_first(float& l, bf16x8 (&pa)[4], const LAS unsigned char* Kb, const bf16x8 (&qr)[4], const LAS float* ext,
                                           bool near, float cfar, int qrow, int kmin, int r32, int hi) {
    f32x16 p0, p1; const float init = near ? 0.f : cfar;
#pragma unroll
    for (int r = 0; r < 16; ++r) { p0[r] = init; p1[r] = init; }
    const LAS unsigned char* kb = Kb + r32 * 128; const int sw = (r32 >> 1) & 7;
    bf16x8 kf[8];
#pragma unroll
    for (int d0 = 0; d0 < 4; ++d0) { const int so = (((2 * d0 + hi) ^ sw) << 4); kf[2 * d0] = *(const LAS bf16x8*)(kb + so); kf[2 * d0 + 1] = *(const LAS bf16x8*)(kb + 4096 + so); }
    __builtin_amdgcn_sched_barrier(0);
#pragma unroll
    for (int d0 = 0; d0 < 4; ++d0) { p0 = __builtin_amdgcn_mfma_f32_32x32x16_bf16(kf[2 * d0], qr[d0], p0, 0, 0, 0); p1 = __builtin_amdgcn_mfma_f32_32x32x16_bf16(kf[2 * d0 + 1], qr[d0], p1, 0, 0, 0); }
    if (near) {
        { const int dh = qrow - kmin - 4 * hi; const LAS float* lb = ext + (dh + 33);
#pragma unroll
        for (int r = 0; r < 16; ++r) { const int c = (r & 3) + 8 * (r >> 2);
            const float b0 = lb[63 - c], b1 = lb[31 - c];
            p0[r] = c > dh ? 0.f : fexp2(p0[r] + b0); p1[r] = c + 32 > dh ? 0.f : fexp2(p1[r] + b1); } }
    } else {
#pragma unroll
        for (int r = 0; r < 16; ++r) { p0[r] = fexp2(p0[r]); p1[r] = fexp2(p1[r]); }
    }
    float s = 0.f;
#pragma unroll
    for (int r = 0; r < 16; ++r) s += p0[r] + p1[r];
    l += s;
    pack_p(p0, p1, pa);
}
template <bool NEAR>
__device__ __forceinline__ void diff_step(f32x16 (&o)[4], float& l, bf16x8 (&pa)[4], const LAS unsigned char* Kn, const LAS unsigned char* Vc, const bf16x8 (&qr)[4],
                                          const LAS float* ext, float cfar, int qrow, int kmin, int lane, int r32, int hi) {
    f32x16 p0, p1; const float init = NEAR ? 0.f : cfar;
#pragma unroll
    for (int r = 0; r < 16; ++r) { p0[r] = init; p1[r] = init; }
    const LAS unsigned char* kb = Kn + r32 * 128; const int sw = (r32 >> 1) & 7;
    const LAS unsigned char* vp = Vc + ((lane >> 4) & 1) * 32 + (lane & 3) * 8 + (4 * hi + ((lane & 15) >> 2)) * 64;
    bf16x8 kf[8];
#pragma unroll
    for (int d0 = 0; d0 < 4; ++d0) { const int so = (((2 * d0 + hi) ^ sw) << 4); kf[2 * d0] = *(const LAS bf16x8*)(kb + so); kf[2 * d0 + 1] = *(const LAS bf16x8*)(kb + 4096 + so); }
    __builtin_amdgcn_sched_barrier(0);
#pragma unroll
    for (int d0 = 0; d0 < 4; ++d0) { p0 = __builtin_amdgcn_mfma_f32_32x32x16_bf16(kf[2 * d0], qr[d0], p0, 0, 0, 0); p1 = __builtin_amdgcn_mfma_f32_32x32x16_bf16(kf[2 * d0 + 1], qr[d0], p1, 0, 0, 0); }
    __builtin_amdgcn_sched_barrier(0);
    {
        float bb0[16], bb1[16]; const int dh = qrow - kmin - 4 * hi;
        if (NEAR) { const LAS float* lb = ext + (dh + 33);
#pragma unroll
            for (int r = 0; r < 16; ++r) { const int c = (r & 3) + 8 * (r >> 2); bb0[r] = lb[63 - c]; bb1[r] = lb[31 - c]; } }
        s16x4 lo[2][4], hi4[2][4];
        const unsigned va = (unsigned)(size_t)vp;
#pragma unroll
        for (int ks = 0; ks < 4; ++ks) { VTR_ASM(lo[0][ks], va, ks * 1024); VTR_ASM(hi4[0][ks], va, ks * 1024 + 512); }
        float s0 = 0.f, s1 = 0.f;
#pragma unroll
        for (int db = 0; db < 4; ++db) {
            if (db + 1 < 4) {
#pragma unroll
                for (int ks = 0; ks < 4; ++ks) { VTR_ASM(lo[(db + 1) & 1][ks], va, (db + 1) * 4096 + ks * 1024); VTR_ASM(hi4[(db + 1) & 1][ks], va, (db + 1) * 4096 + ks * 1024 + 512); }
                if (db & 1) VTR_WAIT(8, 1); else VTR_WAIT(8, 0);
            } else { if (db & 1) VTR_WAIT(0, 1); else VTR_WAIT(0, 0); }
#pragma unroll
            for (int ks = 0; ks < 4; ++ks) o[db] = __builtin_amdgcn_mfma_f32_32x32x16_bf16(pa[ks], PKV(lo[db & 1][ks], hi4[db & 1][ks]), o[db], 0, 0, 0);
#pragma unroll
            for (int r = 4 * db; r < 4 * db + 4; ++r) { const int c = (r & 3) + 8 * (r >> 2);
                if (NEAR) { p0[r] = c > dh ? 0.f : fexp2(p0[r] + bb0[r]); p1[r] = c + 32 > dh ? 0.f : fexp2(p1[r] + bb1[r]); }
                else { p0[r] = fexp2(p0[r]); p1[r] = fexp2(p1[r]); }
                s0 += p0[r]; s1 += p1[r]; }
        }
        l += s0 + s1;
#pragma unroll
        for (int i = 0; i < 16; ++i) { __builtin_amdgcn_sched_group_barrier(0x8, 1, 0); __builtin_amdgcn_sched_group_barrier(0x2, NEAR ? 8 : 4, 0); }
        __builtin_amdgcn_sched_barrier(0);
    }
    pack_p(p0, p1, pa);
}
template <int VAR>
__device__ __forceinline__ void diff_unit(Frame& F, int b, int h, int qb, const float* subg, float lam, float lam_init, bf16* Odst) {
    const int lane = F.lane, r32 = lane & 31, hi = lane >> 5, wid = F.wave, js = wid >> 2, wq = wid & 3;
    bf16* DQ = (bf16*)(F.ws + WS_DQ); const bf16* DK = (const bf16*)(F.ws + WS_DK); const bf16* VA = (const bf16*)(F.ws + WS_VA);
    const long rowbase = (long)b * SEQ; const int q0 = qb * 128, qw = q0 + 32 * wq;
    LAS unsigned char* kv = F.lds;
    LAS float* wsf = (LAS float*)(F.lds + WSF_OFF) + wid * 64; const LAS float* lut = (const LAS float*)(F.lds + LUT_OFF) + h * 128; const LAS float* ext = (const LAS float*)(F.lds + AUX_OFF) + h * 320;
    const int NT = (q0 + 128) / 64;
    const int krow_ = 8 * wid + (lane >> 3);
    const bf16* k1src = DK + (rowbase + krow_) * 512 + h * 128 + (((lane & 7) ^ ((krow_ >> 1) & 7)) * 8);
    const bf16* vsrc0 = VA + (rowbase + 16 * (wid & 3) + (lane >> 2)) * 512 + h * 128 + (wid >> 2) * 32 + (lane & 3) * 8;
#define DIFF_ISSUE(t, bufi) do { LAS unsigned char* bb_ = kv + (bufi) * 32768; const long ro_ = (long)(t) * 64 * 512; \
        glds(k1src + ro_, bb_ + wid * 1024); glds(k1src + ro_ + 64, bb_ + 8192 + wid * 1024); \
        glds(vsrc0 + ro_, bb_ + 16384 + wid * 1024); glds(vsrc0 + ro_ + 64, bb_ + 16384 + (wid + 8) * 1024); } while (0)
    bf16x8 qr[4];
#pragma unroll
    for (int d0 = 0; d0 < 4; ++d0) qr[d0] = *(const bf16x8*)(DQ + (rowbase + qw + r32) * 512 + h * 128 + js * 64 + d0 * 16 + hi * 8);
    asm volatile("" ::: "memory");
    DIFF_ISSUE(0, 0); DIFF_ISSUE(1, 1);
    if (NT > 2) DIFF_ISSUE(2, 2);
    f32x16 o[4];
#pragma unroll
    for (int i = 0; i < 4; ++i)
#pragma unroll
        for (int r = 0; r < 16; ++r) o[i][r] = 0.f;
    float l = 0.f;
    const float cfar = lut[127];
    if (NT > 2) asm volatile("s_waitcnt vmcnt(8)" ::: "memory"); else asm volatile("s_waitcnt vmcnt(4)" ::: "memory");
    __builtin_amdgcn_s_barrier(); asm volatile("" ::: "memory");
    bf16x8 pa[4];
    diff_first(l, pa, kv + js * 8192, qr, ext, (qw - 63) < 113, cfar, qw + r32, 0, r32, hi);
    if (NT > 2) asm volatile("s_waitcnt vmcnt(4) lgkmcnt(0)" ::: "memory"); else asm volatile("s_waitcnt vmcnt(0) lgkmcnt(0)" ::: "memory");
    __builtin_amdgcn_s_barrier(); asm volatile("" ::: "memory");
    const int NTw = ((qw + 31) >> 6) + 1, tn0 = max(0, (qw - 112) >> 6);
    const int vpo = 16384 + ((lane >> 4) & 1) * 32 + (lane & 3) * 8 + (4 * hi + ((lane & 15) >> 2)) * 64;
#define STEP_PRE(t) if ((t) + 3 < NT) DIFF_ISSUE((t) + 3, ((t) + 3) & 3); \
        const LAS unsigned char* Kn = kv + (((t) + 1) & 3) * 32768 + js * 8192; const LAS unsigned char* Vc = kv + ((t) & 3) * 32768;
#define STEP_POST(t) if ((t) + 3 < NT) asm volatile("s_waitcnt vmcnt(4) lgkmcnt(0)" ::: "memory"); else asm volatile("s_waitcnt vmcnt(0) lgkmcnt(0)" ::: "memory"); \
        __builtin_amdgcn_s_barrier(); asm volatile("" ::: "memory");
    int t = 0;
    const int tA = min(tn0, NTw) - 1;
    for (; t < tA; ++t) { STEP_PRE(t); diff_step<false>(o, l, pa, Kn, Vc + 16384, qr, ext, cfar, qw + r32, 64 * (t + 1), lane, r32, hi); STEP_POST(t); }
    for (; t < NTw - 1; ++t) { STEP_PRE(t); diff_step<true>(o, l, pa, Kn, Vc + 16384, qr, ext, cfar, qw + r32, 64 * (t + 1), lane, r32, hi); STEP_POST(t); }
    { STEP_PRE(t); (void)Kn; pv_mma<4>(o, Vc + vpo, pa); STEP_POST(t); ++t; }
    for (; t < NT; ++t) { STEP_PRE(t); (void)Kn; (void)Vc; STEP_POST(t); }
#undef STEP_PRE
#undef STEP_POST
#undef DIFF_ISSUE
    l += __shfl_xor(l, 32);
    if (hi == 0) wsf[r32] = l;
    LDS_WAIT();
    const float sc = js ? lam : 1.0f;
#pragma unroll
    for (int r = 0; r < 16; ++r) { const float rl = sc * __builtin_amdgcn_rcpf(wsf[crow(r, hi)]);
#pragma unroll
        for (int db = 0; db < 4; ++db) o[db][r] *= rl; }
    LAS float* xch = (LAS float*)(F.lds + wq * 16384);
    if (js) {
#pragma unroll
        for (int db = 0; db < 4; ++db)
#pragma unroll
            for (int r = 0; r < 16; ++r) xch[(db * 16 + r) * 64 + lane] = o[db][r];
    }
    asm volatile("s_waitcnt lgkmcnt(0)" ::: "memory"); __syncthreads();
    if (!js && !(VAR & 32)) diff_epilogue(F, o, xch, subg, lam_init, Odst + (rowbase + qw) * 512 + h * 128);
    asm volatile("s_waitcnt lgkmcnt(0)" ::: "memory"); __syncthreads();
}
__device__ __forceinline__ void diff_epilogue(Frame& F, f32x16 (&o)[4], LAS float* xch, const float* subg, float lam_init, bf16* Ow) {
    int lane = F.lane; asm volatile("" : "+v"(lane));
    const int r32 = lane & 31, hi = lane >> 5;
    float ssq[16];
#pragma unroll
    for (int r = 0; r < 16; ++r) { float s = 0.f;
#pragma unroll
        for (int db = 0; db < 4; ++db) { const float v = o[db][r] - xch[(db * 16 + r) * 64 + lane]; o[db][r] = v; s += v * v; }
        ssq[r] = s; }
#pragma unroll
    for (int r = 0; r < 16; ++r) { float s = ssq[r];
        s += __int_as_float(__builtin_amdgcn_update_dpp(0, __float_as_int(s), 0x128, 0xf, 0xf, true));
        s += __int_as_float(__builtin_amdgcn_update_dpp(0, __float_as_int(s), 0x124, 0xf, 0xf, true));
        s += __int_as_float(__builtin_amdgcn_update_dpp(0, __float_as_int(s), 0x122, 0xf, 0xf, true));
        s += __int_as_float(__builtin_amdgcn_update_dpp(0, __float_as_int(s), 0x121, 0xf, 0xf, true));
        s += __int_as_float(__builtin_amdgcn_ds_swizzle(__float_as_int(s), 0x401f));
        ssq[r] = (1.0f - lam_init) * __builtin_amdgcn_rsqf(s * (1.0f / 128.0f) + EPS); }
    float sg[4];
#pragma unroll
    for (int db = 0; db < 4; ++db) sg[db] = ((const LAS float*)(F.lds + MOE_OFF))[32 * db + r32];
    LDS_WAIT();
    LAS bf16* stl = (LAS bf16*)xch;
#pragma unroll
    for (int r = 0; r < 16; ++r) { const int orow = crow(r, hi);
#pragma unroll
        for (int db = 0; db < 4; ++db) stl[orow * 128 + db * 32 + r32] = (bf16)(cvt_pk_bf16(o[db][r] * ssq[r] * sg[db], 0.f) & 0xffffu); }
    LDS_WAIT();
#pragma unroll
    for (int i = 0; i < 8; ++i) { const int row = i * 4 + (lane >> 4), ch = lane & 15; const u32x4 v = *(const LAS u32x4*)(stl + row * 128 + ch * 8); *(u32x4*)(Ow + (long)row * 512 + ch * 8) = v; }
}

template <bool M>
__device__ __forceinline__ bool sb_tile(f32x16 (&o)[2], float& carry, const bf16x8 (&qr)[4], const LAS unsigned char* kp, int ksw, const LAS unsigned char* vp, int hi, int lane, int qrow, int t,
                                        const bf16* ksrc, const bf16* vsrc, LAS unsigned char* kb_, LAS unsigned char* vb_) {
#define SB_ISSUE_K(t_) do { _Pragma("unroll") for (int c = 0; c < 8; ++c) { const int kr_ = 8 * c + (lane >> 3); glds(ksrc + (long)(64 * (t_) + 8 * c) * 512 + (((lane & 7) ^ ((kr_ >> 1) & 7)) * 8), kb_ + c * 1024); } } while (0)
#define SB_ISSUE_V(t_) do { _Pragma("unroll") for (int p = 0; p < 8; ++p) glds(vsrc + (long)(64 * (t_) + 16 * (p & 3)) * 512 + (p >> 2) * 32, vb_ + p * 1024); } while (0)
    {
        const int kmin = 64 * t;
        asm volatile("s_waitcnt vmcnt(8)" ::: "memory");
        bf16x8 kf[8];
#pragma unroll
        for (int d0 = 0; d0 < 4; ++d0) { const int so = (((2 * d0 + hi) ^ ksw) << 4); kf[2 * d0] = *(const LAS bf16x8*)(kp + so); kf[2 * d0 + 1] = *(const LAS bf16x8*)(kp + 4096 + so); }
        asm volatile("s_waitcnt lgkmcnt(0)" ::: "memory");
        if (t > 0) SB_ISSUE_K(t - 1);
        f32x16 p0, p1;
#pragma unroll
        for (int r = 0; r < 16; ++r) { p0[r] = 0.f; p1[r] = 0.f; }
#pragma unroll
        for (int d0 = 0; d0 < 4; ++d0) { p0 = __builtin_amdgcn_mfma_f32_32x32x16_bf16(kf[2 * d0], qr[d0], p0, 0, 0, 0); p1 = __builtin_amdgcn_mfma_f32_32x32x16_bf16(kf[2 * d0 + 1], qr[d0], p1, 0, 0, 0); }
        float Lb[8][4], T_own[8], T_oth[8];
#pragma unroll
        for (int i = 0; i < 8; ++i) {
#pragma unroll
            for (int e = 0; e < 4; ++e) { const float y = (i < 4) ? p0[4 * i + e] : p1[4 * (i - 4) + e]; const int key = kmin + 8 * i + 4 * hi + e;
                const float sp = fmaxf(y, 0.f) + flog2(1.f + fexp2(-fabsf(y)));
                Lb[i][e] = (!M || key < qrow) ? sp : 0.f; }
            T_own[i] = (Lb[i][0] + Lb[i][1]) + (Lb[i][2] + Lb[i][3]);
        }
#pragma unroll
        for (int i = 0; i < 8; ++i) T_oth[i] = __shfl_xor(T_own[i], 32);
        float after = carry;
#pragma unroll
        for (int i = 7; i >= 0; --i) {
            const float off = after + (hi == 0 ? T_oth[i] : 0.f);
            after += T_own[i] + T_oth[i];
            float suf = off;
#pragma unroll
            for (int e = 3; e >= 0; --e) { const float y = (i < 4) ? p0[4 * i + e] : p1[4 * (i - 4) + e]; const int key = kmin + 8 * i + 4 * hi + e;
                const float a = (!M || key < qrow) ? fexp2(y - Lb[i][e] - suf) : 0.f; suf += Lb[i][e];
                if (i < 4) p0[4 * i + e] = a; else p1[4 * (i - 4) + e] = a; }
        }
        carry = after;
        bf16x8 pa[4]; pack_p(p0, p1, pa);
        if (t > 0) asm volatile("s_waitcnt vmcnt(8)" ::: "memory"); else asm volatile("s_waitcnt vmcnt(0)" ::: "memory");
        pv_mma<2>(o, vp, pa);
        asm volatile("s_waitcnt lgkmcnt(0)" ::: "memory");
#if SB_EARLY_EXIT
        if (__all(carry > SB_EXIT_LOG2)) return true;
#endif
        if (t > 0) SB_ISSUE_V(t - 1);
        return false;
    }
#undef SB_ISSUE_K
#undef SB_ISSUE_V
}

__device__ __forceinline__ void sb_unit(Frame& F, int b, int h, int blk) {
    const int lane = F.lane, r32 = lane & 31, hi = lane >> 5, wid = F.wave;
    bf16* SBQ = (bf16*)(F.ws + WS_SBQ); const bf16* SBK = (const bf16*)(F.ws + WS_SBK); const bf16* SBV = (const bf16*)(F.ws + WS_SBV);
    const long rowbase = (long)b * SEQ; const int qw = 32 * blk; const int qrow = qw + r32;
    LAS unsigned char* kb_ = F.lds + wid * 16384; LAS unsigned char* vb_ = kb_ + 8192;
    bf16x8 qr[4];
#pragma unroll
    for (int d0 = 0; d0 < 4; ++d0) qr[d0] = *(const bf16x8*)(SBQ + (rowbase + qrow) * 512 + h * 64 + d0 * 16 + hi * 8);
    f32x16 o[2];
#pragma unroll
    for (int i = 0; i < 2; ++i)
#pragma unroll
        for (int r = 0; r < 16; ++r) o[i][r] = 0.f;
    float carry = 0.f;
    const bf16* ksrc = SBK + (rowbase + (lane >> 3)) * 512 + h * 64;
    const bf16* vsrc = SBV + (rowbase + (lane >> 2)) * 512 + h * 64 + (lane & 3) * 8;
    const LAS unsigned char* kp = kb_ + r32 * 128; const int ksw = (r32 >> 1) & 7;
    const LAS unsigned char* vp = vb_ + ((lane >> 4) & 1) * 32 + (lane & 3) * 8 + (4 * hi + ((lane & 15) >> 2)) * 64;
#define SB_ISSUE_K(t_) do { _Pragma("unroll") for (int c = 0; c < 8; ++c) { const int kr_ = 8 * c + (lane >> 3); glds(ksrc + (long)(64 * (t_) + 8 * c) * 512 + (((lane & 7) ^ ((kr_ >> 1) & 7)) * 8), kb_ + c * 1024); } } while (0)
#define SB_ISSUE_V(t_) do { _Pragma("unroll") for (int p = 0; p < 8; ++p) glds(vsrc + (long)(64 * (t_) + 16 * (p & 3)) * 512 + (p >> 2) * 32, vb_ + p * 1024); } while (0)
    const int t0 = qw >> 6;
    asm volatile("s_waitcnt lgkmcnt(0)" ::: "memory");
    SB_ISSUE_K(t0); SB_ISSUE_V(t0);
    if (!sb_tile<true>(o, carry, qr, kp, ksw, vp, hi, lane, qrow, t0, ksrc, vsrc, kb_, vb_))
        for (int t = t0 - 1; t >= 0; --t) if (sb_tile<false>(o, carry, qr, kp, ksw, vp, hi, lane, qrow, t, ksrc, vsrc, kb_, vb_)) break;
#undef SB_ISSUE_K
#undef SB_ISSUE_V
    asm volatile("s_waitcnt vmcnt(0) lgkmcnt(0)" ::: "memory");
    LAS bf16* stl = (LAS bf16*)kb_;
#pragma unroll
    for (int r = 0; r < 16; ++r) { const int orow = crow(r, hi);
#pragma unroll
        for (int db = 0; db < 2; ++db) stl[orow * 64 + db * 32 + r32] = (bf16)(cvt_pk_bf16(o[db][r], 0.f) & 0xffffu); }
    LDS_WAIT();
    bf16* Ow = SBQ + (rowbase + qw) * 512 + h * 64;
#pragma unroll
    for (int i = 0; i < 4; ++i) { const int row = i * 8 + (lane >> 3), ch = lane & 7; const u32x4 v = *(const LAS u32x4*)(stl + row * 64 + ch * 8); *(u32x4*)(Ow + (long)row * 512 + ch * 8) = v; }
    asm volatile("s_waitcnt lgkmcnt(0)" ::: "memory");
}

__device__ __forceinline__ int t5_bucket(int n) {
    if (n < 16) return n;
    int b = 16;
    const int thr[15] = {19, 21, 24, 27, 31, 35, 40, 46, 52, 59, 67, 77, 87, 99, 113};
#pragma unroll
    for (int j = 0; j < 15; ++j) b += (n >= thr[j]) ? 1 : 0;
    return b;
}

__device__ __forceinline__ void attention_phase(Frame& F, int l) {
    const float* relb = KIN(1); const float* gq = KIN(4) + l * 64; const float* gk = KIN(5) + l * 64;
    LAS float* scal = (LAS float*)(F.lds + WSF_OFF);
    if (F.wave == 0) { const int d = F.lane;
        float a1 = KIN(6)[l * 64 + d] * KIN(7)[l * 64 + d], a2 = KIN(8)[l * 64 + d] * KIN(9)[l * 64 + d], mq = fabsf(gq[d]), mk = fabsf(gk[d]);
        a1 = wave_sum(a1); a2 = wave_sum(a2);
#pragma unroll
        for (int o = 1; o < 64; o <<= 1) { mq = fmaxf(mq, __shfl_xor(mq, o)); mk = fmaxf(mk, __shfl_xor(mk, o)); }
        if (d == 0) { scal[0] = a1; scal[1] = a2; scal[2] = mq; scal[3] = mk; } }
    if (F.tid >= 64 && F.tid < 192) scal[16 + F.tid - 64] = relb[F.tid - 64];
    __syncthreads();
    const float s1 = scal[0], s2 = scal[1], gqm = scal[2], gkm = scal[3];
    const float lam_init = 0.8f - 0.6f * expf(-0.3f * (float)l);
    const float lam = expf(s1) - expf(s2) + lam_init;
    float lutv, lutfar;
    {
        const int h = F.tid >> 7, d = F.tid & 127; float mb = -3.0e38f;
        for (int bkt = 0; bkt < 32; ++bkt) mb = fmaxf(mb, scal[16 + bkt * 4 + h]);
        const float M = 8.f * gqm * gkm + mb;
        lutv = (scal[16 + t5_bucket(d) * 4 + h] - M) * LOG2E; lutfar = (scal[16 + t5_bucket(127) * 4 + h] - M) * LOG2E;
    }
    __syncthreads();
    ((LAS float*)(F.lds + LUT_OFF))[F.tid] = lutv;
    {
        LAS float* ext = (LAS float*)(F.lds + AUX_OFF); const int h = F.tid >> 7, d = F.tid & 127;
        ext[h * 320 + 96 + d] = lutv;
        if (d < 96) { ext[h * 320 + d] = 0.f; ext[h * 320 + 224 + d] = lutfar; } }
    __syncthreads();
    const float* subg = KIN(10) + l * 128;
    if (F.tid < 128) ((LAS float*)(F.lds + MOE_OFF))[F.tid] = subg[F.tid];
    __syncthreads();
#ifndef ATT_MASK
#define ATT_MASK 3
#endif
#ifndef DIFF_VARIANT
#define DIFF_VARIANT -1
#endif
    if (DIFF_VARIANT >= 0) { for (int i = 0;; ++i) { const long L = (long)i * F.G + F.vcu; if (L >= 1024) break;
        const int Lm = (int)(L & 255), bh = Lm >> 3, s = Lm & 7, k = (int)(L >> 8), qb = (k == 0) ? 31 - s : (k == 1) ? 16 + s : (k == 2) ? 15 - s : s;
        diff_unit<(DIFF_VARIANT >= 0 ? DIFF_VARIANT : 0)>(F, bh >> 2, bh & 3, qb, subg, lam, lam_init, (bf16*)(F.ws + WS_XB)); }
        __syncthreads(); }
    PB_START(10);
    const int vcu = F.vcu;
    if (ATT_MASK & 1) for (int i = 0;; ++i) { const long L = (long)i * F.G + vcu; if (L >= 1024) break;
        const int Lm = (int)(L & 255), bh = Lm >> 3, s = Lm & 7, k = (int)(L >> 8), qb = (k == 0) ? 31 - s : (k == 1) ? 16 + s : (k == 2) ? 15 - s : s;
        diff_unit<0>(F, bh >> 2, bh & 3, qb, subg, lam, lam_init, (bf16*)(F.ws + WS_DQ)); }
    __syncthreads();
    PB_END(10);
    PB_START(11);
    const int gw = F.vcu * NWAVES + F.wave, NGW = F.G * NWAVES;
    if (ATT_MASK & 2) for (int i = 0;; ++i) { int bh, x;
        if (F.G == 256) { const int xg = F.vcu >> 5, lw = (F.vcu & 31) * NWAVES + F.wave, pp = (i >> 1) * 256 + lw; if (pp >= 512) break; bh = 8 * xg + (pp >> 6); x = pp & 63; }
        else { const long p = (long)(i >> 1) * NGW + gw; if (p >= 4096) break; bh = (int)(p >> 6); x = (int)(p & 63); }
        const int blk = (i & 1) ? 127 - x : x;
        sb_unit(F, bh >> 3, bh & 7, blk); }
    __syncthreads();
    PB_END(11);
}

constexpr int NPHASE = 1 + 8 * DEPTH;
__global__ void __launch_bounds__(NWAVES * 64, 2) mk_fwd(Args args) {
    extern __shared__ __attribute__((aligned(16))) unsigned char lds_raw[];
    Frame F;
    F.lds = (LAS unsigned char*)lds_raw;
    F.MISC = (volatile LAS unsigned*)(F.lds + MISC_OFF);
    F.tid = threadIdx.x; F.lane = F.tid & 63; F.wave = __builtin_amdgcn_readfirstlane(F.tid >> 6); F.G = gridDim.x;
    F.ws = args.ws; F.ctl = (gu32*)(args.ws + WS_CTL); F.out = args.out;
    for (int u = F.tid; u < (LDS_BYTES - LDSCTL_OFF) / 4; u += NWAVES * 64) ((LAS unsigned*)(F.lds + LDSCTL_OFF))[u] = 0u;
    __syncthreads();
    const unsigned my_xcc = xb_xcc_id(); unsigned my_rank = 0;
    if (F.tid == 0) my_rank = __hip_atomic_fetch_add((unsigned*)(F.ctl + CW_XRANK) + my_xcc, 1u, RLX_AGENT);
    my_rank = (unsigned)__builtin_amdgcn_readfirstlane((int)my_rank);
    if (F.tid == 0) ((volatile LAS unsigned*)(F.lds + MISC_OFF))[12] = my_rank;
    __syncthreads();
    my_rank = ((volatile LAS unsigned*)(F.lds + MISC_OFF))[12];
    F.vcu = (int)blockIdx.x; F.cx = (int)blockIdx.x; F.local_ok = 0;
    XcdBarrier bar; bar.bar = (unsigned*)(F.ctl + CW_BAR); bar.x = 0; bar.st = nullptr;
    if (!MK_SPLIT) bar = xcd_barrier_post((unsigned*)(F.ctl + CW_BAR), F.MISC + 8);
    F.pb_t0 = 0; F.pb_acc = 0;
    const int lo = args.ph_lo, hi = args.ph_hi;
#define IN(k) (lo <= (k) && (k) < hi)
#define SEAM(k) do { if (IN(k) && IN((k) + 1)) xcd_barrier(bar); } while (0)
#define SEAM_L(k) do { if (IN(k) && IN((k) + 1)) { if (F.local_ok) xcc_barrier((unsigned*)(F.ctl + CW_LBAR), my_xcc, (unsigned)F.G / 8u, (unsigned*)(F.ctl + CW_BAR) + XB_TMO); else xcd_barrier(bar); } } while (0)
#define REFRESH() int gw, NGW, c; do { int t_ = threadIdx.x; asm volatile("" : "+v"(t_)); F.tid = t_; F.lane = t_ & 63; F.wave = __builtin_amdgcn_readfirstlane(t_ >> 6); \
        gw = F.vcu * NWAVES + F.wave; NGW = F.G * NWAVES; c = F.cx; __builtin_assume(c >= 0 && c < 1024); (void)gw; (void)NGW; (void)c; } while (0)

    PB_START(0);
    if (PH_ON(0) && IN(0)) { REFRESH();
        convert_small_weights(F, gw, NGW);
        convert_moe_weights(F, 0, gw, NGW);
        rows_phase<false, false, false, true>(F, KIN(0), nullptr, 2 * gw, 2 * NGW, T);
    }
    SEAM(0);
    PB_END(0);
    if (!MK_SPLIT) {
        LAS unsigned* xc = (LAS unsigned*)(F.lds + WSF_OFF);
        if (F.tid < 16) xc[F.tid] = __hip_atomic_load((unsigned*)(F.ctl + CW_XRANK) + F.tid, RLX_AGENT);
        __syncthreads();
        unsigned pre = 0, tot = 0, uni = 1u;
#pragma unroll
        for (unsigned j = 0; j < 16; ++j) { const unsigned cj = xc[j]; pre += (j < my_xcc) ? cj : 0u; tot += cj; uni &= (cj == 0u || cj * 8u == (unsigned)F.G) ? 1u : 0u; }
        F.local_ok = (uni && tot == (unsigned)F.G && F.G == 256) ? 1 : 0;
        if (tot == (unsigned)F.G) { F.vcu = (int)(pre + my_rank); const int per = F.G / 8; F.cx = (F.G % 8 == 0) ? (F.vcu % per) * 8 + F.vcu / per : F.vcu; }
        __syncthreads(); }
#pragma nounroll
    for (int l = 0; l < DEPTH; ++l) {
        const int pb = 1 + 8 * l;
        PB_START(1);
        if (PH_ON(1) && IN(pb + 0)) {   REFRESH();
            LAS float* gl = (LAS float*)(F.lds + LUT_OFF);
            if (F.tid < 128) gl[F.tid] = (F.tid < 64) ? KIN(4)[l * 64 + F.tid] * C2 : KIN(5)[l * 64 + F.tid - 64];
            __syncthreads();
            { SchedGate8 S8{(const char*)(F.ws + WS_XB8IN), (const char*)(F.ws + WS_WG8_T) + (size_t)l * 3584 * D, 128, 14, D / 2, F.G, c, (const int*)(F.ws + WS_IDENT), (const int*)(F.ws + WS_RSTD1)};
              EpiGate8 E8{F.ws + WS_G1, (const LAS float*)(F.lds + AUX_OFF), F.ws + WS_SBQ};
              pg8::gemm_phase<EpiGate8, SchedGate8>(F.lds, D / 2, S8, E8); }
            { SchedPlain S{(const char*)(F.ws + WS_XB), (const char*)(F.ws + WS_WIN_T) + (size_t)l * NIN * D * 2, 128, 6, D, F.G, c, (const int*)(F.ws + WS_RSTD1), nullptr};
              EpiInProj E{F.ws, (LAS float*)(F.lds + LUT_OFF), (const LAS float*)(F.lds + AUX_OFF)};
              pg8::gemm_phase<EpiInProj, SchedPlain>(F.lds, D, S, E); }
        }
        SEAM_L(pb + 0);
        PB_END(1);
        PB_START(2);
        if (PH_ON(2) && IN(pb + 1)) { REFRESH(); attention_phase(F, l); }
        SEAM_L(pb + 1);
        PB_END(2);
        PB_START(3);
        if (PH_ON(3) && IN(pb + 2)) {   REFRESH();
            SchedBranch S{(const char*)(F.ws + WS_DQ), (const char*)(F.ws + WS_SBQ), (const char*)(F.ws + WS_WBD_T) + (size_t)l * D * 512 * 2, (const char*)(F.ws + WS_WBS_T) + (size_t)l * D * 512 * 2, F.G, c};
            EpiBranch E{(const unsigned char*)(F.ws + WS_G1), (bf16*)(F.ws + WS_MIXED)};
            pg8::gemm_phase<EpiBranch, SchedBranch>(F.lds, 512, S, E);
        }
        SEAM_L(pb + 2);
        PB_END(3);
        PB_START(4);
        if (PH_ON(4) && IN(pb + 3)) {   REFRESH();
            SchedPlain S{(const char*)(F.ws + WS_MIXED), (const char*)(F.ws + WS_WOUT_T) + (size_t)l * D * D * 2, 128, 4, D, F.G, c};
            EpiOutProj E{(bf16*)(F.ws + WS_XB), (unsigned char*)(F.ws + WS_XB8)};
            pg8::gemm_phase<EpiOutProj, SchedPlain>(F.lds, D, S, E);
        }
        SEAM_L(pb + 3);
        PB_END(4);
        PB_START(5);
        if (PH_ON(5) && IN(pb + 4)) { REFRESH(); router_phase(F, l); }
        SEAM(pb + 4);
        PB_END(5);
        PB_START(7);
        if (PH_ON(7) && IN(pb + 5)) {   REFRESH();
            build_ust(F, l);
            SchedMoe<true> S{(const char*)(F.ws + WS_XB8), (const char*)(F.ws + WS_WGU_T), (const LAS int*)(F.lds + MOE_OFF), (const int*)(F.ws + WS_ENT_TOK), (const int*)(F.ws + WS_ENT_RS), nullptr, D / 2, (size_t)1024 * 1024, F.G, c};
            EpiMoe1 E{(const LAS float*)(F.lds + AUX_OFF), (unsigned char*)(F.ws + WS_ACT)};
            pg8::gemm_phase<EpiMoe1, SchedMoe<true>>(F.lds, D / 2, S, E);
        }
        SEAM_L(pb + 5);
        PB_END(7);
        PB_START(8);
        if (PH_ON(8) && IN(pb + 6)) {   REFRESH();
            build_ust(F, l);
            SchedMoe<false> S{(const char*)(F.ws + WS_ACT), (const char*)(F.ws + WS_WDN_T), (const LAS int*)(F.lds + MOE_OFF), (const int*)(F.ws + WS_IDENT), (const int*)(F.ws + WS_ENT_TOK), (const int*)(F.ws + WS_ENT_W), DFF / 2, (size_t)1024 * 512, F.G, c};
            EpiMoe2 E{(const LAS int*)(F.lds + AUX_OFF), (unsigned char*)(F.ws + WS_CONTRIB)};
            pg8::gemm_phase<EpiMoe2, SchedMoe<false>>(F.lds, DFF / 2, S, E);
        }
        SEAM(pb + 6);
        PB_END(8);
        PB_START(9);
        if (PH_ON(9) && IN(pb + 7)) {   REFRESH();
            const int per = F.G / 8, xg = F.vcu / per, lw = (F.vcu % per) * NWAVES + F.wave; const bool al = (F.G == 256);
            const int mf = al ? 4096 * xg + 2 * lw : 2 * gw, ms = al ? 512 : 2 * NGW, me = al ? 4096 * xg + 4096 : T;
            if (l + 1 < DEPTH) { rows_phase<true, true, false, true>(F, nullptr, nullptr, mf, ms, me); convert_moe_weights(F, l + 1, gw, NGW); }
            else rows_phase<true, true, true, false>(F, nullptr, F.out, mf, ms, me);
        }
        if (l + 1 < DEPTH) SEAM_L(pb + 7);
        PB_END(9);
    }
    if (PROBE_TYPE >= 0 && blockIdx.x == 0 && threadIdx.x == 0) { const unsigned long long te = __builtin_amdgcn_s_memrealtime();
        while (__builtin_amdgcn_s_memrealtime() - te < PROBE_AMP * F.pb_acc) __builtin_amdgcn_s_sleep(8); }
#undef IN
#undef SEAM
}

extern "C" void kernel_launch(void* const* d_in, const int* in_sizes, int n_in, void* d_out, int out_size, void* d_ws, size_t ws_size, hipStream_t stream) {
    static int grid = 0;
    if (grid == 0) {
        if (n_in != 20 || in_sizes[0] != T * D || out_size != T * D || ws_size < WS_END) { fprintf(stderr, "kernel_launch: unexpected shapes / workspace (n_in %d, ws %zu, need %zu)\n", n_in, ws_size, (size_t)WS_END); grid = -1; return; }
        int dev = 0, cus = 0, per_cu = 0;
        if (hipGetDevice(&dev) != hipSuccess || hipDeviceGetAttribute(&cus, hipDeviceAttributeMultiprocessorCount, dev) != hipSuccess) { grid = -1; return; }
        if (hipFuncSetAttribute((const void*)mk_fwd, hipFuncAttributeMaxDynamicSharedMemorySize, LDS_BYTES) != hipSuccess) { fprintf(stderr, "kernel_launch: hipFuncSetAttribute failed\n"); grid = -1; return; }
        if (hipOccupancyMaxActiveBlocksPerMultiprocessor(&per_cu, (const void*)mk_fwd, NWAVES * 64, LDS_BYTES) != hipSuccess || per_cu < 1) fprintf(stderr, "kernel_launch: occupancy query reports %d\n", per_cu);
        (void)hipGetLastError();
        grid = cus < 1024 ? cus : 1024;
    }
    if (grid < 0) return;
    if (hipMemsetAsync((char*)d_ws + WS_CTL, 0, CTL_ZERO_BYTES, stream) != hipSuccess) return;
    Args a{};
    for (int i = 0; i < 20; ++i) a.in[i] = (const float*)d_in[i];
    a.out = (float*)d_out; a.ws = (unsigned char*)d_ws;
#if MK_SPLIT
    for (int p = 0; p < NPHASE; ++p) { a.ph_lo = p; a.ph_hi = p + 1; hipLaunchKernelGGL(mk_fwd, dim3(grid), dim3(NWAVES * 64), LDS_BYTES, stream, a); }
#else
    a.ph_lo = 0; a.ph_hi = NPHASE;
    hipLaunchKernelGGL(mk_fwd, dim3(grid), dim3(NWAVES * 64), LDS_BYTES, stream, a);
#endif
}
```
